# Optimizing an MI355X kernel written in HIP

```python
import math
import jax
import jax.numpy as jnp
from jax import lax
import numpy as np

D_MODEL = 2048
BATCH = 2
SEQ = 16384
DEPTH = 2

GRID_W = 64
CTX_LEN = 256
NORM_EPS = 1e-6

RW_N = 64
RW_H = D_MODEL // RW_N
RW_D = RW_H * RW_N
W_LORA = 96
A_LORA = 96
G_LORA = 64
RW_GN_EPS = 64e-5

HY_D = D_MODEL
HY_ORDER = 2
HY_EMB = 33
HY_BANDS = (HY_EMB - 1) // 2
HY_HIDDEN = 64
HY_TARGET = 1e-2
HY_FAST_PCT = 0.3
HY_SLOW_PCT = 1.5

P_HEADS = 8
N_KEYS = 128
N_EXPERTS = N_KEYS * N_KEYS
P_TOPK = 16
D_KEY = 256
D_KEY_HALF = D_KEY // 2
PEER_BLOCK = 128

RW_STATE_COLS = 2 * RW_D + 2 * W_LORA + 2 * A_LORA
RWKV_COLS = RW_STATE_COLS + RW_D + G_LORA
HY_COLS = (HY_ORDER + 1) * HY_D
CONV_COLS = RWKV_COLS + HY_COLS
IN_COLS = CONV_COLS + 2 * D_MODEL

kernel_name = 'hybrid_rwkv7_hyena_peer_dit'


def rms_norm(x, g):
    xf = x.astype(jnp.float32)
    y = xf * lax.rsqrt(jnp.mean(xf * xf, axis=-1, keepdims=True) + NORM_EPS)
    return y.astype(x.dtype) * g


def modulate(x, g, shift, scale):
    return rms_norm(x, g) * (1.0 + scale) + shift


def short_conv(u, w, n_seg):
    b, L, C = u.shape
    us = u.reshape(b, n_seg, L // n_seg, C)
    up = jnp.pad(us, ((0, 0), (0, 0), (1, 1), (0, 0)))
    out = w[0] * up[:, :, :-2] + w[1] * up[:, :, 1:-1] + w[2] * up[:, :, 2:]
    return out.reshape(b, L, C)


def project_and_conv(h, w_in, conv_w, n_seg):
    p = h @ w_in
    return short_conv(p[..., :CONV_COLS], conv_w, n_seg), jax.nn.sigmoid(p[..., CONV_COLS:])


def rwkv_prepare(cols, w0, w2, a0, a2, k_k):
    b, L, _ = cols.shape
    heads = lambda t: t.reshape(b, L, RW_H, RW_N)
    k = heads(cols[..., :RW_D])
    v = heads(cols[..., RW_D:2 * RW_D])
    o = 2 * RW_D
    wd = (cols[..., o:o + W_LORA], cols[..., o + W_LORA:o + 2 * W_LORA])
    o += 2 * W_LORA
    ad = (cols[..., o:o + A_LORA], cols[..., o + A_LORA:o + 2 * A_LORA])
    kk = heads(cols[..., :RW_D] * k_k).astype(jnp.float32)
    kk = kk * lax.rsqrt(jnp.maximum(jnp.sum(kk * kk, axis=-1, keepdims=True), 1e-24))
    logw, a = [], []
    for d in range(2):
        wraw = (w0[d] + jnp.tanh(wd[d]) @ w2[d]).astype(jnp.float32)
        logw.append(heads(-jnp.exp(-jax.nn.softplus(-wraw) - 0.5)))
        a.append(heads(jax.nn.sigmoid((a0[d] + ad[d] @ a2[d]).astype(jnp.float32))))
    return k, v, kk, a, logw


def wkv_scan(k, v, kk, a, logw, k_a, s0, reverse, r):
    to_t = lambda t: jnp.moveaxis(t.astype(jnp.float32), 1, 0)
    xs = (to_t(k), to_t(v), to_t(kk), to_t(a), to_t(logw))
    if r is not None:
        xs = xs + (to_t(r),)

    def step(S, inp):
        k_t, v_t, kk_t, a_t, lw_t = inp[:5]
        kt = k_t * (1.0 + (a_t - 1.0) * k_a)
        s_kk = jnp.einsum('bhij,bhj->bhi', S, kk_t)
        S = (S * jnp.exp(lw_t)[:, :, None, :]
             - s_kk[..., :, None] * (kk_t * a_t)[:, :, None, :]
             + v_t[..., :, None] * kt[:, :, None, :])
        if r is None:
            return S, None
        return S, jnp.einsum('bhij,bhj->bhi', S, inp[5])

    s_fin, ys = lax.scan(step, s0, xs, reverse=reverse)
    return s_fin, (None if r is None else jnp.moveaxis(ys, 0, 1))


def rwkv_mixer(cols, rw_p, s0_f, s0_b, with_output):
    w0, w2, a0, a2, g2, k_k, k_a, r_k, ln_w, ln_b = rw_p
    k, v, kk, a, logw = rwkv_prepare(cols[..., :RW_STATE_COLS], w0, w2, a0, a2, k_k)
    k_a_h = k_a.reshape(RW_H, RW_N)
    if not with_output:
        s_f, _ = wkv_scan(k, v, kk, a[0], logw[0], k_a_h, s0_f, False, None)
        s_b, _ = wkv_scan(k, v, kk, a[1], logw[1], k_a_h, s0_b, True, None)
        return None, s_f, s_b
    b, L, _ = cols.shape
    r = cols[..., RW_STATE_COLS:RW_STATE_COLS + RW_D].reshape(b, L, RW_H, RW_N)
    gd = cols[..., RW_STATE_COLS + RW_D:RWKV_COLS]
    s_f, y_f = wkv_scan(k, v, kk, a[0], logw[0], k_a_h, s0_f, False, r)
    s_b, y_b = wkv_scan(k, v, kk, a[1], logw[1], k_a_h, s0_b, True, r)
    y = y_f + y_b
    mu = jnp.mean(y, axis=-1, keepdims=True)
    var = jnp.mean(jnp.square(y - mu), axis=-1, keepdims=True)
    yn = ((y - mu) * lax.rsqrt(var + RW_GN_EPS)).reshape(b, L, RW_D).astype(cols.dtype) * ln_w + ln_b
    bonus = (jnp.sum(r * k * r_k, axis=-1, keepdims=True) * v).reshape(b, L, RW_D)
    g = jax.nn.sigmoid(gd) @ g2
    return (yn + bonus) * g, s_f, s_b


def hyena_filter_spectrum(L, hy_p):
    w1, b1, w2, b2, w3, freq = hy_p
    f32 = jnp.float32
    t = jnp.linspace(0.0, 1.0, L, dtype=f32)[:, None]
    bands = jnp.linspace(1e-4, HY_BANDS - 1, HY_BANDS, dtype=f32)[None, :]
    ang = (2.0 * math.pi / L) * jnp.arange(L, dtype=f32)[:, None] * bands
    z = jnp.concatenate([t, jnp.cos(ang), -jnp.sin(ang)], axis=-1)
    hdn = jnp.sin(freq * (z @ w1 + b1))
    hdn = jnp.sin(freq * (hdn @ w2 + b2))
    h = (hdn @ w3).astype(f32).reshape(L, HY_ORDER, 2, HY_D)
    deltas = jnp.abs(jnp.linspace(math.log(HY_TARGET) / HY_SLOW_PCT, math.log(HY_TARGET) / HY_FAST_PCT, HY_D, dtype=f32))
    h = h * jnp.exp(-t * deltas)[:, None, None, :]
    h = h * lax.rsqrt(jnp.sum(h * h, axis=(0, 2), keepdims=True))
    fwd, bwd = h[:, :, 0], h[:, :, 1]
    g = jnp.concatenate([fwd[:1] + bwd[:1], fwd[1:], jnp.zeros_like(fwd[:1]), bwd[:0:-1]], axis=0)
    return jnp.fft.rfft(g, axis=0)


def fft_long_conv(u, spec):
    L = u.shape[1]
    U = jnp.fft.rfft(u.astype(jnp.float32), n=2 * L, axis=1)
    return jnp.fft.irfft(U * spec[None], n=2 * L, axis=1)[:, :L].astype(u.dtype)


def hyena_mixer(cols, spec, skip):
    v, x1, x2 = jnp.split(cols, 3, axis=-1)
    z = x1 * (fft_long_conv(v, spec[:, 0]) + v * skip[0])
    return x2 * (fft_long_conv(z, spec[:, 1]) + z * skip[1])


def token_mixing(h, w_in, conv_w, w_out, rw_p, hy_spec, hy_skip, n_seg, s0_f, s0_b):
    mix, gates = project_and_conv(h, w_in, conv_w, n_seg)
    y_rw, s_f, s_b = rwkv_mixer(mix[..., :RWKV_COLS], rw_p, s0_f, s0_b, True)
    y_hy = hyena_mixer(mix[..., RWKV_COLS:], hy_spec, hy_skip)
    y = gates[..., :D_MODEL] * y_rw + gates[..., D_MODEL:] * y_hy
    return y @ w_out, s_f, s_b


def peer(h, wq, keys, u_tab, v_tab):
    b, L, d = h.shape
    t = b * L
    hf = h.reshape(t, d)
    q = (hf @ wq).reshape(t, P_HEADS, 2, D_KEY_HALF)
    s = jnp.einsum('thpd,hpnd->thpn', q, keys).astype(jnp.float32)
    s1, i1 = lax.top_k(s[:, :, 0], P_TOPK)
    s2, i2 = lax.top_k(s[:, :, 1], P_TOPK)
    cand = (s1[..., :, None] + s2[..., None, :]).reshape(t, P_HEADS, P_TOPK * P_TOPK)
    cidx = (i1[..., :, None] * N_KEYS + i2[..., None, :]).reshape(t, P_HEADS, P_TOPK * P_TOPK)
    best, pos = lax.top_k(cand, P_TOPK)
    idx = jnp.take_along_axis(cidx, pos, axis=-1)
    gate = jax.nn.softmax(best, axis=-1).astype(h.dtype)
    nb = t // PEER_BLOCK

    def block(args):
        xb, ib, gb = args
        ub = jnp.take(u_tab, ib, axis=0)
        act = jax.nn.gelu(jnp.einsum('thkd,td->thk', ub, xb), approximate=False)
        vb = jnp.take(v_tab, ib, axis=0)
        return jnp.einsum('thk,thkd->td', gb * act, vb)

    out = lax.map(block, (hf.reshape(nb, PEER_BLOCK, d),
                          idx.reshape(nb, PEER_BLOCK, P_HEADS, P_TOPK),
                          gate.reshape(nb, PEER_BLOCK, P_HEADS, P_TOPK)))
    return out.reshape(b, L, d)


def setup_inputs(seed: int = 0) -> dict:
    key = jax.random.key(seed)
    ks = iter(jax.random.split(key, 48))
    nrm = lambda shape, s: s * jax.random.normal(next(ks), shape, jnp.float32)
    conv_base = jnp.array([0.25, 0.5, 0.25], dtype=jnp.float32)[None, :, None]
    return {
        'x': nrm((BATCH, SEQ, D_MODEL), 1.0),
        'c': nrm((BATCH, D_MODEL), 1.0),
        'ctx': nrm((BATCH, CTX_LEN, D_MODEL), 1.0),
        'c_ctx': nrm((D_MODEL,), 1.0),
        'ada_w': nrm((DEPTH, D_MODEL, 6 * D_MODEL), 0.5 * D_MODEL ** -0.5),
        'ada_b': nrm((DEPTH, 6 * D_MODEL), 0.01),
        'norm1_g': 1.0 + nrm((DEPTH, D_MODEL), 0.1),
        'norm2_g': 1.0 + nrm((DEPTH, D_MODEL), 0.1),
        'w_in': nrm((DEPTH, D_MODEL, IN_COLS), D_MODEL ** -0.5),
        'conv_w': conv_base + nrm((DEPTH, 3, CONV_COLS), 0.1),
        'rw_w0': nrm((DEPTH, 2, RW_D), 1.0) - 0.5,
        'rw_w2': nrm((DEPTH, 2, W_LORA, RW_D), 0.5 * W_LORA ** -0.5),
        'rw_a0': nrm((DEPTH, 2, RW_D), 0.1),
        'rw_a2': nrm((DEPTH, 2, A_LORA, RW_D), 0.5 * A_LORA ** -0.5),
        'rw_g2': nrm((DEPTH, G_LORA, RW_D), G_LORA ** -0.5),
        'rw_k_k': 0.85 + nrm((DEPTH, RW_D), 0.05),
        'rw_k_a': 1.0 + nrm((DEPTH, RW_D), 0.05),
        'rw_r_k': nrm((DEPTH, RW_H, RW_N), 0.1),
        'rw_ln_w': 1.0 + nrm((DEPTH, RW_D), 0.1),
        'rw_ln_b': nrm((DEPTH, RW_D), 0.01),
        'hy_w1': nrm((DEPTH, HY_EMB, HY_HIDDEN), HY_EMB ** -0.5),
        'hy_b1': nrm((DEPTH, HY_HIDDEN), 0.1),
        'hy_w2': nrm((DEPTH, HY_HIDDEN, HY_HIDDEN), HY_HIDDEN ** -0.5),
        'hy_b2': nrm((DEPTH, HY_HIDDEN), 0.1),
        'hy_w3': nrm((DEPTH, HY_HIDDEN, HY_ORDER * 2 * HY_D), HY_HIDDEN ** -0.5),
        'hy_freq': 1.0 + nrm((DEPTH, HY_HIDDEN), 0.1),
        'hy_skip': nrm((DEPTH, HY_ORDER, HY_D), 0.1),
        'w_out': nrm((DEPTH, D_MODEL, D_MODEL), D_MODEL ** -0.5),
        'peer_wq': nrm((DEPTH, D_MODEL, P_HEADS * D_KEY), D_MODEL ** -0.5),
        'peer_keys': nrm((DEPTH, P_HEADS, 2, N_KEYS, D_KEY_HALF), D_KEY_HALF ** -0.5),
        'peer_u': nrm((DEPTH, N_EXPERTS, D_MODEL), D_MODEL ** -0.5),
        'peer_v': nrm((DEPTH, N_EXPERTS, D_MODEL), 0.5),
        'final_g': 1.0 + nrm((D_MODEL,), 0.1),
    }


def reference(x, c, ctx, c_ctx, ada_w, ada_b, norm1_g, norm2_g, w_in, conv_w,
              rw_w0, rw_w2, rw_a0, rw_a2, rw_g2, rw_k_k, rw_k_a, rw_r_k, rw_ln_w, rw_ln_b,
              hy_w1, hy_b1, hy_w2, hy_b2, hy_w3, hy_freq, hy_skip, w_out,
              peer_wq, peer_keys, peer_u, peer_v, final_g):
    b, L, _ = x.shape
    rows = L // GRID_W
    ctx_len = ctx.shape[1]
    s_zero = jnp.zeros((b, RW_H, RW_N, RW_N), jnp.float32)
    for l in range(DEPTH):
        last = l == DEPTH - 1
        rw_p = (rw_w0[l], rw_w2[l], rw_a0[l], rw_a2[l], rw_g2[l], rw_k_k[l], rw_k_a[l],
                rw_r_k[l], rw_ln_w[l], rw_ln_b[l])
        hy_p = (hy_w1[l], hy_b1[l], hy_w2[l], hy_b2[l], hy_w3[l], hy_freq[l])
        mod_x = (jax.nn.silu(c) @ ada_w[l] + ada_b[l])[:, None, :]
        mod_c = (jax.nn.silu(c_ctx) @ ada_w[l] + ada_b[l])[None, None, :]
        sh1x, sc1x, ga1x, sh2x, sc2x, ga2x = jnp.split(mod_x, 6, axis=-1)
        sh1c, sc1c, ga1c, sh2c, sc2c, ga2c = jnp.split(mod_c, 6, axis=-1)

        hc = modulate(ctx, norm1_g[l], sh1c, sc1c)
        if last:
            cols_c = short_conv(hc @ w_in[l][:, :RW_STATE_COLS], conv_w[l][:, :RW_STATE_COLS], 1)
            _, s_f, s_b = rwkv_mixer(cols_c, rw_p, s_zero, s_zero, False)
        else:
            y_c, s_f, s_b = token_mixing(hc, w_in[l], conv_w[l], w_out[l], rw_p,
                                         hyena_filter_spectrum(ctx_len, hy_p), hy_skip[l], 1,
                                         s_zero, s_zero)
            ctx = ctx + ga1c * y_c
            ctx = ctx + ga2c * peer(modulate(ctx, norm2_g[l], sh2c, sc2c),
                                    peer_wq[l], peer_keys[l], peer_u[l], peer_v[l])

        hx = modulate(x, norm1_g[l], sh1x, sc1x)
        y_x, _, _ = token_mixing(hx, w_in[l], conv_w[l], w_out[l], rw_p,
                                 hyena_filter_spectrum(L, hy_p), hy_skip[l], rows, s_f, s_b)
        x = x + ga1x * y_x
        x = x + ga2x * peer(modulate(x, norm2_g[l], sh2x, sc2x),
                            peer_wq[l], peer_keys[l], peer_u[l], peer_v[l])
    return rms_norm(x, final_g)
```

```cpp
#include <hip/hip_runtime.h>
#include <cstdio>
#include <cstdint>

typedef unsigned short bf16_t;
typedef float f32x4 __attribute__((ext_vector_type(4)));
typedef float f32x2 __attribute__((ext_vector_type(2)));
typedef unsigned u32x4 __attribute__((ext_vector_type(4)));
typedef unsigned u32x2 __attribute__((ext_vector_type(2)));
#define LAS __attribute__((address_space(3)))

#define XB_TMO      128
#define XB_XCNT(j)  (256  + 64 * (j))
#define XB_XSUB(j)  (1280 + 64 * (j))
#define XB_XGEN(j)  (2304 + 64 * (j))
#define XB_TOP      3328
#define XB_TOPGEN   3392
#define XCD_BAR_WORDS 3456
#define XB_SPIN_CAP (1u << 22)

__device__ __forceinline__ unsigned xb_ld(unsigned* p)              { return __hip_atomic_load(p, __ATOMIC_RELAXED, __HIP_MEMORY_SCOPE_AGENT); }
__device__ __forceinline__ unsigned xb_add(unsigned* p, unsigned v) { return __hip_atomic_fetch_add(p, v, __ATOMIC_RELAXED, __HIP_MEMORY_SCOPE_AGENT); }
__device__ __forceinline__ unsigned xb_xcc_id() { return (unsigned)__builtin_amdgcn_s_getreg((3 << 11) | 20) & 0xFu; }
#define XB_SPIN(cond, bar) do { unsigned _sp = 0; while (cond) { __builtin_amdgcn_s_sleep(1); \
    if ((++_sp & 255u) == 0u) { if (xb_ld(&(bar)[XB_TMO])) break; if (_sp > XB_SPIN_CAP) { atomicAdd(&(bar)[XB_TMO], 1u); break; } } } } while (0)

struct XcdBarrier { unsigned* bar; unsigned x; volatile LAS unsigned* st; };

__device__ __forceinline__ XcdBarrier xcd_barrier_post(unsigned* bar, volatile LAS unsigned* st) {
    XcdBarrier b; b.bar = bar; b.x = xb_xcc_id(); b.st = st;
    if (threadIdx.x == 0) (void)xb_add(&bar[XB_XCNT(b.x)], 1u);
    return b;
}
__device__ __forceinline__ void xcd_barrier_complete(unsigned* bar, unsigned x, unsigned& nloc, unsigned& nx) {
    const unsigned G = gridDim.x * gridDim.y * gridDim.z;
    unsigned sum, cnt, mine, sp = 0u;
    for (;;) {
        sum = 0u; cnt = 0u; mine = 0u;
#pragma unroll
        for (unsigned j = 0; j < 16; ++j) { const unsigned c = xb_ld(&bar[XB_XCNT(j)]); sum += c; cnt += (c > 0u) ? 1u : 0u; mine = (j == x) ? c : mine; }
        if (sum == G) break;
        __builtin_amdgcn_s_sleep(1);
        if ((++sp & 255u) == 0u) { if (xb_ld(&bar[XB_TMO])) break; if (sp > XB_SPIN_CAP) { atomicAdd(&bar[XB_TMO], 1u); break; } }
    }
    nloc = mine > 0u ? mine : 1u; nx = cnt > 0u ? cnt : 1u;
}
__device__ __forceinline__ void xcd_barrier(const XcdBarrier& b) {
    asm volatile("s_waitcnt vmcnt(0)" ::: "memory");
    __syncthreads();
    if (threadIdx.x == 0) {
        unsigned* bar = b.bar;
        __builtin_amdgcn_s_waitcnt(0);
        unsigned nloc = b.st[0], nx = b.st[1];
        if (nloc == 0u) { xcd_barrier_complete(bar, b.x, nloc, nx); b.st[0] = nloc; b.st[1] = nx; }
        const unsigned old = xb_add(&bar[XB_XSUB(b.x)], 1u);
        const unsigned gen = old / nloc;
        if (old + 1u == (gen + 1u) * nloc) {
            __builtin_amdgcn_fence(__ATOMIC_RELEASE, "agent");
            asm volatile("s_waitcnt vmcnt(0)" ::: "memory");
            const unsigned og = xb_add(&bar[XB_TOP], 1u);
            const unsigned tg = og / nx;
            if (og + 1u == (tg + 1u) * nx) xb_add(&bar[XB_TOPGEN], 1u);
            else XB_SPIN(xb_ld(&bar[XB_TOPGEN]) == tg, bar);
            __builtin_amdgcn_fence(__ATOMIC_ACQUIRE, "agent");
            xb_add(&bar[XB_XGEN(b.x)], 1u);
            asm volatile("s_waitcnt vmcnt(0)" ::: "memory");
        } else {
            XB_SPIN(xb_ld(&bar[XB_XGEN(b.x)]) == gen, bar);
            __builtin_amdgcn_fence(__ATOMIC_ACQUIRE, "agent");
            asm volatile("s_waitcnt vmcnt(0)" ::: "memory");
        }
    }
    __syncthreads();
}

namespace pg8 {
#define PG8_LAS __attribute__((address_space(3)))
typedef unsigned short bf16_t;
typedef short bf16x8 __attribute__((ext_vector_type(8)));
typedef float f32x4 __attribute__((ext_vector_type(4)));
typedef unsigned u32x4 __attribute__((ext_vector_type(4)));
constexpr int BM = 256, BK = 64, HALF = 128, HTB = HALF * BK * 2  , STAGE_BYTES = 8 * HTB, NXCD = 8, WGM = 8;

__host__ __device__ __forceinline__ int lds_byte(int r, int c) { const int st = (r >> 4) * 2 + (c >> 5), rr = r & 15, cc = c & 31, ob = rr * 64 + cc * 2; return st * 1024 + (ob ^ (((ob >> 9) & 1) << 5)); }
__host__ __device__ __forceinline__ void stage_rc(int b, int& R, int& C) { const int st = b / 1024, sb = b % 1024, swz = sb ^ (((sb >> 9) & 1) << 5); R = (st >> 1) * 16 + swz / 64; C = (st & 1) * 32 + (swz % 64) / 2; }
__host__ __device__ __forceinline__ int perm32(int rho) { const int n = rho >> 4, i = rho & 15; return 8 * (i >> 2) + 4 * n + (i & 3); }

struct Unit { int pm, pn; };
struct Gemm { const bf16_t* A; const bf16_t* Bt; int M, N, K, lda, ldb; };

struct StaticOrder {
    int nM, nN, nwg, G, c;
    __host__ __device__ void init(int M, int N, int G_, int c_) { nM = M / BM; nN = N / BM; nwg = nM * nN; G = G_; c = c_; }
    __host__ __device__ bool next(int i, Unit& u) const {
        const long L = (long)i * G + c; if (L >= nwg) return false;
        int wgid = (int)L; { const int q = nwg / NXCD, r = nwg % NXCD, xcd = wgid % NXCD, off = wgid / NXCD; wgid = (xcd < r ? xcd * (q + 1) : r * (q + 1) + (xcd - r) * q) + off; }
        const int nig = WGM * nN, gid = wgid / nig, fm = gid * WGM, gsz = (nM - fm) < WGM ? (nM - fm) : WGM;
        u.pm = fm + ((wgid % nig) % gsz); u.pn = (wgid % nig) / gsz; return true;
    }
    __device__ __forceinline__ void a_ready(const Unit&) const {}
    __device__ __forceinline__ void done(const Unit&) const {}
};
__device__ __forceinline__ unsigned cvt_pk_bf16(float lo, float hi) { unsigned r; asm volatile("v_cvt_pk_bf16_f32 %0, %1, %2" : "=v"(r) : "v"(lo), "v"(hi)); return r; }
typedef float f32x2 __attribute__((ext_vector_type(2)));
template <class Epi, class Sched>
__device__ __forceinline__ void gemm_phase(PG8_LAS unsigned char* lds, const Gemm g, const Sched& S, const Epi& E) {
    const int tid = threadIdx.x, wid = __builtin_amdgcn_readfirstlane(tid >> 6), lane = tid & 63, wr = wid >> 2, wc = wid & 3, fr = lane & 15, fq = lane >> 4;
    const int K = g.K, nt = K / BK;
    unsigned voffA[2], voffB[2];
#pragma unroll
    for (int i = 0; i < 2; ++i) { int R, C; stage_rc(tid * 16 + i * 8192, R, C); const int Rb = Epi::PERM ? ((R & ~31) + perm32(R & 31)) : R;
        voffA[i] = (unsigned)(R * g.lda + C) * 2u; voffB[i] = (unsigned)(Rb * g.ldb + C) * 2u; }
    const size_t kstep = (size_t)(BK * 2);
    const size_t hstepA = (size_t)HALF * g.lda * 2, hstepB = (size_t)HALF * g.ldb * 2;
    const size_t tstepA = 2 * hstepA, tstepB = 2 * hstepB;
    const unsigned ldsw = (unsigned)wid * 1024u;
    const int aoff = lds_byte(wr * 64 + fr, fq * 8), boff = lds_byte(wc * 32 + fr, fq * 8);
#define PG8_SA(b, h) (((b) * 2 + (h)) * HTB)
#define PG8_SB(b, h) ((4 + (b) * 2 + (h)) * HTB)
#define PG8_STAGE(bufoff, gbase, voff) do { _Pragma("unroll") for (int _i = 0; _i < 2; ++_i) \
        __builtin_amdgcn_global_load_lds((const unsigned*)((const char*)(gbase) + (voff)[_i]), (PG8_LAS unsigned*)(lds + (bufoff) + ldsw + _i * 8192), 16, 0, 0); } while (0)
#define PG8_LDA(dst, b, h) do { _Pragma("unroll") for (int m = 0; m < 4; ++m) _Pragma("unroll") for (int k = 0; k < 2; ++k) dst[m][k] = *(const PG8_LAS bf16x8*)(lds + PG8_SA(b, h) + aoff + m * 2048 + k * 1024); } while (0)
#define PG8_LDB(dst, b, h) do { _Pragma("unroll") for (int n = 0; n < 2; ++n) _Pragma("unroll") for (int k = 0; k < 2; ++k) dst[n][k] = *(const PG8_LAS bf16x8*)(lds + PG8_SB(b, h) + boff + n * 2048 + k * 1024); } while (0)
#define PG8_MMA(ai, bj, At, Bt) do { __builtin_amdgcn_s_setprio(1); _Pragma("unroll") for (int m = 0; m < 4; ++m) _Pragma("unroll") for (int n = 0; n < 2; ++n) _Pragma("unroll") for (int k = 0; k < 2; ++k) \
        acc[ai][bj][m][n] = __builtin_amdgcn_mfma_f32_16x16x32_bf16(Bt[n][k], At[m][k], acc[ai][bj][m][n], 0, 0, 0); __builtin_amdgcn_s_setprio(0); } while (0)
#define PG8_WAIT_V(n) asm volatile("s_waitcnt vmcnt(" #n ")" ::: "memory")
#define PG8_WAIT_L(n) asm volatile("s_waitcnt lgkmcnt(" #n ")" ::: "memory")
#define PG8_BAR __builtin_amdgcn_s_barrier()
#define PG8_SCHED __builtin_amdgcn_sched_barrier(0)
    Unit cur, nxt; int ui = 0;
    if (!S.next(0, cur)) return;
    f32x4 acc[2][2][4][2];
#pragma unroll
    for (int a = 0; a < 2; ++a)
#pragma unroll
        for (int b = 0; b < 2; ++b)
#pragma unroll
            for (int m = 0; m < 4; ++m)
#pragma unroll
                for (int n = 0; n < 2; ++n) acc[a][b][m][n] = (f32x4){0.f, 0.f, 0.f, 0.f};
    bf16x8 At[4][2], B0[2][2], B1[2][2];
    const char* cA = (const char*)g.A + (size_t)cur.pm * tstepA; const char* cB = (const char*)g.Bt + (size_t)cur.pn * tstepB;
    S.a_ready(cur);
    PG8_STAGE(PG8_SB(0, 0), cB, voffB); PG8_STAGE(PG8_SA(0, 0), cA, voffA); PG8_STAGE(PG8_SB(0, 1), cB + hstepB, voffB); PG8_STAGE(PG8_SA(0, 1), cA + hstepA, voffA);
    if (wr == 1) PG8_BAR;
    PG8_WAIT_V(4); PG8_BAR;
    PG8_STAGE(PG8_SB(1, 0), cB + kstep, voffB); PG8_STAGE(PG8_SA(1, 0), cA + kstep, voffA); PG8_STAGE(PG8_SB(1, 1), cB + hstepB + kstep, voffB);
    PG8_WAIT_V(6); PG8_BAR;
    for (;;) {
        const bool has_next = S.next(ui + 1, nxt);
        const char* nA = has_next ? (const char*)g.A + (size_t)nxt.pm * tstepA : cA; const char* nB = has_next ? (const char*)g.Bt + (size_t)nxt.pn * tstepB : cB;
        for (int t = 0; t < nt; t += 2) {
            const bool last = (t == nt - 2);
            const char* a1 = cA + (size_t)(t + 1) * kstep;
            const char* a2 = last ? nA : cA + (size_t)(t + 2) * kstep; const char* b2 = last ? nB : cB + (size_t)(t + 2) * kstep;
            const char* a3 = a2 + kstep; const char* b3 = b2 + kstep;
            if (last && has_next) S.a_ready(nxt);
            PG8_LDB(B0, 0, 0); PG8_SCHED; PG8_LDA(At, 0, 0); PG8_STAGE(PG8_SA(1, 1), a1 + hstepA, voffA);
            PG8_WAIT_L(8); PG8_BAR; PG8_WAIT_L(0); PG8_MMA(0, 0, At, B0); PG8_BAR; PG8_SCHED;
            PG8_LDB(B1, 0, 1); PG8_STAGE(PG8_SB(0, 0), b2, voffB);
            PG8_BAR; PG8_WAIT_L(0); PG8_MMA(0, 1, At, B1); PG8_BAR;
            PG8_LDA(At, 0, 1); PG8_STAGE(PG8_SA(0, 0), a2, voffA);
            PG8_BAR; PG8_WAIT_L(0); PG8_MMA(1, 0, At, B0); PG8_BAR; PG8_SCHED;
            PG8_STAGE(PG8_SB(0, 1), b2 + hstepB, voffB);
            PG8_WAIT_V(6); PG8_BAR; PG8_MMA(1, 1, At, B1); PG8_BAR;
            PG8_LDB(B0, 1, 0); PG8_SCHED; PG8_LDA(At, 1, 0); PG8_STAGE(PG8_SA(0, 1), a2 + hstepA, voffA);
            PG8_WAIT_L(8); PG8_BAR; PG8_WAIT_L(0); PG8_MMA(0, 0, At, B0); PG8_BAR; PG8_SCHED;
            PG8_LDB(B1, 1, 1); PG8_STAGE(PG8_SB(1, 0), b3, voffB);
            PG8_BAR; PG8_WAIT_L(0); PG8_MMA(0, 1, At, B1); PG8_BAR;
            PG8_LDA(At, 1, 1); PG8_STAGE(PG8_SA(1, 0), a3, voffA);
            PG8_BAR; PG8_WAIT_L(0); PG8_MMA(1, 0, At, B0); PG8_BAR; PG8_SCHED;
            PG8_STAGE(PG8_SB(1, 1), b3 + hstepB, voffB);
            PG8_WAIT_V(6); PG8_BAR; PG8_MMA(1, 1, At, B1); PG8_BAR;
        }
            if constexpr (!Epi::AFTER_DRAIN) { E(acc, cur, wr, wc, fr, fq); S.done(cur); }
            if (!has_next) break;
#pragma unroll
        for (int a = 0; a < 2; ++a)
#pragma unroll
            for (int b = 0; b < 2; ++b)
#pragma unroll
                for (int m = 0; m < 4; ++m)
#pragma unroll
                    for (int n = 0; n < 2; ++n) acc[a][b][m][n] = (f32x4){0.f, 0.f, 0.f, 0.f};
        cur = nxt; cA = nA; cB = nB; ++ui;
    }
    PG8_WAIT_V(0);
    if (wr == 0) PG8_BAR;
    PG8_BAR;
    if constexpr (Epi::AFTER_DRAIN) { E.fused(acc, cur, wr, wc, fr, fq, lds, wid, lane); S.done(cur); }
#undef PG8_SA
#undef PG8_SB
#undef PG8_STAGE
#undef PG8_LDA
#undef PG8_LDB
#undef PG8_MMA
#undef PG8_WAIT_V
#undef PG8_WAIT_L
#undef PG8_BAR
#undef PG8_SCHED
}
}

constexpr int D = 2048, NB = 2, SEQ = 16384, CL = 256, TL = NB * SEQ, TC = NB * CL, MR = TL + TC;
constexpr int NHEAD = 32, HN = 64;
constexpr int IN_COLS = 16832, CONV_COLS = 12736;
constexpr int NR = 6656, NHY = 6144, NG = 4096, NTOT = NR + NHY + NG;
constexpr int LORA_W = 512;
constexpr int NPART = 32;
constexpr int NEXP = 16384;
constexpr float NORM_EPS = 1e-6f, GN_EPS = 64e-5f;
constexpr int NTHREADS = 512;
constexpr int LDS_BYTES = 150 * 1024;

constexpr size_t al256(size_t x) { return (x + 255) & ~(size_t)255; }
constexpr size_t SLOT_BYTES = (size_t)MR * D * 2;
constexpr size_t WS_BAR    = 0;
constexpr size_t WS_MOD    = 16384;
constexpr size_t WS_MODP   = WS_MOD    + al256((size_t)2 * 3 * 6 * D * 4);
constexpr size_t WS_TW     = WS_MODP   + al256((size_t)NPART * 2 * 3 * 6 * D * 4);
constexpr size_t WS_CONVW  = WS_TW     + al256((size_t)32768 * 8);
constexpr size_t WS_LBIAS  = WS_CONVW  + al256((size_t)3 * NTOT * 4);
constexpr size_t WS_CTXRES = WS_LBIAS  + al256((size_t)4 * D * 4);
constexpr size_t WS_H      = WS_CTXRES + al256((size_t)TC * D * 4);
constexpr size_t WS_WTIN   = WS_H      + SLOT_BYTES;
constexpr size_t WS_WTLORA = WS_WTIN   + al256((size_t)NTOT * D * 2);
constexpr size_t WS_WTOUT  = WS_WTLORA + al256((size_t)4 * D * LORA_W * 2);
constexpr size_t WS_WTSC   = WS_WTOUT  + al256((size_t)D * D * 2);
constexpr size_t WS_W3T    = WS_WTSC   + al256((size_t)D * D * 2);
constexpr size_t WS_HDN    = WS_W3T    + al256((size_t)8192 * 256 * 2);
constexpr size_t WS_HDNC   = WS_HDN    + al256((size_t)SEQ * 256 * 2);
constexpr size_t WS_PCTX   = WS_HDNC   + al256((size_t)CL * 256 * 2);
constexpr size_t WS_LORAIN = WS_PCTX   + al256((size_t)TC * NR * 2);
constexpr size_t WS_SLOT0  = WS_LORAIN + al256((size_t)MR * LORA_W * 2);
constexpr size_t WS_END    = WS_SLOT0  + 7 * SLOT_BYTES;
constexpr size_t CH_ARR = (size_t)NB * D * CL * 4;
constexpr size_t WS_CV   = WS_LORAIN;
constexpr size_t WS_YHC  = WS_CV + 3 * CH_ARR;
constexpr size_t WS_HCF  = WS_YHC + CH_ARR;
static_assert(WS_HCF + (size_t)8192 * 256 * 4 <= WS_SLOT0, "ctx hyena arrays must fit the lora_in region");

struct Params {
    const float* in[33];
    float* out;
    unsigned char* ws;
};

enum { I_X = 0, I_C, I_CTX, I_CCTX, I_ADAW, I_ADAB, I_N1G, I_N2G, I_WIN, I_CONVW, I_W0, I_W2, I_A0, I_A2, I_G2, I_KK, I_KA, I_RK, I_LNW, I_LNB,
       I_HW1, I_HB1, I_HW2, I_HB2, I_HW3, I_HFREQ, I_HSKIP, I_WOUT, I_WQ, I_KEYS, I_PU, I_PV, I_FING };

__device__ __forceinline__ float bf2f(bf16_t v) { return __uint_as_float((unsigned)v << 16); }
__device__ __forceinline__ bf16_t f2bf(float f) { unsigned u = __float_as_uint(f); u += 0x7FFFu + ((u >> 16) & 1u); return (bf16_t)(u >> 16); }
__device__ __forceinline__ unsigned pack2(float lo, float hi) { return (unsigned)f2bf(lo) | ((unsigned)f2bf(hi) << 16); }
__device__ __forceinline__ float bflo(unsigned w) { return __uint_as_float(w << 16); }
__device__ __forceinline__ float bfhi(unsigned w) { return __uint_as_float(w & 0xFFFF0000u); }
__device__ __forceinline__ float sigmoidf_(float x) { return 1.0f / (1.0f + __expf(-x)); }
__device__ __forceinline__ float tanhf_(float x) { return 1.0f - 2.0f / (1.0f + __expf(2.0f * x)); }
template <int CTRL> __device__ __forceinline__ float dppf(float x) { return __builtin_bit_cast(float, __builtin_amdgcn_mov_dpp(__builtin_bit_cast(int, x), CTRL, 0xf, 0xf, true)); }
__device__ __forceinline__ float red16(float x) { x += dppf<0xB1>(x); x += dppf<0x4E>(x); x += dppf<0x141>(x); x += dppf<0x128>(x); return x; }
__device__ __forceinline__ float wave_sum(float x) { x = red16(x); x += __shfl_xor(x, 16); x += __shfl_xor(x, 32); return x; }

__device__ __forceinline__ const float* xrow_c(const Params& p, int r) { return r < TL ? p.out + (size_t)r * D : (const float*)(p.ws + WS_CTXRES) + (size_t)(r - TL) * D; }
__device__ __forceinline__ float* xrow(const Params& p, int r) { return r < TL ? p.out + (size_t)r * D : (float*)(p.ws + WS_CTXRES) + (size_t)(r - TL) * D; }
__device__ __forceinline__ int mrow_of(int r) { return r < TL ? (r >> 14) : 2; }
__device__ __forceinline__ const float* modp(const Params& p, int l, int mrow, int chunk) { return (const float*)(p.ws + WS_MOD) + ((size_t)(l * 3 + mrow) * 6 + chunk) * D; }
__device__ __forceinline__ bf16_t* slot(const Params& p, int s) { return (bf16_t*)(p.ws + WS_SLOT0 + (size_t)s * SLOT_BYTES); }

__device__ __forceinline__ int src_col(int n) {
    if (n < 4096) return n;
    if (n < 6144) return 4480 + (n - 4096);
    if (n < NR) { const int cc = n - 6144, blk = cc >> 7, o = cc & 127;
        if (o < 96) return (blk == 0 ? 4096 : blk == 1 ? 4288 : blk == 2 ? 4192 : 4384) + o;
        return blk == 0 ? 6528 + (o - 96) : blk == 1 ? 6528 + 32 + (o - 96) : -1; }
    if (n < NR + NHY) return 6592 + (n - NR);
    { const int g = n - NR - NHY, tile = g >> 8, o = g & 255;
      return o < 128 ? CONV_COLS + tile * 128 + o : CONV_COLS + D + tile * 128 + (o - 128); }
}

__device__ __forceinline__ float siluf_(float x) { return x * sigmoidf_(x); }
__device__ void ph_init(const Params& p) {
    const size_t gt = (size_t)blockIdx.x * NTHREADS + threadIdx.x, GT = (size_t)gridDim.x * NTHREADS;
    { const f32x4* s = (const f32x4*)p.in[I_X]; f32x4* d = (f32x4*)p.out; for (size_t i = gt; i < (size_t)TL * D / 4; i += GT) d[i] = s[i]; }
    { const f32x4* s = (const f32x4*)p.in[I_CTX]; f32x4* d = (f32x4*)(p.ws + WS_CTXRES); for (size_t i = gt; i < (size_t)TC * D / 4; i += GT) d[i] = s[i]; }
    { f32x2* tw = (f32x2*)(p.ws + WS_TW); for (size_t j = gt; j < 32768; j += GT) { float s, c; sincospif((float)j * (1.0f / 16384.0f), &s, &c); tw[j] = (f32x2){c, -s}; } }
    const float* cv = p.in[I_C]; const float* cc = p.in[I_CCTX];
    float* mp = (float*)(p.ws + WS_MODP);
    for (int u = blockIdx.x; u < 2 * 12 * NPART; u += gridDim.x) {
        const int kc = u % NPART, cch = (u / NPART) % 12, l = u / (NPART * 12);
        const int col = cch * 1024 + threadIdx.x * 2;
        float a0 = 0.f, a1 = 0.f, b0 = 0.f, b1 = 0.f, c0 = 0.f, c1 = 0.f;
        const float* w = p.in[I_ADAW] + ((size_t)l * D + (size_t)kc * 64) * (6 * D) + col;
#pragma unroll 8
        for (int k = 0; k < 64; ++k) {
            const int kk = kc * 64 + k;
            const float s0 = siluf_(cv[kk]), s1 = siluf_(cv[D + kk]), s2 = siluf_(cc[kk]);
            const f32x2 wv = *(const f32x2*)(w + (size_t)k * (6 * D));
            a0 += s0 * wv.x; a1 += s0 * wv.y; b0 += s1 * wv.x; b1 += s1 * wv.y; c0 += s2 * wv.x; c1 += s2 * wv.y;
        }
        float* o = mp + ((size_t)(kc * 2 + l) * 3) * (6 * D) + col;
        *(f32x2*)(o) = (f32x2){a0, a1}; *(f32x2*)(o + 6 * D) = (f32x2){b0, b1}; *(f32x2*)(o + 12 * D) = (f32x2){c0, c1};
    }
}
__device__ void ph_modred(const Params& p) {
    const int gt = blockIdx.x * NTHREADS + threadIdx.x, GT = gridDim.x * NTHREADS;
    const float* mp = (const float*)(p.ws + WS_MODP); float* md = (float*)(p.ws + WS_MOD);
    for (int i = gt; i < 2 * 3 * 6 * D; i += GT) {
        const int col = i % (6 * D), r = (i / (6 * D)) % 3, l = i / (18 * D);
        float s = p.in[I_ADAB][l * 6 * D + col];
        for (int kc = 0; kc < NPART; ++kc) s += mp[((size_t)(kc * 2 + l) * 3 + r) * (6 * D) + col];
        md[i] = s;
    }
}

__device__ void norm_rows(const Params& p, const float* g, int l, int ch_shift, int ch_scale, int M) {
    const int lane = threadIdx.x & 63, wv = blockIdx.x * 8 + (threadIdx.x >> 6), NW = gridDim.x * 8;
    bf16_t* h = (bf16_t*)(p.ws + WS_H);
    for (int r = wv; r < M; r += NW) {
        const float* xr = xrow_c(p, r); const int mr = mrow_of(r);
        const float* sh = modp(p, l, mr, ch_shift); const float* sc = modp(p, l, mr, ch_scale);
        f32x4 v[8]; float ss = 0.f;
#pragma unroll
        for (int c = 0; c < 8; ++c) { v[c] = *(const f32x4*)(xr + c * 256 + lane * 4); ss += v[c][0] * v[c][0] + v[c][1] * v[c][1] + v[c][2] * v[c][2] + v[c][3] * v[c][3]; }
        ss = wave_sum(ss);
        const float rs = rsqrtf(ss * (1.0f / D) + NORM_EPS);
#pragma unroll
        for (int c = 0; c < 8; ++c) { const int col = c * 256 + lane * 4;
            const f32x4 gg = *(const f32x4*)(g + col), s1 = *(const f32x4*)(sc + col), s0 = *(const f32x4*)(sh + col);
            const f32x4 y = (v[c] * rs) * gg * (s1 + 1.0f) + s0;
            u32x2 w; w.x = pack2(y[0], y[1]); w.y = pack2(y[2], y[3]);
            *(u32x2*)(h + (size_t)r * D + col) = w; }
    }
}

template <class F> __device__ __forceinline__ void cvt_T(bf16_t* dst, int N, int Kd, F f) {
    const int lane = threadIdx.x & 63, wv = blockIdx.x * 8 + (threadIdx.x >> 6), NW = gridDim.x * 8;
    const int nblk = N / 64, units = nblk * (Kd / 32);
    for (int u = wv; u < units; u += NW) {
        const int n = (u % nblk) * 64 + lane, k0 = (u / nblk) * 32;
        unsigned w[16];
#pragma unroll
        for (int i = 0; i < 16; ++i) w[i] = pack2(f(k0 + 2 * i, n), f(k0 + 2 * i + 1, n));
        u32x4* d = (u32x4*)(dst + (size_t)n * Kd + k0);
#pragma unroll
        for (int i = 0; i < 4; ++i) d[i] = (u32x4){w[4 * i], w[4 * i + 1], w[4 * i + 2], w[4 * i + 3]};
    }
}

__device__ void filter_mlp(const Params& p, int l, int Lf, bf16_t* dst) {
    const int lane = threadIdx.x & 63, wv = blockIdx.x * 8 + (threadIdx.x >> 6), NW = gridDim.x * 8;
    const float* w1 = p.in[I_HW1] + (size_t)l * 33 * 64; const float* b1 = p.in[I_HB1] + l * 64;
    const float* w2 = p.in[I_HW2] + (size_t)l * 64 * 64; const float* b2 = p.in[I_HB2] + l * 64;
    const float fr = p.in[I_HFREQ][l * 64 + lane];
    for (int n = wv; n < Lf; n += NW) {
        float zf = 0.f;
        if (lane == 0) zf = (float)n / (float)(Lf - 1);
        else if (lane <= 32) { const int bi = (lane - 1) & 15; const float band = 1e-4f + (float)bi * ((15.0f - 1e-4f) / 15.0f);
            float s, c; sincospif(2.0f * (float)n * band / (float)Lf, &s, &c); zf = lane <= 16 ? c : -s; }
        float a = b1[lane];
        for (int i = 0; i < 33; ++i) a += __shfl(zf, i) * w1[i * 64 + lane];
        const float h1 = sinf(fr * a);
        float b = b2[lane];
        for (int i = 0; i < 64; ++i) b += __shfl(h1, i) * w2[i * 64 + lane];
        const float h2 = sinf(fr * b);
        bf16_t* d = dst + (size_t)n * 256;
        d[lane] = f2bf(h2); d[64 + lane] = 0; d[128 + lane] = 0; d[192 + lane] = 0;
    }
}

__device__ void ph_prep(const Params& p, int l) {
    { const float* w = p.in[I_WIN] + (size_t)l * D * IN_COLS;
      cvt_T((bf16_t*)(p.ws + WS_WTIN), NTOT, D, [=](int k, int n) { const int s = src_col(n); return s >= 0 ? w[(size_t)k * IN_COLS + s] : 0.f; });
      float* cw = (float*)(p.ws + WS_CONVW); const float* cs = p.in[I_CONVW] + (size_t)l * 3 * CONV_COLS;
      for (int i = blockIdx.x * NTHREADS + threadIdx.x; i < 3 * NTOT; i += gridDim.x * NTHREADS) { const int j = i / NTOT, n = i % NTOT; const int s = src_col(n);
          cw[i] = (n < NR + NHY && s >= 0) ? cs[j * CONV_COLS + s] : 0.f; } }
    { const float* w2 = p.in[I_W2] + (size_t)l * 2 * 96 * D; const float* a2 = p.in[I_A2] + (size_t)l * 2 * 96 * D;
      cvt_T((bf16_t*)(p.ws + WS_WTLORA), 4 * D, LORA_W, [=](int k, int n) { const int t = n >> 11, j = n & (D - 1), kb = k >> 7, o = k & 127;
          if (kb != t || o >= 96) return 0.f; const float* s = (t & 1) ? a2 : w2; return s[((size_t)(t >> 1) * 96 + o) * D + j]; }); }
    { float* lb = (float*)(p.ws + WS_LBIAS); for (int i = blockIdx.x * NTHREADS + threadIdx.x; i < 4 * D; i += gridDim.x * NTHREADS) { const int t = i >> 11, j = i & (D - 1);
          lb[i] = ((t & 1) ? p.in[I_A0] : p.in[I_W0])[(size_t)l * 2 * D + (t >> 1) * D + j]; } }
    { const float* w = p.in[I_WOUT] + (size_t)l * D * D; cvt_T((bf16_t*)(p.ws + WS_WTOUT), D, D, [=](int k, int n) { return w[(size_t)k * D + n]; }); }
    { const float* w = p.in[I_HW3] + (size_t)l * 64 * 8192; cvt_T((bf16_t*)(p.ws + WS_W3T), 8192, 256, [=](int k, int n) { return k < 64 ? w[(size_t)k * 8192 + n] : 0.f; }); }
    { const float* wq = p.in[I_WQ] + (size_t)l * D * D; const float* keys = p.in[I_KEYS] + (size_t)l * 16 * 128 * 128; unsigned* dst = (unsigned*)(p.ws + WS_WTSC);
      for (size_t i = (size_t)blockIdx.x * NTHREADS + threadIdx.x; i < (size_t)D * D / 2; i += (size_t)gridDim.x * NTHREADS) {
          const int row = (int)(i / (D / 2)), kk = (int)(i % (D / 2)) * 2, hp = row >> 7;
          const f32x4* kr = (const f32x4*)(keys + (size_t)row * 128); const f32x4* q0 = (const f32x4*)(wq + (size_t)kk * D + hp * 128); const f32x4* q1 = (const f32x4*)(wq + (size_t)(kk + 1) * D + hp * 128);
          float s0 = 0.f, s1 = 0.f;
#pragma unroll 4
          for (int d4 = 0; d4 < 32; ++d4) { const f32x4 a = kr[d4], b = q0[d4], c = q1[d4];
              s0 += a[0] * b[0] + a[1] * b[1] + a[2] * b[2] + a[3] * b[3]; s1 += a[0] * c[0] + a[1] * c[1] + a[2] * c[2] + a[3] * c[3]; }
          dst[i] = pack2(s0, s1); } }
    filter_mlp(p, l, SEQ, (bf16_t*)(p.ws + WS_HDN));
    if (l == 0) filter_mlp(p, l, CL, (bf16_t*)(p.ws + WS_HDNC));
    norm_rows(p, p.in[I_N1G] + l * D, l, 0, 1, MR);
}

using pg8::Unit; using pg8::cvt_pk_bf16;
typedef f32x4 Acc[2][2][4][2];

__device__ __forceinline__ void st4bf(bf16_t* p, const f32x4 v) { u32x2 w; w.x = cvt_pk_bf16(v[0], v[1]); w.y = cvt_pk_bf16(v[2], v[3]); *(u32x2*)p = w; }

template <int GROUP> struct EpiConv {
    static constexpr bool PERM = false, AFTER_DRAIN = false;
    const float* cw;
    bf16_t* pctx;
    bf16_t* d0; bf16_t* lora;
    __device__ __forceinline__ void operator()(const Acc& acc, const Unit& u, int wr, int wc, int fr, int fq) const {
        if (u.pm >= TL / 256) {
#pragma unroll
            for (int ai = 0; ai < 2; ++ai)
#pragma unroll
                for (int m = 0; m < 4; ++m) { const int row = (u.pm - TL / 256) * 256 + ai * 128 + wr * 64 + m * 16 + fr;
#pragma unroll
                    for (int bj = 0; bj < 2; ++bj)
#pragma unroll
                        for (int n = 0; n < 2; ++n) st4bf(pctx + (size_t)row * NR + u.pn * 256 + bj * 128 + wc * 32 + n * 16 + 4 * fq, acc[ai][bj][m][n]); }
            return;
        }
#pragma unroll
        for (int bj = 0; bj < 2; ++bj)
#pragma unroll
            for (int n = 0; n < 2; ++n) {
                const int colg = u.pn * 256 + bj * 128 + wc * 32 + n * 16 + 4 * fq;
                const f32x4 w0 = *(const f32x4*)(cw + colg), w1 = *(const f32x4*)(cw + NTOT + colg), w2 = *(const f32x4*)(cw + 2 * NTOT + colg);
#pragma unroll
                for (int ai = 0; ai < 2; ++ai) {
                    f32x4 rp[4], rn[4];
#pragma unroll
                    for (int m = 0; m < 4; ++m)
#pragma unroll
                        for (int e = 0; e < 4; ++e) { rp[m][e] = dppf<0x121>(acc[ai][bj][m][n][e]); rn[m][e] = dppf<0x12F>(acc[ai][bj][m][n][e]); }
#pragma unroll
                    for (int m = 0; m < 4; ++m) {
                        const f32x4 z = (f32x4){0.f, 0.f, 0.f, 0.f};
                        const f32x4 pv = (fr == 0) ? (m > 0 ? rp[m > 0 ? m - 1 : 0] : z) : rp[m];
                        const f32x4 nx = (fr == 15) ? (m < 3 ? rn[m < 3 ? m + 1 : 3] : z) : rn[m];
                        const f32x4 o = w0 * pv + w1 * acc[ai][bj][m][n] + w2 * nx;
                        const int row = u.pm * 256 + ai * 128 + wr * 64 + m * 16 + fr;
                        if (GROUP == 0) {
                            if (colg < 3 * D) { bf16_t* d = d0 + (size_t)(colg >> 11) * (SLOT_BYTES / 2); st4bf(d + (size_t)row * D + (colg & (D - 1)), o); }
                            else { const int cc = colg - 3 * D, blk = cc >> 7, oo = cc & 127; f32x4 a;
                                if (oo < 96) { if (blk & 1) a = o; else { a[0] = tanhf_(o[0]); a[1] = tanhf_(o[1]); a[2] = tanhf_(o[2]); a[3] = tanhf_(o[3]); } }
                                else if (blk < 2) { a[0] = sigmoidf_(o[0]); a[1] = sigmoidf_(o[1]); a[2] = sigmoidf_(o[2]); a[3] = sigmoidf_(o[3]); }
                                else a = z;
                                st4bf(lora + (size_t)row * LORA_W + cc, a); }
                        } else {
                            bf16_t* d = d0 + (size_t)(colg >> 11) * (SLOT_BYTES / 2); const int c = colg & (D - 1), b = row >> 14, t = row & (SEQ - 1);
                            bf16_t* q = d + ((size_t)(b * D + c)) * SEQ + t;
                            q[0] = f2bf(o[0]); q[SEQ] = f2bf(o[1]); q[2 * SEQ] = f2bf(o[2]); q[3 * SEQ] = f2bf(o[3]);
                        }
                    }
                }
            }
    }
};

struct EpiLora {
    static constexpr bool PERM = false, AFTER_DRAIN = false;
    const float* bias4;
    bf16_t* dst0;
    __device__ __forceinline__ void operator()(const Acc& acc, const Unit& u, int wr, int wc, int fr, int fq) const {
        const int t = u.pn >> 3; const bool isa = t & 1; const float mul = isa ? 1.0f : -0.60653065971f; const float* bias = bias4 + t * D; bf16_t* d = dst0 + (size_t)t * (SLOT_BYTES / 2);
#pragma unroll
        for (int bj = 0; bj < 2; ++bj)
#pragma unroll
            for (int n = 0; n < 2; ++n) { const int col = (u.pn & 7) * 256 + bj * 128 + wc * 32 + n * 16 + 4 * fq; const f32x4 bv = *(const f32x4*)(bias + col);
#pragma unroll
                for (int ai = 0; ai < 2; ++ai)
#pragma unroll
                    for (int m = 0; m < 4; ++m) { const int row = u.pm * 256 + ai * 128 + wr * 64 + m * 16 + fr; const f32x4 x = acc[ai][bj][m][n] + bv; f32x4 o;
#pragma unroll
                        for (int e = 0; e < 4; ++e) o[e] = sigmoidf_(x[e]) * mul;
                        st4bf(d + (size_t)row * D + col, o); } }
    }
};

struct EpiBf {
    static constexpr bool PERM = false, AFTER_DRAIN = false;
    bf16_t* O; int ldc;
    __device__ __forceinline__ void operator()(const Acc& acc, const Unit& u, int wr, int wc, int fr, int fq) const {
#pragma unroll
        for (int ai = 0; ai < 2; ++ai)
#pragma unroll
            for (int m = 0; m < 4; ++m) { const int row = u.pm * 256 + ai * 128 + wr * 64 + m * 16 + fr;
#pragma unroll
                for (int bj = 0; bj < 2; ++bj)
#pragma unroll
                    for (int n = 0; n < 2; ++n) st4bf(O + (size_t)row * ldc + u.pn * 256 + bj * 128 + wc * 32 + n * 16 + 4 * fq, acc[ai][bj][m][n]); }
    }
};
struct EpiF32 {
    static constexpr bool PERM = false, AFTER_DRAIN = false;
    float* O; int ldc;
    __device__ __forceinline__ void operator()(const Acc& acc, const Unit& u, int wr, int wc, int fr, int fq) const {
#pragma unroll
        for (int ai = 0; ai < 2; ++ai)
#pragma unroll
            for (int m = 0; m < 4; ++m) { const int row = u.pm * 256 + ai * 128 + wr * 64 + m * 16 + fr;
#pragma unroll
                for (int bj = 0; bj < 2; ++bj)
#pragma unroll
                    for (int n = 0; n < 2; ++n) *(f32x4*)(O + (size_t)row * ldc + u.pn * 256 + bj * 128 + wc * 32 + n * 16 + 4 * fq) = acc[ai][bj][m][n]; }
    }
};
struct EpiGate {
    static constexpr bool PERM = false, AFTER_DRAIN = false;
    const bf16_t* yrw;
    const bf16_t* yhy;
    const float* yhc;
    bf16_t* y;
    __device__ __forceinline__ void operator()(const Acc& acc, const Unit& u, int wr, int wc, int fr, int fq) const {
#pragma unroll
        for (int ai = 0; ai < 2; ++ai)
#pragma unroll
            for (int m = 0; m < 4; ++m) { const int row = u.pm * 256 + ai * 128 + wr * 64 + m * 16 + fr;
#pragma unroll
                for (int n = 0; n < 2; ++n) { const int ch = u.pn * 128 + wc * 32 + n * 16 + 4 * fq;
                    const u32x2 rw = *(const u32x2*)(yrw + (size_t)row * D + ch);
                    const float r4[4] = {bflo(rw.x), bfhi(rw.x), bflo(rw.y), bfhi(rw.y)};
                    f32x4 o;
#pragma unroll
                    for (int e = 0; e < 4; ++e) { float hy;
                        if (row < TL) hy = bf2f(yhy[((size_t)((row >> 14) * D + ch + e)) * SEQ + (row & (SEQ - 1))]);
                        else { const int rc = row - TL; hy = yhc[((size_t)((rc >> 8) * D + ch + e)) * CL + (rc & (CL - 1))]; }
                        o[e] = sigmoidf_(acc[ai][0][m][n][e]) * r4[e] + sigmoidf_(acc[ai][1][m][n][e]) * hy; }
                    st4bf(y + (size_t)row * D + ch, o); } }
    }
};
struct EpiResid {
    static constexpr bool PERM = false, AFTER_DRAIN = false;
    float* xl; float* xc; const float* ga;
    __device__ __forceinline__ void operator()(const Acc& acc, const Unit& u, int wr, int wc, int fr, int fq) const {
#pragma unroll
        for (int ai = 0; ai < 2; ++ai)
#pragma unroll
            for (int m = 0; m < 4; ++m) { const int row = u.pm * 256 + ai * 128 + wr * 64 + m * 16 + fr; const int mr = mrow_of(row);
                float* xr = row < TL ? xl + (size_t)row * D : xc + (size_t)(row - TL) * D; const float* g = ga + (size_t)mr * 6 * D;
#pragma unroll
                for (int bj = 0; bj < 2; ++bj)
#pragma unroll
                    for (int n = 0; n < 2; ++n) { const int col = u.pn * 256 + bj * 128 + wc * 32 + n * 16 + 4 * fq;
                        const f32x4 gv = *(const f32x4*)(g + col); f32x4* q = (f32x4*)(xr + col); *q = *q + gv * acc[ai][bj][m][n]; } }
    }
};

template <class Epi> __device__ __forceinline__ void run_gemm(unsigned char* lds, const bf16_t* A, int lda, const bf16_t* Bt, int ldb, int M, int N, int K, const Epi& E) {
    pg8::Gemm g{A, Bt, M, N, K, lda, ldb}; pg8::StaticOrder S; S.init(M, N, (int)gridDim.x, (int)blockIdx.x);
    pg8::gemm_phase<Epi, pg8::StaticOrder>((PG8_LAS unsigned char*)lds, g, S, E);
}

template <int GROUP> __device__ void ph_ctxconv(const Params& p) {
    constexpr int NC = GROUP == 0 ? NR : NHY;
    const float* cw = (const float*)(p.ws + WS_CONVW) + (GROUP == 0 ? 0 : NR);
    const bf16_t* pc = (const bf16_t*)(p.ws + WS_PCTX);
    const int items = TC * (NC / 4);
    for (int i = blockIdx.x * NTHREADS + threadIdx.x; i < items; i += gridDim.x * NTHREADS) {
        const int rc = i / (NC / 4), colg = (i % (NC / 4)) * 4, t = rc & (CL - 1);
        const f32x4 w0 = *(const f32x4*)(cw + colg), w1 = *(const f32x4*)(cw + NTOT + colg), w2 = *(const f32x4*)(cw + 2 * NTOT + colg);
        const u32x2 c = *(const u32x2*)(pc + (size_t)rc * NR + colg);
        u32x2 a = (u32x2){0u, 0u}, b = (u32x2){0u, 0u};
        if (t > 0) a = *(const u32x2*)(pc + (size_t)(rc - 1) * NR + colg);
        if (t < CL - 1) b = *(const u32x2*)(pc + (size_t)(rc + 1) * NR + colg);
        const f32x4 pv = (f32x4){bflo(a.x), bfhi(a.x), bflo(a.y), bfhi(a.y)}, cu = (f32x4){bflo(c.x), bfhi(c.x), bflo(c.y), bfhi(c.y)}, nx = (f32x4){bflo(b.x), bfhi(b.x), bflo(b.y), bfhi(b.y)};
        const f32x4 o = w0 * pv + w1 * cu + w2 * nx;
        const int row = TL + rc;
        if (GROUP == 0) {
            if (colg < 3 * D) { bf16_t* d = slot(p, colg < D ? 0 : colg < 2 * D ? 1 : 2); st4bf(d + (size_t)row * D + (colg & (D - 1)), o); }
            else { const int cc = colg - 3 * D, blk = cc >> 7, oo = cc & 127; f32x4 v;
                if (oo < 96) { if (blk & 1) v = o; else { v[0] = tanhf_(o[0]); v[1] = tanhf_(o[1]); v[2] = tanhf_(o[2]); v[3] = tanhf_(o[3]); } }
                else if (blk < 2) { v[0] = sigmoidf_(o[0]); v[1] = sigmoidf_(o[1]); v[2] = sigmoidf_(o[2]); v[3] = sigmoidf_(o[3]); }
                else v = (f32x4){0.f, 0.f, 0.f, 0.f};
                st4bf((bf16_t*)(p.ws + WS_LORAIN) + (size_t)row * LORA_W + cc, v); }
        } else {
            float* d = (float*)(p.ws + WS_CV) + (size_t)(colg >> 11) * (NB * D * CL); const int c0 = colg & (D - 1), b_ = rc >> 8;
#pragma unroll
            for (int e = 0; e < 4; ++e) d[((size_t)(b_ * D + c0 + e)) * CL + t] = o[e];
        }
    }
}

constexpr int SC_CH = 32;
constexpr int SC_NCH = (CL + SEQ) / SC_CH;
constexpr int SC_BUF_F = 6 * SC_CH * 64;
__device__ __forceinline__ int scan_row(int b, int dir, int s) {
    if (s < CL) return TL + b * CL + (dir ? CL - 1 - s : s);
    const int t = s - CL; return b * SEQ + (dir ? SEQ - 1 - t : t);
}
__device__ void ph_scan(const Params& p, int l, unsigned char* lds_raw) {
    float* lds = (float*)lds_raw;
    float* ybuf = lds + 2 * SC_BUF_F;
    const int tid = threadIdx.x, tl = tid >> 4, jq = tid & 15, ip = tid >> 4;
    for (int unit = blockIdx.x; unit < NB * NHEAD * 2; unit += gridDim.x) {
        const int dir = unit & 1, h = (unit >> 1) & (NHEAD - 1), b = unit >> 6;
        const bf16_t* kb = slot(p, 0); const bf16_t* vb = slot(p, 1); const bf16_t* rb = slot(p, 2);
        bf16_t* lw = slot(p, 3 + 2 * dir); const bf16_t* ab = slot(p, 4 + 2 * dir);
        const int col0 = h * HN + 4 * jq;
        const f32x4 kkw = *(const f32x4*)(p.in[I_KK] + l * D + col0), kaw = *(const f32x4*)(p.in[I_KA] + l * D + col0);
        float S0[4] = {0.f, 0.f, 0.f, 0.f}, S1[4] = {0.f, 0.f, 0.f, 0.f};
        u32x2 gk, gv, gr, gw, ga;
        auto gload = [&](int c) { const size_t off = (size_t)scan_row(b, dir, c * SC_CH + tl) * D + col0;
            gk = *(const u32x2*)(kb + off); gv = *(const u32x2*)(vb + off); gr = *(const u32x2*)(rb + off); gw = *(const u32x2*)(lw + off); ga = *(const u32x2*)(ab + off); };
        auto gstage = [&](int buf) { float* B = lds + buf * SC_BUF_F + tl * 64 + 4 * jq;
            const f32x4 k4 = (f32x4){bflo(gk.x), bfhi(gk.x), bflo(gk.y), bfhi(gk.y)}, a4 = (f32x4){bflo(ga.x), bfhi(ga.x), bflo(ga.y), bfhi(ga.y)};
            const f32x4 w4 = (f32x4){__expf(bflo(gw.x)), __expf(bfhi(gw.x)), __expf(bflo(gw.y)), __expf(bfhi(gw.y))};
            const f32x4 kx = k4 * kkw; float ss = kx[0] * kx[0] + kx[1] * kx[1] + kx[2] * kx[2] + kx[3] * kx[3]; ss = red16(ss);
            const f32x4 kk = kx * rsqrtf(fmaxf(ss, 1e-24f));
            *(f32x4*)(B) = kk; *(f32x4*)(B + SC_CH * 64) = w4; *(f32x4*)(B + 2 * SC_CH * 64) = kk * a4; *(f32x4*)(B + 3 * SC_CH * 64) = k4 * ((a4 - 1.0f) * kaw + 1.0f);
            *(f32x4*)(B + 4 * SC_CH * 64) = (f32x4){bflo(gr.x), bfhi(gr.x), bflo(gr.y), bfhi(gr.y)}; *(f32x4*)(B + 5 * SC_CH * 64) = (f32x4){bflo(gv.x), bfhi(gv.x), bflo(gv.y), bfhi(gv.y)}; };
        __syncthreads();
        gload(0); gstage(0);
        __syncthreads();
        for (int c = 0; c < SC_NCH; ++c) {
            const int buf = c & 1;
            if (c + 1 < SC_NCH) gload(c + 1);
            if (c > 0) {
                const float* Y = ybuf + (buf ^ 1) * (SC_CH * 64) + tl * 64 + 4 * jq; const f32x4 yv = *(const f32x4*)Y;
                st4bf(lw + (size_t)scan_row(b, dir, (c - 1) * SC_CH + tl) * D + col0, yv); }
            const float* B = lds + buf * SC_BUF_F + 4 * jq; float* Yw = ybuf + buf * (SC_CH * 64);
#pragma unroll 4
            for (int s = 0; s < SC_CH; ++s) {
                const f32x4 kk = *(const f32x4*)(B + s * 64), w = *(const f32x4*)(B + SC_CH * 64 + s * 64), ka = *(const f32x4*)(B + 2 * SC_CH * 64 + s * 64),
                            kt = *(const f32x4*)(B + 3 * SC_CH * 64 + s * 64), rr = *(const f32x4*)(B + 4 * SC_CH * 64 + s * 64);
                const f32x2 vv = *(const f32x2*)(lds + buf * SC_BUF_F + 5 * SC_CH * 64 + s * 64 + 2 * ip);
                float d0 = S0[0] * kk[0] + S0[1] * kk[1] + S0[2] * kk[2] + S0[3] * kk[3];
                float d1 = S1[0] * kk[0] + S1[1] * kk[1] + S1[2] * kk[2] + S1[3] * kk[3];
                d0 = red16(d0); d1 = red16(d1);
#pragma unroll
                for (int e = 0; e < 4; ++e) { S0[e] = S0[e] * w[e] + vv.x * kt[e] - d0 * ka[e]; S1[e] = S1[e] * w[e] + vv.y * kt[e] - d1 * ka[e]; }
                float y0 = S0[0] * rr[0] + S0[1] * rr[1] + S0[2] * rr[2] + S0[3] * rr[3];
                float y1 = S1[0] * rr[0] + S1[1] * rr[1] + S1[2] * rr[2] + S1[3] * rr[3];
                y0 = red16(y0); y1 = red16(y1);
                if (jq == 0) *(f32x2*)(Yw + s * 64 + 2 * ip) = (f32x2){y0, y1};
            }
            if (c + 1 < SC_NCH) gstage(buf ^ 1);
            __syncthreads();
        }
        { const float* Y = ybuf + ((SC_NCH - 1) & 1) * (SC_CH * 64) + tl * 64 + 4 * jq; const f32x4 yv = *(const f32x4*)Y;
          st4bf(lw + (size_t)scan_row(b, dir, (SC_NCH - 1) * SC_CH + tl) * D + col0, yv); }
    }
}

__device__ void ph_rwkv_out(const Params& p, int l, int M) {
    const int tid = threadIdx.x, col = 4 * tid, h = tid >> 4;
    const f32x4 lnw = *(const f32x4*)(p.in[I_LNW] + l * D + col), lnb = *(const f32x4*)(p.in[I_LNB] + l * D + col), rk = *(const f32x4*)(p.in[I_RK] + l * D + col);
    const float* g2 = p.in[I_G2] + (size_t)l * 64 * D;
    const bf16_t* kb = slot(p, 0); const bf16_t* vb = slot(p, 1); const bf16_t* rb = slot(p, 2); const bf16_t* yf = slot(p, 3); const bf16_t* yb = slot(p, 5);
    const bf16_t* lora = (const bf16_t*)(p.ws + WS_LORAIN); bf16_t* out = slot(p, 6);
    for (int row = blockIdx.x; row < M; row += gridDim.x) {
        const size_t off = (size_t)row * D + col;
        const u32x2 a = *(const u32x2*)(yf + off), b = *(const u32x2*)(yb + off), k2 = *(const u32x2*)(kb + off), v2 = *(const u32x2*)(vb + off), r2 = *(const u32x2*)(rb + off);
        const f32x4 y = (f32x4){bflo(a.x) + bflo(b.x), bfhi(a.x) + bfhi(b.x), bflo(a.y) + bflo(b.y), bfhi(a.y) + bfhi(b.y)};
        const f32x4 k4 = (f32x4){bflo(k2.x), bfhi(k2.x), bflo(k2.y), bfhi(k2.y)}, v4 = (f32x4){bflo(v2.x), bfhi(v2.x), bflo(v2.y), bfhi(v2.y)}, r4 = (f32x4){bflo(r2.x), bfhi(r2.x), bflo(r2.y), bfhi(r2.y)};
        const float mu = red16(y[0] + y[1] + y[2] + y[3]) * (1.0f / HN);
        const f32x4 dy = y - mu;
        const float var = red16(dy[0] * dy[0] + dy[1] * dy[1] + dy[2] * dy[2] + dy[3] * dy[3]) * (1.0f / HN);
        const f32x4 yn = dy * rsqrtf(var + GN_EPS) * lnw + lnb;
        const f32x4 rkk = r4 * k4 * rk;
        const float bon = red16(rkk[0] + rkk[1] + rkk[2] + rkk[3]);
        f32x4 g = (f32x4){0.f, 0.f, 0.f, 0.f};
        const bf16_t* lr = lora + (size_t)row * LORA_W;
#pragma unroll 8
        for (int i = 0; i < 64; ++i) { const float s = bf2f(lr[i < 32 ? 96 + i : 224 + (i - 32)]); g += *(const f32x4*)(g2 + (size_t)i * D + col) * s; }
        const f32x4 o = (yn + v4 * bon) * g;
        st4bf(out + off, o);
    }
}

__device__ __forceinline__ float hy_delta(int c) { return 3.0701134573f + (float)c * ((15.3505672866f - 3.0701134573f) / 2047.0f); }
__device__ void ph_ctxfilter(const Params& p, int l) {
    const bf16_t* hd = (const bf16_t*)(p.ws + WS_HDNC); const float* w3 = p.in[I_HW3] + (size_t)l * 64 * 8192; float* hcf = (float*)(p.ws + WS_HCF);
    for (int i = blockIdx.x * NTHREADS + threadIdx.x; i < 8192 * CL; i += gridDim.x * NTHREADS) {
        const int col = i % 8192, n = i / 8192; float s = 0.f;
        for (int k = 0; k < 64; ++k) s += bf2f(hd[n * 256 + k]) * w3[(size_t)k * 8192 + col];
        hcf[(size_t)col * CL + n] = s * __expf(-((float)n / (float)(CL - 1)) * hy_delta(col & (D - 1)));
    }
}
__device__ void ph_ctxhyena(const Params& p, int l, unsigned char* lds_raw) {
    const int lane = threadIdx.x & 63, wid = threadIdx.x >> 6, wv = blockIdx.x * 8 + wid, NW = gridDim.x * 8;
    float* L = (float*)lds_raw + wid * 768;
    const float* hcf = (const float*)(p.ws + WS_HCF); const float* cv = (const float*)(p.ws + WS_CV); float* yhc = (float*)(p.ws + WS_YHC);
    for (int u = wv; u < NB * D; u += NW) {
        const int c = u & (D - 1), b = u >> 11;
        float z[4];
#pragma unroll
        for (int j = 0; j < 4; ++j) z[j] = cv[((size_t)(b * D + c)) * CL + lane + 64 * j];
#pragma unroll
        for (int o = 0; o < 2; ++o) {
            float ss = 0.f;
#pragma unroll
            for (int j = 0; j < 4; ++j) { const int n = lane + 64 * j; const float f = hcf[((size_t)((o * 2 + 0) * D + c)) * CL + n], g = hcf[((size_t)((o * 2 + 1) * D + c)) * CL + n];
                L[256 + n] = f; L[512 + n] = g; L[n] = z[j]; ss += f * f + g * g; }
            ss = wave_sum(ss); const float rn = rsqrtf(ss);
            const float sk = p.in[I_HSKIP][(l * 2 + o) * D + c];
            const float* gate = cv + (size_t)(o + 1) * (NB * D * CL) + ((size_t)(b * D + c)) * CL;
            float acc[4] = {0.f, 0.f, 0.f, 0.f};
            for (int s = 0; s < CL; ++s) { const float us = L[s];
#pragma unroll
                for (int j = 0; j < 4; ++j) { const int t = lane + 64 * j; const int d = t - s; const float w = d >= 0 ? L[256 + d] + (d == 0 ? L[512] : 0.f) : L[512 - d]; acc[j] += w * us; } }
#pragma unroll
            for (int j = 0; j < 4; ++j) z[j] = gate[lane + 64 * j] * (acc[j] * rn + z[j] * sk);
        }
#pragma unroll
        for (int j = 0; j < 4; ++j) yhc[((size_t)(b * D + c)) * CL + lane + 64 * j] = z[j];
    }
}

__device__ __forceinline__ f32x2 cmul(const f32x2 a, const f32x2 b) { return (f32x2){a.x * b.x - a.y * b.y, a.x * b.y + a.y * b.x}; }
__device__ __forceinline__ f32x2 cconj(const f32x2 a) { return (f32x2){a.x, -a.y}; }
template <bool INV> __device__ __forceinline__ void dft4(f32x2& a, f32x2& b, f32x2& c, f32x2& d) {
    const f32x2 s0 = a + c, s1 = a - c, s2 = b + d, s3 = b - d;
    const f32x2 t = INV ? (f32x2){-s3.y, s3.x} : (f32x2){s3.y, -s3.x};
    a = s0 + s2; c = s0 - s2; b = s1 + t; d = s1 - t;
}
template <bool INV> __device__ __forceinline__ void dft16(f32x2 (&x)[16]) {
    constexpr float C[10] = {1.f, 0.92387953251f, 0.70710678119f, 0.38268343237f, 0.f, 0.f, -0.70710678119f, 0.f, 0.f, -0.92387953251f};
    constexpr float S[10] = {0.f, 0.38268343237f, 0.70710678119f, 0.92387953251f, 1.f, 0.f, 0.70710678119f, 0.f, 0.f, -0.38268343237f};
#pragma unroll
    for (int n1 = 0; n1 < 4; ++n1) dft4<INV>(x[n1], x[n1 + 4], x[n1 + 8], x[n1 + 12]);
#pragma unroll
    for (int n1 = 1; n1 < 4; ++n1)
#pragma unroll
        for (int k2 = 1; k2 < 4; ++k2) { const int m = n1 * k2; x[n1 + 4 * k2] = cmul(x[n1 + 4 * k2], (f32x2){C[m], INV ? S[m] : -S[m]}); }
#pragma unroll
    for (int k2 = 0; k2 < 4; ++k2) dft4<INV>(x[4 * k2], x[4 * k2 + 1], x[4 * k2 + 2], x[4 * k2 + 3]);
    f32x2 y[16];
#pragma unroll
    for (int k1 = 0; k1 < 4; ++k1)
#pragma unroll
        for (int k2 = 0; k2 < 4; ++k2) y[4 * k1 + k2] = x[4 * k2 + k1];
#pragma unroll
    for (int k = 0; k < 16; ++k) x[k] = y[k];
}
__device__ __forceinline__ int zpad(int pidx) { return pidx + 2 * (pidx >> 4); }
constexpr int ZN = 18432;

template <class Gen> __device__ __forceinline__ void fft_fwd0(f32x2* Z, const f32x2* tw, int tid, Gen gen) {
    __syncthreads();
#pragma unroll 1
    for (int i = 0; i < 8; ++i) { const int n2 = tid + 512 * i;
        f32x2 a = gen(n2), b = gen(4096 + n2), c = gen(8192 + n2), d = gen(12288 + n2);
        dft4<false>(a, b, c, d);
        const f32x2 w1 = tw[2 * n2], w2 = cmul(w1, w1), w3 = cmul(w2, w1);
        Z[zpad(n2)] = a; Z[zpad(4096 + n2)] = cmul(b, w1); Z[zpad(8192 + n2)] = cmul(c, w2); Z[zpad(12288 + n2)] = cmul(d, w3); }
    __syncthreads();
}
template <int M, int TWS> __device__ __forceinline__ void fft_fwd_mid(f32x2* Z, const f32x2* tw, int tid) {
#pragma unroll 1
    for (int j = 0; j < 2; ++j) { const int q = tid + 512 * j, blk = q / M, n2 = q % M, base = blk * (16 * M) + n2;
        f32x2 x[16];
#pragma unroll
        for (int n1 = 0; n1 < 16; ++n1) x[n1] = Z[zpad(base + n1 * M)];
        dft16<false>(x);
        const f32x2 w1 = tw[TWS * n2]; f32x2 wk = w1;
        Z[zpad(base)] = x[0];
#pragma unroll
        for (int k = 1; k < 16; ++k) { Z[zpad(base + k * M)] = cmul(x[k], wk); wk = cmul(wk, w1); } }
    __syncthreads();
}
template <int M, int TWS> __device__ __forceinline__ void fft_inv_mid(f32x2* Z, const f32x2* tw, int tid) {
#pragma unroll 1
    for (int j = 0; j < 2; ++j) { const int q = tid + 512 * j, blk = q / M, n2 = q % M, base = blk * (16 * M) + n2;
        f32x2 x[16];
        const f32x2 w1 = cconj(tw[TWS * n2]); f32x2 wk = w1;
        x[0] = Z[zpad(base)];
#pragma unroll
        for (int k = 1; k < 16; ++k) { x[k] = cmul(Z[zpad(base + k * M)], wk); wk = cmul(wk, w1); }
        dft16<true>(x);
#pragma unroll
        for (int n1 = 0; n1 < 16; ++n1) Z[zpad(base + n1 * M)] = x[n1]; }
    __syncthreads();
}
__device__ __forceinline__ void fft_fwd_rest_to_stash(f32x2* Z, const f32x2* tw, int tid, f32x2* gs) {
    fft_fwd_mid<256, 8>(Z, tw, tid); fft_fwd_mid<16, 128>(Z, tw, tid);
#pragma unroll 1
    for (int j = 0; j < 2; ++j) { const int q = tid + 512 * j; f32x2 x[16];
#pragma unroll
        for (int n1 = 0; n1 < 16; ++n1) x[n1] = Z[18 * q + n1];
        dft16<false>(x);
#pragma unroll
        for (int k = 0; k < 16; ++k) gs[(j * 16 + k) * 512 + tid] = x[k]; }
}
template <class Out> __device__ __forceinline__ void fft_conv_rest(f32x2* Z, const f32x2* tw, int tid, const f32x2* gs, Out out) {
    fft_fwd_mid<256, 8>(Z, tw, tid); fft_fwd_mid<16, 128>(Z, tw, tid);
#pragma unroll 1
    for (int j = 0; j < 2; ++j) { const int q = tid + 512 * j; f32x2 x[16];
#pragma unroll
        for (int n1 = 0; n1 < 16; ++n1) x[n1] = Z[18 * q + n1];
        dft16<false>(x);
#pragma unroll
        for (int k = 0; k < 16; ++k) x[k] = cmul(x[k], gs[(j * 16 + k) * 512 + tid]);
        dft16<true>(x);
#pragma unroll
        for (int n1 = 0; n1 < 16; ++n1) Z[18 * q + n1] = x[n1]; }
    __syncthreads();
    fft_inv_mid<16, 128>(Z, tw, tid); fft_inv_mid<256, 8>(Z, tw, tid);
#pragma unroll 1
    for (int i = 0; i < 8; ++i) { const int n2 = tid + 512 * i;
        const f32x2 w1 = cconj(tw[2 * n2]), w2 = cmul(w1, w1), w3 = cmul(w2, w1);
        f32x2 a = Z[zpad(n2)], b = cmul(Z[zpad(4096 + n2)], w1), c = cmul(Z[zpad(8192 + n2)], w2), d = cmul(Z[zpad(12288 + n2)], w3);
        dft4<true>(a, b, c, d);
        out(n2, a); out(4096 + n2, b); out(8192 + n2, c); out(12288 + n2, d); }
}

__device__ void ph_hyena(const Params& p, int l, unsigned char* lds_raw) {
    f32x2* Z = (f32x2*)lds_raw; float* red = (float*)(lds_raw + (size_t)ZN * 8);
    const f32x2* tw = (const f32x2*)(p.ws + WS_TW);
    const int tid = threadIdx.x;
    const bf16_t* Ht = (const bf16_t*)slot(p, 3);
    bf16_t* hv = slot(p, 0); const bf16_t* hx1 = slot(p, 1); const bf16_t* hx2 = slot(p, 2);
    f32x2* zs = (f32x2*)slot(p, 5) + (size_t)blockIdx.x * SEQ;
    f32x2* rs = (f32x2*)slot(p, 5) + (size_t)(gridDim.x + blockIdx.x) * SEQ;
    f32x2* gs = (f32x2*)slot(p, 5) + (size_t)(2 * gridDim.x + blockIdx.x) * SEQ;
    for (int c = blockIdx.x; c < D; c += gridDim.x) {
        const float delta = hy_delta(c);
        const size_t cb0 = ((size_t)(0 * D + c)) * SEQ, cb1 = ((size_t)(1 * D + c)) * SEQ;
#pragma unroll 1
        for (int o = 0; o < 2; ++o) {
            const bf16_t* fw = Ht + ((size_t)((o * 2 + 0) * D + c)) * SEQ; const bf16_t* bw = Ht + ((size_t)((o * 2 + 1) * D + c)) * SEQ;
            float ssq = 0.f;
            fft_fwd0(Z, tw, tid, [&](int n) { const int nb = n == 0 ? 0 : SEQ - n;
                const float f = bf2f(fw[n]) * __expf(-((float)n * (1.0f / (SEQ - 1))) * delta), g = bf2f(bw[nb]) * __expf(-((float)nb * (1.0f / (SEQ - 1))) * delta);
                ssq += f * f + g * g; return (f32x2){f + g, 0.f}; });
            fft_fwd_rest_to_stash(Z, tw, tid, gs);
            ssq = wave_sum(ssq); if ((tid & 63) == 0) red[tid >> 6] = ssq;
            fft_fwd0(Z, tw, tid, [=](int n) { return o == 0 ? (f32x2){bf2f(hv[cb0 + n]), bf2f(hv[cb1 + n])} : zs[n]; });
            float tot = 0.f;
#pragma unroll
            for (int w = 0; w < 8; ++w) tot += red[w];
            const float scale = 0.5f * (1.0f / SEQ) * rsqrtf(tot);
            fft_conv_rest(Z, tw, tid, gs, [=](int n, f32x2 val) { rs[n] = val; });
            fft_fwd0(Z, tw, tid, [=](int n) { const int nb = n == 0 ? 0 : SEQ - n;
                const float f = bf2f(fw[n]) * __expf(-((float)n * (1.0f / (SEQ - 1))) * delta), g = bf2f(bw[nb]) * __expf(-((float)nb * (1.0f / (SEQ - 1))) * delta);
                const float gd = n == 0 ? f + g : f - g; const f32x2 w = tw[n]; return (f32x2){gd * w.x, gd * w.y}; });
            fft_fwd_rest_to_stash(Z, tw, tid, gs);
            fft_fwd0(Z, tw, tid, [=](int n) { const f32x2 zz = o == 0 ? (f32x2){bf2f(hv[cb0 + n]), bf2f(hv[cb1 + n])} : zs[n]; return cmul(zz, tw[n]); });
            const float sk = p.in[I_HSKIP][(l * 2 + o) * D + c];
            const bf16_t* gate = o == 0 ? hx1 : hx2;
            fft_conv_rest(Z, tw, tid, gs, [=](int n, f32x2 val) {
                const f32x2 cv = (rs[n] + cmul(val, cconj(tw[n]))) * scale;
                const f32x2 zz = o == 0 ? (f32x2){bf2f(hv[cb0 + n]), bf2f(hv[cb1 + n])} : zs[n];
                const f32x2 res = (f32x2){bf2f(gate[cb0 + n]) * (cv.x + zz.x * sk), bf2f(gate[cb1 + n]) * (cv.y + zz.y * sk)};
                if (o == 0) zs[n] = res; else { hv[cb0 + n] = f2bf(res.x); hv[cb1 + n] = f2bf(res.y); } });
        }
    }
}

__device__ void ph_prep2(const Params& p, int l, int M) {
    { const f32x4* su = (const f32x4*)(p.in[I_PU] + (size_t)l * NEXP * D); const f32x4* sv = (const f32x4*)(p.in[I_PV] + (size_t)l * NEXP * D);
      u32x2* du = (u32x2*)slot(p, 0); u32x2* dv = (u32x2*)slot(p, 1);
      for (size_t i = (size_t)blockIdx.x * NTHREADS + threadIdx.x; i < (size_t)NEXP * D / 4; i += (size_t)gridDim.x * NTHREADS) {
          const f32x4 a = su[i], b = sv[i]; du[i] = (u32x2){pack2(a[0], a[1]), pack2(a[2], a[3])}; dv[i] = (u32x2){pack2(b[0], b[1]), pack2(b[2], b[3])}; } }
    norm_rows(p, p.in[I_N2G] + l * D, l, 3, 4, M);
}

__constant__ unsigned char c_cand[50] = {
    0x00,0x01,0x02,0x03,0x04,0x05,0x06,0x07,0x08,0x09,0x0A,0x0B,0x0C,0x0D,0x0E,0x0F, 0x10,0x11,0x12,0x13,0x14,0x15,0x16,0x17, 0x20,0x21,0x22,0x23,0x24, 0x30,0x31,0x32,0x33,
    0x40,0x41,0x42, 0x50,0x51, 0x60,0x61, 0x70,0x71, 0x80,0x90,0xA0,0xB0,0xC0,0xD0,0xE0,0xF0};
__device__ void ph_topk(const Params& p, int M, unsigned char* lds_raw) {
    const int lane = threadIdx.x & 63, wid = threadIdx.x >> 6, wv = blockIdx.x * 8 + wid, NW = gridDim.x * 8;
    float* L = (float*)lds_raw + wid * 512;
    float* topv = L + 256; int* topi = (int*)(L + 288); float* cval = L + 320; int* cflat = (int*)(L + 384);
    const float* sc = (const float*)slot(p, 3); int* idx = (int*)slot(p, 2); float* gate = (float*)slot(p, 2) + (size_t)MR * 128;
    for (int it = wv; it < M * 8; it += NW) {
        const int row = it >> 3, h = it & 7;
        const float* s = sc + (size_t)row * D + h * 256;
        float mine[4];
#pragma unroll
        for (int j = 0; j < 4; ++j) { mine[j] = s[lane + 64 * j]; L[lane + 64 * j] = mine[j]; }
#pragma unroll
        for (int pp = 0; pp < 2; ++pp) {
            int r0 = 0, r1 = 0; const float a = mine[2 * pp], b = mine[2 * pp + 1]; const int ia = lane, ib = lane + 64;
            for (int j4 = 0; j4 < 32; ++j4) { const f32x4 q = *(const f32x4*)(L + pp * 128 + 4 * j4);
#pragma unroll
                for (int e = 0; e < 4; ++e) { const int j = 4 * j4 + e; r0 += (q[e] > a || (q[e] == a && j < ia)) ? 1 : 0; r1 += (q[e] > b || (q[e] == b && j < ib)) ? 1 : 0; } }
            if (r0 < 16) { topv[pp * 16 + r0] = a; topi[pp * 16 + r0] = ia; }
            if (r1 < 16) { topv[pp * 16 + r1] = b; topi[pp * 16 + r1] = ib; }
        }
        float cv = -3.0e38f; int cf = 1 << 20, ca = 0, cb = 0;
        if (lane < 50) { const int ab = c_cand[lane]; ca = ab >> 4; cb = ab & 15; cv = topv[ca] + topv[16 + cb]; cf = ca * 16 + cb; }
        cval[lane] = cv; cflat[lane] = cf;
        int rk = 0;
        for (int j = 0; j < 50; ++j) { const float v = cval[j]; const int f = cflat[j]; rk += (v > cv || (v == cv && f < cf)) ? 1 : 0; }
        const bool win = lane < 50 && rk < 16;
        const float vmax = __shfl(cv, __ffsll((unsigned long long)__ballot(win && rk == 0)) - 1);
        const float e = win ? __expf(cv - vmax) : 0.f;
        const float den = wave_sum(e);
        if (win) { idx[(size_t)row * 128 + h * 16 + rk] = topi[ca] * 128 + (topi[16 + cb] - 0); gate[(size_t)row * 128 + h * 16 + rk] = e / den; }
    }
}

__device__ __forceinline__ float gelu_exact(float x) { return 0.5f * x * (1.0f + erff(x * 0.70710678118654752f)); }
__device__ void ph_expert(const Params& p, int l, int M) {
    const int lane = threadIdx.x & 63, wv = blockIdx.x * 8 + (threadIdx.x >> 6), NW = gridDim.x * 8;
    const bf16_t* U = slot(p, 0); const bf16_t* V = slot(p, 1); const bf16_t* hb = (const bf16_t*)(p.ws + WS_H);
    const int* idx = (const int*)slot(p, 2); const float* gate = (const float*)slot(p, 2) + (size_t)MR * 128;
    for (int row = wv; row < M; row += NW) {
        float x[32], acc[32];
#pragma unroll
        for (int c = 0; c < 4; ++c) { const u32x4 w = *(const u32x4*)(hb + (size_t)row * D + c * 512 + lane * 8);
#pragma unroll
            for (int e = 0; e < 4; ++e) { x[c * 8 + 2 * e] = bflo(w[e]); x[c * 8 + 2 * e + 1] = bfhi(w[e]); } }
#pragma unroll
        for (int i = 0; i < 32; ++i) acc[i] = 0.f;
        const int id0 = idx[(size_t)row * 128 + lane], id1 = idx[(size_t)row * 128 + 64 + lane];
        const float g0 = gate[(size_t)row * 128 + lane], g1 = gate[(size_t)row * 128 + 64 + lane];
#pragma unroll 2
        for (int e = 0; e < 128; ++e) {
            const int id = __builtin_amdgcn_readlane(e < 64 ? id0 : id1, e & 63);
            const float g = __builtin_bit_cast(float, __builtin_amdgcn_readlane(__builtin_bit_cast(int, e < 64 ? g0 : g1), e & 63));
            const bf16_t* ur = U + (size_t)id * D + lane * 8; const bf16_t* vr = V + (size_t)id * D + lane * 8;
            u32x4 uw[4], vw[4];
#pragma unroll
            for (int c = 0; c < 4; ++c) { uw[c] = *(const u32x4*)(ur + c * 512); vw[c] = *(const u32x4*)(vr + c * 512); }
            float d = 0.f;
#pragma unroll
            for (int c = 0; c < 4; ++c)
#pragma unroll
                for (int q = 0; q < 4; ++q) d += bflo(uw[c][q]) * x[c * 8 + 2 * q] + bfhi(uw[c][q]) * x[c * 8 + 2 * q + 1];
            d = wave_sum(d);
            const float a = g * gelu_exact(d);
#pragma unroll
            for (int c = 0; c < 4; ++c)
#pragma unroll
                for (int q = 0; q < 4; ++q) { acc[c * 8 + 2 * q] += a * bflo(vw[c][q]); acc[c * 8 + 2 * q + 1] += a * bfhi(vw[c][q]); }
        }
        float* xr = xrow(p, row); const float* ga = modp(p, l, mrow_of(row), 5);
#pragma unroll
        for (int c = 0; c < 4; ++c)
#pragma unroll
            for (int q = 0; q < 2; ++q) { const int col = c * 512 + lane * 8 + 4 * q; f32x4* dst = (f32x4*)(xr + col); const f32x4 gv = *(const f32x4*)(ga + col);
                *dst = *dst + gv * (f32x4){acc[c * 8 + 4 * q], acc[c * 8 + 4 * q + 1], acc[c * 8 + 4 * q + 2], acc[c * 8 + 4 * q + 3]}; }
    }
}

__device__ void ph_final(const Params& p) {
    const int lane = threadIdx.x & 63, wv = blockIdx.x * 8 + (threadIdx.x >> 6), NW = gridDim.x * 8;
    const float* g = p.in[I_FING];
    for (int r = wv; r < TL; r += NW) {
        float* xr = p.out + (size_t)r * D; f32x4 v[8]; float ss = 0.f;
#pragma unroll
        for (int c = 0; c < 8; ++c) { v[c] = *(const f32x4*)(xr + c * 256 + lane * 4); ss += v[c][0] * v[c][0] + v[c][1] * v[c][1] + v[c][2] * v[c][2] + v[c][3] * v[c][3]; }
        ss = wave_sum(ss); const float rs = rsqrtf(ss * (1.0f / D) + NORM_EPS);
#pragma unroll
        for (int c = 0; c < 8; ++c) { const int col = c * 256 + lane * 4; *(f32x4*)(xr + col) = (v[c] * rs) * *(const f32x4*)(g + col); }
    }
}

constexpr int PH_PER_LAYER = 17;
template <int PH> __global__ void __launch_bounds__(NTHREADS, 2) k_phase(Params p, int l) {
    extern __shared__ __attribute__((aligned(16))) unsigned char shm[];
    unsigned char* ws = p.ws;
    const bool last = (l == 1);
    const int ML = last ? TL : MR;
    if constexpr (PH == 100) ph_init(p);
    if constexpr (PH == 101) ph_modred(p);
    if constexpr (PH == 102) ph_final(p);
    if constexpr (PH == 0) ph_prep(p, l);
    if constexpr (PH == 1) { EpiConv<0> E{(const float*)(ws + WS_CONVW), (bf16_t*)(ws + WS_PCTX), slot(p, 0), (bf16_t*)(ws + WS_LORAIN)};
        run_gemm(shm, (const bf16_t*)(ws + WS_H), D, (const bf16_t*)(ws + WS_WTIN), D, MR, NR, D, E); }
    if constexpr (PH == 2) ph_ctxconv<0>(p);
    if constexpr (PH == 3) { EpiLora E{(const float*)(ws + WS_LBIAS), slot(p, 3)};
        run_gemm(shm, (const bf16_t*)(ws + WS_LORAIN), LORA_W, (const bf16_t*)(ws + WS_WTLORA), LORA_W, MR, 4 * D, LORA_W, E); }
    if constexpr (PH == 4) ph_scan(p, l, shm);
    if constexpr (PH == 5) ph_rwkv_out(p, l, ML);
    if constexpr (PH == 6) { EpiConv<1> E{(const float*)(ws + WS_CONVW) + NR, (bf16_t*)(ws + WS_PCTX), slot(p, 0), nullptr};
        run_gemm(shm, (const bf16_t*)(ws + WS_H), D, (const bf16_t*)(ws + WS_WTIN) + (size_t)NR * D, D, ML, NHY, D, E); }
    if constexpr (PH == 7) { ph_ctxconv<1>(p); ph_ctxfilter(p, l); }
    if constexpr (PH == 8) ph_ctxhyena(p, l, shm);
    if constexpr (PH == 9) { EpiBf E{slot(p, 3), SEQ};
        run_gemm(shm, (const bf16_t*)(ws + WS_W3T), 256, (const bf16_t*)(ws + WS_HDN), 256, 8192, SEQ, 256, E); }
    if constexpr (PH == 10) ph_hyena(p, l, shm);
    if constexpr (PH == 11) { EpiGate E{slot(p, 6), slot(p, 0), (const float*)(ws + WS_YHC), slot(p, 5)};
        run_gemm(shm, (const bf16_t*)(ws + WS_H), D, (const bf16_t*)(ws + WS_WTIN) + (size_t)(NR + NHY) * D, D, ML, NG, D, E); }
    if constexpr (PH == 12) { EpiResid E{p.out, (float*)(ws + WS_CTXRES), (const float*)(ws + WS_MOD) + (size_t)(l * 18 + 2) * D};
        run_gemm(shm, slot(p, 5), D, (const bf16_t*)(ws + WS_WTOUT), D, ML, D, D, E); }
    if constexpr (PH == 13) ph_prep2(p, l, ML);
    if constexpr (PH == 14) { EpiF32 E{(float*)slot(p, 3), D};
        run_gemm(shm, (const bf16_t*)(ws + WS_H), D, (const bf16_t*)(ws + WS_WTSC), D, ML, D, D, E); }
    if constexpr (PH == 15) ph_topk(p, ML, shm);
    if constexpr (PH == 16) ph_expert(p, l, ML);
}

#ifndef SKIP_MASK
#define SKIP_MASK 0
#endif
template <int PH> static void launch_phase(const Params& p, int l, int grid, hipStream_t stream) {
    static bool attr = false;
    if (!attr) { (void)hipFuncSetAttribute((const void*)k_phase<PH>, hipFuncAttributeMaxDynamicSharedMemorySize, LDS_BYTES); attr = true; }
    hipLaunchKernelGGL(k_phase<PH>, dim3(grid), dim3(NTHREADS), LDS_BYTES, stream, p, l);
}

extern "C" void kernel_launch(void* const* d_in, const int* in_sizes, int n_in, void* d_out, int out_size, void* d_ws, size_t ws_size, hipStream_t stream) {
    if (n_in != 33 || out_size != TL * D || ws_size < WS_END) { fprintf(stderr, "kernel_launch: unexpected shapes / workspace (%d inputs, out %d, ws %zu < %zu)\n", n_in, out_size, ws_size, (size_t)WS_END); return; }
    const int grid = 256;
    Params p{};
    for (int i = 0; i < 33; ++i) p.in[i] = (const float*)d_in[i];
    p.out = (float*)d_out; p.ws = (unsigned char*)d_ws;
    launch_phase<100>(p, 0, grid, stream);
    launch_phase<101>(p, 0, grid, stream);
    for (int l = 0; l < 2; ++l) {
        launch_phase<0>(p, l, grid, stream); launch_phase<1>(p, l, grid, stream); launch_phase<2>(p, l, grid, stream); launch_phase<3>(p, l, grid, stream);
        launch_phase<4>(p, l, grid, stream); launch_phase<5>(p, l, grid, stream); launch_phase<6>(p, l, grid, stream);
        if (l == 0) { launch_phase<7>(p, l, grid, stream); launch_phase<8>(p, l, grid, stream); }
        launch_phase<9>(p, l, grid, stream); launch_phase<10>(p, l, grid, stream); launch_phase<11>(p, l, grid, stream); launch_phase<12>(p, l, grid, stream);
        launch_phase<13>(p, l, grid, stream); launch_phase<14>(p, l, grid, stream); launch_phase<15>(p, l, grid, stream); launch_phase<16>(p, l, grid, stream);
    }
    launch_phase<102>(p, 0, grid, stream);
}
```

```cpp
#include <hip/hip_runtime.h>
#include <cstdio>
#include <cstdint>

typedef unsigned short bf16_t;
typedef float f32x4 __attribute__((ext_vector_type(4)));
typedef float f32x2 __attribute__((ext_vector_type(2)));
typedef unsigned u32x4 __attribute__((ext_vector_type(4)));
typedef unsigned u32x2 __attribute__((ext_vector_type(2)));
#define LAS __attribute__((address_space(3)))

#define XB_TMO      128
#define XB_XCNT(j)  (256  + 64 * (j))
#define XB_XSUB(j)  (1280 + 64 * (j))
#define XB_XGEN(j)  (2304 + 64 * (j))
#define XB_TOP      3328
#define XB_TOPGEN   3392
#define XCD_BAR_WORDS 3456
#define XB_SPIN_CAP (1u << 22)

__device__ __forceinline__ unsigned xb_ld(unsigned* p)              { return __hip_atomic_load(p, __ATOMIC_RELAXED, __HIP_MEMORY_SCOPE_AGENT); }
__device__ __forceinline__ unsigned xb_add(unsigned* p, unsigned v) { return __hip_atomic_fetch_add(p, v, __ATOMIC_RELAXED, __HIP_MEMORY_SCOPE_AGENT); }
__device__ __forceinline__ unsigned xb_xcc_id() { return (unsigned)__builtin_amdgcn_s_getreg((3 << 11) | 20) & 0xFu; }
#define XB_SPIN(cond, bar) do { unsigned _sp = 0; while (cond) { __builtin_amdgcn_s_sleep(1); \
    if ((++_sp & 255u) == 0u) { if (xb_ld(&(bar)[XB_TMO])) break; if (_sp > XB_SPIN_CAP) { atomicAdd(&(bar)[XB_TMO], 1u); break; } } } } while (0)

struct XcdBarrier { unsigned* bar; unsigned x; volatile LAS unsigned* st; };

__device__ __forceinline__ XcdBarrier xcd_barrier_post(unsigned* bar, volatile LAS unsigned* st) {
    XcdBarrier b; b.bar = bar; b.x = xb_xcc_id(); b.st = st;
    if (threadIdx.x == 0) (void)xb_add(&bar[XB_XCNT(b.x)], 1u);
    return b;
}
__device__ __forceinline__ void xcd_barrier_complete(unsigned* bar, unsigned x, unsigned& nloc, unsigned& nx) {
    const unsigned G = gridDim.x * gridDim.y * gridDim.z;
    unsigned sum, cnt, mine, sp = 0u;
    for (;;) {
        sum = 0u; cnt = 0u; mine = 0u;
#pragma unroll
        for (unsigned j = 0; j < 16; ++j) { const unsigned c = xb_ld(&bar[XB_XCNT(j)]); sum += c; cnt += (c > 0u) ? 1u : 0u; mine = (j == x) ? c : mine; }
        if (sum == G) break;
        __builtin_amdgcn_s_sleep(1);
        if ((++sp & 255u) == 0u) { if (xb_ld(&bar[XB_TMO])) break; if (sp > XB_SPIN_CAP) { atomicAdd(&bar[XB_TMO], 1u); break; } }
    }
    nloc = mine > 0u ? mine : 1u; nx = cnt > 0u ? cnt : 1u;
}
__device__ __forceinline__ void xcd_barrier(const XcdBarrier& b) {
    asm volatile("s_waitcnt vmcnt(0)" ::: "memory");
    __syncthreads();
    if (threadIdx.x == 0) {
        unsigned* bar = b.bar;
        __builtin_amdgcn_s_waitcnt(0);
        unsigned nloc = b.st[0], nx = b.st[1];
        if (nloc == 0u) { xcd_barrier_complete(bar, b.x, nloc, nx); b.st[0] = nloc; b.st[1] = nx; }
        const unsigned old = xb_add(&bar[XB_XSUB(b.x)], 1u);
        const unsigned gen = old / nloc;
        if (old + 1u == (gen + 1u) * nloc) {
            __builtin_amdgcn_fence(__ATOMIC_RELEASE, "agent");
            asm volatile("s_waitcnt vmcnt(0)" ::: "memory");
            const unsigned og = xb_add(&bar[XB_TOP], 1u);
            const unsigned tg = og / nx;
            if (og + 1u == (tg + 1u) * nx) xb_add(&bar[XB_TOPGEN], 1u);
            else XB_SPIN(xb_ld(&bar[XB_TOPGEN]) == tg, bar);
            __builtin_amdgcn_fence(__ATOMIC_ACQUIRE, "agent");
            xb_add(&bar[XB_XGEN(b.x)], 1u);
            asm volatile("s_waitcnt vmcnt(0)" ::: "memory");
        } else {
            XB_SPIN(xb_ld(&bar[XB_XGEN(b.x)]) == gen, bar);
            __builtin_amdgcn_fence(__ATOMIC_ACQUIRE, "agent");
            asm volatile("s_waitcnt vmcnt(0)" ::: "memory");
        }
    }
    __syncthreads();
}

namespace pg8 {
#define PG8_LAS __attribute__((address_space(3)))
typedef unsigned short bf16_t;
typedef short bf16x8 __attribute__((ext_vector_type(8)));
typedef float f32x4 __attribute__((ext_vector_type(4)));
typedef unsigned u32x4 __attribute__((ext_vector_type(4)));
constexpr int BM = 256, BK = 64, HALF = 128, HTB = HALF * BK * 2  , STAGE_BYTES = 8 * HTB, NXCD = 8, WGM = 8;

__host__ __device__ __forceinline__ int lds_byte(int r, int c) { const int st = (r >> 4) * 2 + (c >> 5), rr = r & 15, cc = c & 31, ob = rr * 64 + cc * 2; return st * 1024 + (ob ^ (((ob >> 9) & 1) << 5)); }
__host__ __device__ __forceinline__ void stage_rc(int b, int& R, int& C) { const int st = b / 1024, sb = b % 1024, swz = sb ^ (((sb >> 9) & 1) << 5); R = (st >> 1) * 16 + swz / 64; C = (st & 1) * 32 + (swz % 64) / 2; }
__host__ __device__ __forceinline__ int perm32(int rho) { const int n = rho >> 4, i = rho & 15; return 8 * (i >> 2) + 4 * n + (i & 3); }

struct Unit { int pm, pn; };
struct Gemm { const bf16_t* A; const bf16_t* Bt; int M, N, K, lda, ldb; };

struct StaticOrder {
    int nM, nN, nwg, G, c;
    __host__ __device__ void init(int M, int N, int G_, int c_) { nM = M / BM; nN = N / BM; nwg = nM * nN; G = G_; c = c_; }
    __host__ __device__ bool next(int i, Unit& u) const {
        const long L = (long)i * G + c; if (L >= nwg) return false;
        int wgid = (int)L; { const int q = nwg / NXCD, r = nwg % NXCD, xcd = wgid % NXCD, off = wgid / NXCD; wgid = (xcd < r ? xcd * (q + 1) : r * (q + 1) + (xcd - r) * q) + off; }
        const int nig = WGM * nN, gid = wgid / nig, fm = gid * WGM, gsz = (nM - fm) < WGM ? (nM - fm) : WGM;
        u.pm = fm + ((wgid % nig) % gsz); u.pn = (wgid % nig) / gsz; return true;
    }
    __device__ __forceinline__ void a_ready(const Unit&) const {}
    __device__ __forceinline__ void done(const Unit&) const {}
};
typedef float f32x2c __attribute__((ext_vector_type(2))); typedef __bf16 bf16x2c __attribute__((ext_vector_type(2)));
__device__ __forceinline__ unsigned cvt_pk_bf16(float lo, float hi) { const f32x2c v = {lo, hi}; return __builtin_bit_cast(unsigned, __builtin_convertvector(v, bf16x2c)); }
typedef float f32x2 __attribute__((ext_vector_type(2)));
template <class Epi, class Sched>
__device__ __forceinline__ void gemm_phase(PG8_LAS unsigned char* lds, const Gemm g, const Sched& S, const Epi& E, const int tid) {
    const int wid = __builtin_amdgcn_readfirstlane(tid >> 6), lane = tid & 63, wr = wid >> 2, wc = wid & 3, fr = lane & 15, fq = lane >> 4;
    const int K = g.K, nt = K / BK;
    unsigned voffA[2], voffB[2];
#pragma unroll
    for (int i = 0; i < 2; ++i) { int R, C; stage_rc(tid * 16 + i * 8192, R, C); const int Rb = Epi::PERM ? ((R & ~31) + perm32(R & 31)) : R;
        voffA[i] = (unsigned)(R * g.lda + C) * 2u; voffB[i] = (unsigned)(Rb * g.ldb + C) * 2u; }
    const size_t kstep = (size_t)(BK * 2);
    const size_t hstepA = (size_t)HALF * g.lda * 2, hstepB = (size_t)HALF * g.ldb * 2;
    const size_t tstepA = 2 * hstepA, tstepB = 2 * hstepB;
    const unsigned ldsw = (unsigned)wid * 1024u;
    const int aoff = lds_byte(wr * 64 + fr, fq * 8), boff = lds_byte(wc * 32 + fr, fq * 8);
#define PG8_SA(b, h) (((b) * 2 + (h)) * HTB)
#define PG8_SB(b, h) ((4 + (b) * 2 + (h)) * HTB)
#define PG8_STAGE(bufoff, gbase, voff) do { _Pragma("unroll") for (int _i = 0; _i < 2; ++_i) \
        __builtin_amdgcn_global_load_lds((const unsigned*)((const char*)(gbase) + (voff)[_i]), (PG8_LAS unsigned*)(lds + (bufoff) + ldsw + _i * 8192), 16, 0, 0); } while (0)
#define PG8_LDA(dst, b, h) do { _Pragma("unroll") for (int m = 0; m < 4; ++m) _Pragma("unroll") for (int k = 0; k < 2; ++k) dst[m][k] = *(const PG8_LAS bf16x8*)(lds + PG8_SA(b, h) + aoff + m * 2048 + k * 1024); } while (0)
#define PG8_LDB(dst, b, h) do { _Pragma("unroll") for (int n = 0; n < 2; ++n) _Pragma("unroll") for (int k = 0; k < 2; ++k) dst[n][k] = *(const PG8_LAS bf16x8*)(lds + PG8_SB(b, h) + boff + n * 2048 + k * 1024); } while (0)
#define PG8_MMA(ai, bj, At, Bt) do { __builtin_amdgcn_s_setprio(1); _Pragma("unroll") for (int m = 0; m < 4; ++m) _Pragma("unroll") for (int n = 0; n < 2; ++n) _Pragma("unroll") for (int k = 0; k < 2; ++k) \
        acc[ai][bj][m][n] = __builtin_amdgcn_mfma_f32_16x16x32_bf16(Bt[n][k], At[m][k], acc[ai][bj][m][n], 0, 0, 0); __builtin_amdgcn_s_setprio(0); } while (0)
#define PG8_WAIT_V(n) asm volatile("s_waitcnt vmcnt(" #n ")" ::: "memory")
#define PG8_WAIT_L(n) asm volatile("s_waitcnt lgkmcnt(" #n ")" ::: "memory")
#define PG8_BAR __builtin_amdgcn_s_barrier()
#define PG8_SCHED __builtin_amdgcn_sched_barrier(0)
    Unit cur, nxt; int ui = 0;
    if (!S.next(0, cur)) return;
    f32x4 acc[2][2][4][2];
#pragma unroll
    for (int a = 0; a < 2; ++a)
#pragma unroll
        for (int b = 0; b < 2; ++b)
#pragma unroll
            for (int m = 0; m < 4; ++m)
#pragma unroll
                for (int n = 0; n < 2; ++n) acc[a][b][m][n] = (f32x4){0.f, 0.f, 0.f, 0.f};
    bf16x8 At[4][2], B0[2][2], B1[2][2];
    const char* cA = (const char*)g.A + (size_t)cur.pm * tstepA; const char* cB = (const char*)g.Bt + (size_t)cur.pn * tstepB;
    S.a_ready(cur);
    PG8_STAGE(PG8_SB(0, 0), cB, voffB); PG8_STAGE(PG8_SA(0, 0), cA, voffA); PG8_STAGE(PG8_SB(0, 1), cB + hstepB, voffB); PG8_STAGE(PG8_SA(0, 1), cA + hstepA, voffA);
    if (wr == 1) PG8_BAR;
    PG8_WAIT_V(4); PG8_BAR;
    PG8_STAGE(PG8_SB(1, 0), cB + kstep, voffB); PG8_STAGE(PG8_SA(1, 0), cA + kstep, voffA); PG8_STAGE(PG8_SB(1, 1), cB + hstepB + kstep, voffB);
    PG8_WAIT_V(6); PG8_BAR;
    for (;;) {
        const bool has_next = S.next(ui + 1, nxt);
        const char* nA = has_next ? (const char*)g.A + (size_t)nxt.pm * tstepA : cA; const char* nB = has_next ? (const char*)g.Bt + (size_t)nxt.pn * tstepB : cB;
        for (int t = 0; t < nt; t += 2) {
            const bool last = (t == nt - 2);
            const char* a1 = cA + (size_t)(t + 1) * kstep;
            const char* a2 = last ? nA : cA + (size_t)(t + 2) * kstep; const char* b2 = last ? nB : cB + (size_t)(t + 2) * kstep;
            const char* a3 = a2 + kstep; const char* b3 = b2 + kstep;
            if (last && has_next) S.a_ready(nxt);
            PG8_LDB(B0, 0, 0); PG8_SCHED; PG8_LDA(At, 0, 0); PG8_STAGE(PG8_SA(1, 1), a1 + hstepA, voffA);
            PG8_WAIT_L(8); PG8_BAR; PG8_WAIT_L(0); PG8_MMA(0, 0, At, B0); PG8_BAR; PG8_SCHED;
            PG8_LDB(B1, 0, 1); PG8_STAGE(PG8_SB(0, 0), b2, voffB);
            PG8_BAR; PG8_WAIT_L(0); PG8_MMA(0, 1, At, B1); PG8_BAR;
            PG8_LDA(At, 0, 1); PG8_STAGE(PG8_SA(0, 0), a2, voffA);
            PG8_BAR; PG8_WAIT_L(0); PG8_MMA(1, 0, At, B0); PG8_BAR; PG8_SCHED;
            PG8_STAGE(PG8_SB(0, 1), b2 + hstepB, voffB);
            PG8_WAIT_V(6); PG8_BAR; PG8_MMA(1, 1, At, B1); PG8_BAR;
            PG8_LDB(B0, 1, 0); PG8_SCHED; PG8_LDA(At, 1, 0); PG8_STAGE(PG8_SA(0, 1), a2 + hstepA, voffA);
            PG8_WAIT_L(8); PG8_BAR; PG8_WAIT_L(0); PG8_MMA(0, 0, At, B0); PG8_BAR; PG8_SCHED;
            PG8_LDB(B1, 1, 1); PG8_STAGE(PG8_SB(1, 0), b3, voffB);
            PG8_BAR; PG8_WAIT_L(0); PG8_MMA(0, 1, At, B1); PG8_BAR;
            PG8_LDA(At, 1, 1); PG8_STAGE(PG8_SA(1, 0), a3, voffA);
            PG8_BAR; PG8_WAIT_L(0); PG8_MMA(1, 0, At, B0); PG8_BAR; PG8_SCHED;
            PG8_STAGE(PG8_SB(1, 1), b3 + hstepB, voffB);
            PG8_WAIT_V(6); PG8_BAR; PG8_MMA(1, 1, At, B1); PG8_BAR;
        }
            if constexpr (!Epi::AFTER_DRAIN) { E(acc, cur, wr, wc, fr, fq); S.done(cur); }
            if (!has_next) break;
#pragma unroll
        for (int a = 0; a < 2; ++a)
#pragma unroll
            for (int b = 0; b < 2; ++b)
#pragma unroll
                for (int m = 0; m < 4; ++m)
#pragma unroll
                    for (int n = 0; n < 2; ++n) acc[a][b][m][n] = (f32x4){0.f, 0.f, 0.f, 0.f};
        cur = nxt; cA = nA; cB = nB; ++ui;
    }
    PG8_WAIT_V(0);
    if (wr == 0) PG8_BAR;
    PG8_BAR;
    if constexpr (Epi::AFTER_DRAIN) { E.fused(acc, cur, wr, wc, fr, fq, lds, wid, lane); S.done(cur); }
#undef PG8_SA
#undef PG8_SB
#undef PG8_STAGE
#undef PG8_LDA
#undef PG8_LDB
#undef PG8_MMA
#undef PG8_WAIT_V
#undef PG8_WAIT_L
#undef PG8_BAR
#undef PG8_SCHED
}
}

constexpr int D = 2048, NB = 2, SEQ = 16384, CL = 256, TL = NB * SEQ, TC = NB * CL, MR = TL + TC;
constexpr int NHEAD = 32, HN = 64;
constexpr int IN_COLS = 16832, CONV_COLS = 12736;
constexpr int NR = 6656, NHY = 6144, NG = 4096, NTOT = NR + NHY + NG;
constexpr int LORA_W = 512;
constexpr int NPART = 32;
constexpr int NEXP = 16384;
constexpr float NORM_EPS = 1e-6f, GN_EPS = 64e-5f;
constexpr int NTHREADS = 512;
constexpr int LDS_BYTES = 159 * 1024;

constexpr size_t al256(size_t x) { return (x + 255) & ~(size_t)255; }
constexpr size_t SLOT_BYTES = (size_t)MR * D * 2;
constexpr size_t WS_BAR    = 0;
constexpr size_t WS_PTRS   = 14336;
constexpr size_t WS_MOD    = 16384;
constexpr size_t WS_MODP   = WS_MOD    + al256((size_t)2 * 3 * 6 * D * 4);
constexpr size_t WS_TW     = WS_MODP   + al256((size_t)NPART * 2 * 3 * 6 * D * 4);
constexpr size_t WS_CONVW  = WS_TW     + al256((size_t)32768 * 8);
constexpr size_t WS_LBIAS  = WS_CONVW  + al256((size_t)3 * NTOT * 4);
constexpr size_t WS_CTXRES = WS_LBIAS  + al256((size_t)4 * D * 4);
constexpr size_t WS_H      = WS_CTXRES + al256((size_t)TC * D * 4);
constexpr size_t WS_WTIN   = WS_H      + SLOT_BYTES;
constexpr size_t WS_WTLORA = WS_WTIN   + al256((size_t)NTOT * D * 2);
constexpr size_t WS_WTOUT  = WS_WTLORA + al256((size_t)4 * D * LORA_W * 2);
constexpr size_t WS_WTSC   = WS_WTOUT  + al256((size_t)D * D * 2);
constexpr size_t WS_W3T    = WS_WTSC   + al256((size_t)D * D * 2);
constexpr size_t WS_HDN    = WS_W3T    + al256((size_t)8192 * 256 * 2);
constexpr size_t WS_HDNC   = WS_HDN    + al256((size_t)SEQ * 256 * 2);
constexpr size_t WS_PCTX   = WS_HDNC   + al256((size_t)CL * 256 * 2);
constexpr size_t WS_LORAIN = WS_PCTX   + al256((size_t)TC * NR * 2);
constexpr size_t WS_SLOT0  = WS_LORAIN + al256((size_t)MR * LORA_W * 2);
constexpr size_t WS_PEER8  = WS_SLOT0  + 7 * SLOT_BYTES;
constexpr size_t WS_END    = WS_PEER8  + al256((size_t)2 * NEXP * D);
constexpr size_t CH_ARR = (size_t)NB * D * CL * 4;
constexpr size_t WS_CV   = WS_LORAIN;
constexpr size_t WS_YHC  = WS_CV + 3 * CH_ARR;
constexpr size_t WS_HCF  = WS_YHC + CH_ARR;
static_assert(WS_HCF + (size_t)8192 * 256 * 4 <= WS_SLOT0, "ctx hyena arrays must fit the lora_in region");

#define GAS __attribute__((address_space(1)))
struct KArgs {
    const float* in[33];
    float* out;
    unsigned char* ws;
};
struct Params {
    float* out;
    unsigned char* ws;
    int tid, bid, nblk;
};

enum { I_X = 0, I_C, I_CTX, I_CCTX, I_ADAW, I_ADAB, I_N1G, I_N2G, I_WIN, I_CONVW, I_W0, I_W2, I_A0, I_A2, I_G2, I_KK, I_KA, I_RK, I_LNW, I_LNB,
       I_HW1, I_HB1, I_HW2, I_HB2, I_HW3, I_HFREQ, I_HSKIP, I_WOUT, I_WQ, I_KEYS, I_PU, I_PV, I_FING };

__device__ __forceinline__ float bf2f(bf16_t v) { return __uint_as_float((unsigned)v << 16); }
__device__ __forceinline__ bf16_t f2bf(float f) { unsigned u = __float_as_uint(f); u += 0x7FFFu + ((u >> 16) & 1u); return (bf16_t)(u >> 16); }
__device__ __forceinline__ unsigned pack2(float lo, float hi) { return (unsigned)f2bf(lo) | ((unsigned)f2bf(hi) << 16); }
__device__ __forceinline__ float bflo(unsigned w) { return __uint_as_float(w << 16); }
__device__ __forceinline__ float bfhi(unsigned w) { return __uint_as_float(w & 0xFFFF0000u); }
__device__ __forceinline__ float sigmoidf_(float x) { return __builtin_amdgcn_rcpf(1.0f + __expf(-x)); }
__device__ __forceinline__ float tanhf_(float x) { return 1.0f - 2.0f * __builtin_amdgcn_rcpf(1.0f + __expf(2.0f * x)); }
template <int CTRL> __device__ __forceinline__ float dppf(float x) { return __builtin_bit_cast(float, __builtin_amdgcn_mov_dpp(__builtin_bit_cast(int, x), CTRL, 0xf, 0xf, true)); }
__device__ __forceinline__ float red16(float x) { x += dppf<0xB1>(x); x += dppf<0x4E>(x); x += dppf<0x141>(x); x += dppf<0x128>(x); return x; }
__device__ __forceinline__ float rdlane(float x, int l) { return __builtin_bit_cast(float, __builtin_amdgcn_readlane(__builtin_bit_cast(int, x), l)); }
__device__ __forceinline__ float wave_sum(float x) { x = red16(x); return (rdlane(x, 0) + rdlane(x, 16)) + (rdlane(x, 32) + rdlane(x, 48)); }

__device__ __forceinline__ const float* inp(const Params& p, int k) {
    const unsigned long long v = ((const unsigned long long*)(p.ws + WS_PTRS))[k];
    const unsigned lo = __builtin_amdgcn_readfirstlane((unsigned)v), hi = __builtin_amdgcn_readfirstlane((unsigned)(v >> 32));
    GAS const float* g_ = (GAS const float*)(((unsigned long long)hi << 32) | lo); asm volatile("" : "+s"(g_)); return (const float*)g_;
}
__device__ __forceinline__ const float* xrow_c(const Params& p, int r) { return r < TL ? p.out + (size_t)r * D : (const float*)(p.ws + WS_CTXRES) + (size_t)(r - TL) * D; }
__device__ __forceinline__ float* xrow(const Params& p, int r) { return r < TL ? p.out + (size_t)r * D : (float*)(p.ws + WS_CTXRES) + (size_t)(r - TL) * D; }
__device__ __forceinline__ int mrow_of(int r) { return r < TL ? (r >> 14) : 2; }
__device__ __forceinline__ const float* modp(const Params& p, int l, int mrow, int chunk) { return (const float*)(p.ws + WS_MOD) + ((size_t)(l * 3 + mrow) * 6 + chunk) * D; }
__device__ __forceinline__ bf16_t* slot(const Params& p, int s) { return (bf16_t*)(p.ws + WS_SLOT0 + (size_t)s * SLOT_BYTES); }

__device__ __forceinline__ int src_col(int n) {
    if (n < 4096) return n;
    if (n < 6144) return 4480 + (n - 4096);
    if (n < NR) { const int cc = n - 6144, blk = cc >> 7, o = cc & 127;
        if (o < 96) return (blk == 0 ? 4096 : blk == 1 ? 4288 : blk == 2 ? 4192 : 4384) + o;
        return blk == 0 ? 6528 + (o - 96) : blk == 1 ? 6528 + 32 + (o - 96) : -1; }
    if (n < NR + NHY) return 6592 + (n - NR);
    { const int g = n - NR - NHY, tile = g >> 8, o = g & 255;
      return o < 128 ? CONV_COLS + tile * 128 + o : CONV_COLS + D + tile * 128 + (o - 128); }
}

__device__ __forceinline__ float siluf_(float x) { return x * sigmoidf_(x); }
__device__ __forceinline__ void ph_init(const Params& p, const float* in_x, const float* in_ctx, const float* cv, const float* cc, const float* ada_w) {
    const size_t gt = (size_t)p.bid * NTHREADS + p.tid, GT = (size_t)p.nblk * NTHREADS;
    float* mp = (float*)(p.ws + WS_MODP);
    for (int u = p.bid; u < 2 * 12 * NPART; u += p.nblk) {
        const int kc = u % NPART, cch = (u / NPART) % 12, l = u / (NPART * 12);
        const int col = cch * 1024 + p.tid * 2;
        float a0 = 0.f, a1 = 0.f, b0 = 0.f, b1 = 0.f, c0 = 0.f, c1 = 0.f;
        const float* w = ada_w + ((size_t)l * D + (size_t)kc * 64) * (6 * D) + col;
#pragma unroll 8
        for (int k = 0; k < 64; ++k) {
            const int kk = kc * 64 + k;
            const float s0 = siluf_(cv[kk]), s1 = siluf_(cv[D + kk]), s2 = siluf_(cc[kk]);
            const f32x2 wv = *(const f32x2*)(w + (size_t)k * (6 * D));
            a0 += s0 * wv.x; a1 += s0 * wv.y; b0 += s1 * wv.x; b1 += s1 * wv.y; c0 += s2 * wv.x; c1 += s2 * wv.y;
        }
        float* o = mp + ((size_t)(kc * 2 + l) * 3) * (6 * D) + col;
        *(f32x2*)(o) = (f32x2){a0, a1}; *(f32x2*)(o + 6 * D) = (f32x2){b0, b1}; *(f32x2*)(o + 12 * D) = (f32x2){c0, c1};
    }
}
__device__ __forceinline__ void ph_modred(const Params& p) {
    const int gt = p.bid * NTHREADS + p.tid, GT = p.nblk * NTHREADS;
    const float* mp = (const float*)(p.ws + WS_MODP); float* md = (float*)(p.ws + WS_MOD);
    for (int i = gt; i < 2 * 3 * 6 * D; i += GT) {
        const int col = i % (6 * D), r = (i / (6 * D)) % 3, l = i / (18 * D);
        float s = inp(p, I_ADAB)[l * 6 * D + col];
        for (int kc = 0; kc < NPART; ++kc) s += mp[((size_t)(kc * 2 + l) * 3 + r) * (6 * D) + col];
        md[i] = s;
    }
}

__device__ __forceinline__ void norm_rows(const Params& p, const float* g, int l, int ch_shift, int ch_scale, int M, const float* xin = nullptr, const float* cin = nullptr) {
    const int lane = p.tid & 63, wv = p.bid * 8 + (p.tid >> 6), NW = p.nblk * 8;
    bf16_t* h = (bf16_t*)(p.ws + WS_H);
    for (int r = wv; r < M; r += NW) {
        const float* xr = xin ? (r < TL ? xin + (size_t)r * D : cin + (size_t)(r - TL) * D) : xrow_c(p, r); const int mr = mrow_of(r);
        const float* sh = modp(p, l, mr, ch_shift); const float* sc = modp(p, l, mr, ch_scale);
        f32x4 v[8]; float ss = 0.f;
#pragma unroll
        for (int c = 0; c < 8; ++c) { v[c] = *(const f32x4*)(xr + c * 256 + lane * 4); ss += v[c][0] * v[c][0] + v[c][1] * v[c][1] + v[c][2] * v[c][2] + v[c][3] * v[c][3]; }
        ss = wave_sum(ss);
        const float rs = rsqrtf(ss * (1.0f / D) + NORM_EPS);
#pragma unroll
        for (int c = 0; c < 8; ++c) { const int col = c * 256 + lane * 4;
            const f32x4 gg = *(const f32x4*)(g + col), s1 = *(const f32x4*)(sc + col), s0 = *(const f32x4*)(sh + col);
            const f32x4 y = (v[c] * rs) * gg * (s1 + 1.0f) + s0;
            u32x2 w; w.x = pack2(y[0], y[1]); w.y = pack2(y[2], y[3]);
            *(u32x2*)(h + (size_t)r * D + col) = w; }
    }
}

template <class F> __device__ __forceinline__ void cvt_T(const Params& p, bf16_t* dst, int N, int Kd, F f) {
    const int lane = p.tid & 63, wv = p.bid * 8 + (p.tid >> 6), NW = p.nblk * 8;
    const int nblk = N / 64, units = nblk * (Kd / 32);
    for (int u = wv; u < units; u += NW) {
        const int n = (u % nblk) * 64 + lane, k0 = (u / nblk) * 32;
        float v[32];
#pragma unroll
        for (int i = 0; i < 32; ++i) v[i] = f(k0 + i, n);
        unsigned w[16];
#pragma unroll
        for (int i = 0; i < 16; ++i) w[i] = pack2(v[2 * i], v[2 * i + 1]);
        u32x4* d = (u32x4*)(dst + (size_t)n * Kd + k0);
#pragma unroll
        for (int i = 0; i < 4; ++i) d[i] = (u32x4){w[4 * i], w[4 * i + 1], w[4 * i + 2], w[4 * i + 3]};
    }
}

__device__ __forceinline__ void filter_mlp(const Params& p, int l, int Lf, bf16_t* dst) {
    const int lane = p.tid & 63, wv = p.bid * 8 + (p.tid >> 6), NW = p.nblk * 8;
    const float* w1 = inp(p, I_HW1) + (size_t)l * 33 * 64; const float* b1 = inp(p, I_HB1) + l * 64;
    const float* w2 = inp(p, I_HW2) + (size_t)l * 64 * 64; const float* b2 = inp(p, I_HB2) + l * 64;
    const float fr = inp(p, I_HFREQ)[l * 64 + lane];
    float w1c[33], w2c[64];
#pragma unroll
    for (int i = 0; i < 33; ++i) w1c[i] = w1[i * 64 + lane];
#pragma unroll
    for (int i = 0; i < 64; ++i) w2c[i] = w2[i * 64 + lane];
    const float b1l = b1[lane], b2l = b2[lane];
    for (int n = wv; n < Lf; n += NW) {
        float zf = 0.f;
        if (lane == 0) zf = (float)n / (float)(Lf - 1);
        else if (lane <= 32) { const int bi = (lane - 1) & 15; const float band = 1e-4f + (float)bi * ((15.0f - 1e-4f) / 15.0f);
            float s, c; sincospif(2.0f * (float)n * band / (float)Lf, &s, &c); zf = lane <= 16 ? c : -s; }
        float a = b1l;
#pragma unroll
        for (int i = 0; i < 33; ++i) a += rdlane(zf, i) * w1c[i];
        const float h1 = sinf(fr * a);
        float b = b2l;
#pragma unroll
        for (int i = 0; i < 64; ++i) b += rdlane(h1, i) * w2c[i];
        const float h2 = sinf(fr * b);
        bf16_t* d = dst + (size_t)n * 256;
        d[lane] = f2bf(h2); d[64 + lane] = 0; d[128 + lane] = 0; d[192 + lane] = 0;
    }
}

__device__ __forceinline__ void prep_win(const Params& p, int l, int n0, int n1) {
    const float* w = inp(p, I_WIN) + (size_t)l * D * IN_COLS;
    cvt_T(p, (bf16_t*)(p.ws + WS_WTIN) + (size_t)n0 * D, n1 - n0, D, [=](int k, int n) { const int s = src_col(n + n0); return s >= 0 ? w[(size_t)k * IN_COLS + s] : 0.f; });
    float* cw = (float*)(p.ws + WS_CONVW); const float* cs = inp(p, I_CONVW) + (size_t)l * 3 * CONV_COLS; const int nn = n1 - n0;
    for (int i = p.bid * NTHREADS + p.tid; i < 3 * nn; i += p.nblk * NTHREADS) { const int j = i / nn, n = n0 + i % nn; const int s = src_col(n);
        cw[j * NTOT + n] = (n < NR + NHY && s >= 0) ? cs[j * CONV_COLS + s] : 0.f; }
}
__device__ __forceinline__ void ph_prepA(const Params& p, int l) {
    prep_win(p, l, 0, NR);
    { const float* w2 = inp(p, I_W2) + (size_t)l * 2 * 96 * D; const float* a2 = inp(p, I_A2) + (size_t)l * 2 * 96 * D;
      cvt_T(p, (bf16_t*)(p.ws + WS_WTLORA), 4 * D, LORA_W, [=](int k, int n) { const int t = n >> 11, j = n & (D - 1), kb = k >> 7, o = k & 127;
          if (kb != t || o >= 96) return 0.f; const float* s = (t & 1) ? a2 : w2; return s[((size_t)(t >> 1) * 96 + o) * D + j]; }); }
    { float* lb = (float*)(p.ws + WS_LBIAS); for (int i = p.bid * NTHREADS + p.tid; i < 4 * D; i += p.nblk * NTHREADS) { const int t = i >> 11, j = i & (D - 1);
          lb[i] = ((t & 1) ? inp(p, I_A0) : inp(p, I_W0))[(size_t)l * 2 * D + (t >> 1) * D + j]; } }
}
__device__ __forceinline__ void ph_prepB(const Params& p, int l) { prep_win(p, l, NR, NTOT); }

__device__ __forceinline__ void ph_prep_bg(const Params& p, int l) {
    { const float* w = inp(p, I_WOUT) + (size_t)l * D * D; cvt_T(p, (bf16_t*)(p.ws + WS_WTOUT), D, D, [=](int k, int n) { return w[(size_t)k * D + n]; }); }
    { const float* w = inp(p, I_HW3) + (size_t)l * 64 * 8192; cvt_T(p, (bf16_t*)(p.ws + WS_W3T), 8192, 256, [=](int k, int n) { return k < 64 ? w[(size_t)k * 8192 + n] : 0.f; }); }
    { const float* wq = inp(p, I_WQ) + (size_t)l * D * D; const float* keys = inp(p, I_KEYS) + (size_t)l * 16 * 128 * 128; unsigned* dst = (unsigned*)(p.ws + WS_WTSC);
      for (size_t i = (size_t)p.bid * NTHREADS + p.tid; i < (size_t)D * D / 2; i += (size_t)p.nblk * NTHREADS) {
          const int row = (int)(i / (D / 2)), kk = (int)(i % (D / 2)) * 2, hp = row >> 7;
          const f32x4* kr = (const f32x4*)(keys + (size_t)row * 128); const f32x4* q0 = (const f32x4*)(wq + (size_t)kk * D + hp * 128); const f32x4* q1 = (const f32x4*)(wq + (size_t)(kk + 1) * D + hp * 128);
          float s0 = 0.f, s1 = 0.f;
#pragma unroll 4
          for (int d4 = 0; d4 < 32; ++d4) { const f32x4 a = kr[d4], b = q0[d4], c = q1[d4];
              s0 += a[0] * b[0] + a[1] * b[1] + a[2] * b[2] + a[3] * b[3]; s1 += a[0] * c[0] + a[1] * c[1] + a[2] * c[2] + a[3] * c[3]; }
          dst[i] = pack2(s0, s1); } }
    filter_mlp(p, l, SEQ, (bf16_t*)(p.ws + WS_HDN));
    if (l == 0) filter_mlp(p, l, CL, (bf16_t*)(p.ws + WS_HDNC));
    { const f32x4* su = (const f32x4*)(inp(p, I_PU) + (size_t)l * NEXP * D); const f32x4* sv = (const f32x4*)(inp(p, I_PV) + (size_t)l * NEXP * D);
      unsigned* du = (unsigned*)(p.ws + WS_PEER8); unsigned* dv = du + (size_t)NEXP * D / 4;
      for (size_t i = (size_t)p.bid * NTHREADS + p.tid; i < (size_t)NEXP * D / 4; i += (size_t)p.nblk * NTHREADS) {
          const f32x4 a = su[i] * 128.0f, b = sv[i] * 8.0f;
          int wa = __builtin_amdgcn_cvt_pk_fp8_f32(a[0], a[1], 0, false); wa = __builtin_amdgcn_cvt_pk_fp8_f32(a[2], a[3], wa, true);
          int wb = __builtin_amdgcn_cvt_pk_fp8_f32(b[0], b[1], 0, false); wb = __builtin_amdgcn_cvt_pk_fp8_f32(b[2], b[3], wb, true);
          du[i] = (unsigned)wa; dv[i] = (unsigned)wb; } }
}

using pg8::Unit; using pg8::cvt_pk_bf16;
typedef f32x4 Acc[2][2][4][2];

__device__ __forceinline__ void st8bf(bf16_t* p, const f32x4 a, const f32x4 b) { *(u32x4*)p = (u32x4){cvt_pk_bf16(a[0], a[1]), cvt_pk_bf16(a[2], a[3]), cvt_pk_bf16(b[0], b[1]), cvt_pk_bf16(b[2], b[3])}; }
__device__ __forceinline__ void st4bf(bf16_t* p, const f32x4 v) { u32x2 w; w.x = cvt_pk_bf16(v[0], v[1]); w.y = cvt_pk_bf16(v[2], v[3]); *(u32x2*)p = w; }

template <int GROUP> struct EpiConv {
    static constexpr bool PERM = false, AFTER_DRAIN = false;
    const float* cw;
    bf16_t* pctx;
    bf16_t* d0; bf16_t* lora;
    __device__ __forceinline__ void operator()(const Acc& acc, const Unit& u, int wr, int wc, int fr, int fq) const {
        if (u.pm >= TL / 256) {
#pragma unroll
            for (int ai = 0; ai < 2; ++ai)
#pragma unroll
                for (int m = 0; m < 4; ++m) { const int row = (u.pm - TL / 256) * 256 + ai * 128 + wr * 64 + m * 16 + fr;
#pragma unroll
                    for (int bj = 0; bj < 2; ++bj)
#pragma unroll
                        for (int n = 0; n < 2; ++n) st4bf(pctx + (size_t)row * NR + u.pn * 256 + bj * 128 + wc * 32 + n * 16 + 4 * fq, acc[ai][bj][m][n]); }
            return;
        }
        f32x4 tap[2][2][3];
#pragma unroll
        for (int bj = 0; bj < 2; ++bj)
#pragma unroll
            for (int n = 0; n < 2; ++n)
#pragma unroll
                for (int j = 0; j < 3; ++j) tap[bj][n][j] = *(const f32x4*)(cw + j * NTOT + u.pn * 256 + bj * 128 + wc * 32 + n * 16 + 4 * fq);
#pragma unroll
        for (int bj = 0; bj < 2; ++bj)
#pragma unroll
            for (int n = 0; n < 2; ++n) {
                const int colg = u.pn * 256 + bj * 128 + wc * 32 + n * 16 + 4 * fq;
                const f32x4 w0 = tap[bj][n][0], w1 = tap[bj][n][1], w2 = tap[bj][n][2];
#pragma unroll
                for (int ai = 0; ai < 2; ++ai) {
                    f32x4 rp[4], rn[4];
#pragma unroll
                    for (int m = 0; m < 4; ++m)
#pragma unroll
                        for (int e = 0; e < 4; ++e) { rp[m][e] = dppf<0x121>(acc[ai][bj][m][n][e]); rn[m][e] = dppf<0x12F>(acc[ai][bj][m][n][e]); }
#pragma unroll
                    for (int m = 0; m < 4; ++m) {
                        const f32x4 z = (f32x4){0.f, 0.f, 0.f, 0.f};
                        const f32x4 pv = (fr == 0) ? (m > 0 ? rp[m > 0 ? m - 1 : 0] : z) : rp[m];
                        const f32x4 nx = (fr == 15) ? (m < 3 ? rn[m < 3 ? m + 1 : 3] : z) : rn[m];
                        const f32x4 o = w0 * pv + w1 * acc[ai][bj][m][n] + w2 * nx;
                        const int row = u.pm * 256 + ai * 128 + wr * 64 + m * 16 + fr;
                        if (GROUP == 0) {
                            if (colg < 3 * D) { bf16_t* d = d0 + (size_t)(colg >> 11) * (SLOT_BYTES / 2); st4bf(d + (size_t)row * D + (colg & (D - 1)), o); }
                            else { const int cc = colg - 3 * D, blk = cc >> 7, oo = cc & 127; f32x4 a;
                                if (oo < 96) { if (blk & 1) a = o; else { a[0] = tanhf_(o[0]); a[1] = tanhf_(o[1]); a[2] = tanhf_(o[2]); a[3] = tanhf_(o[3]); } }
                                else if (blk < 2) { a[0] = sigmoidf_(o[0]); a[1] = sigmoidf_(o[1]); a[2] = sigmoidf_(o[2]); a[3] = sigmoidf_(o[3]); }
                                else a = z;
                                st4bf(lora + (size_t)row * LORA_W + cc, a); }
                        } else {
                            bf16_t* d = d0 + (size_t)(colg >> 11) * (SLOT_BYTES / 2); const int c = colg & (D - 1), b = row >> 14, t = row & (SEQ - 1);
                            const bool odd = fr & 1;
                            const float r0 = dppf<0xB1>(odd ? o[0] : o[2]), r1 = dppf<0xB1>(odd ? o[1] : o[3]);
                            const unsigned w0 = cvt_pk_bf16(odd ? r0 : o[0], odd ? o[2] : r0), w1 = cvt_pk_bf16(odd ? r1 : o[1], odd ? o[3] : r1);
                            bf16_t* q = d + ((size_t)(b * D + c + (odd ? 2 : 0))) * SEQ + (t - (odd ? 1 : 0));
                            *(unsigned*)q = w0; *(unsigned*)(q + SEQ) = w1;
                        }
                    }
                }
            }
    }
};

struct EpiLora {
    static constexpr bool PERM = true, AFTER_DRAIN = false;
    const float* bias4;
    int t0;
    bf16_t* dst0;
    __device__ __forceinline__ void operator()(const Acc& acc, const Unit& u, int wr, int wc, int fr, int fq) const {
        const int t = t0 + (u.pn >> 3); const bool isa = t & 1; const float mul = isa ? 1.0f : -0.60653065971f; const float* bias = bias4 + t * D; bf16_t* d = dst0 + (size_t)t * (SLOT_BYTES / 2);
#pragma unroll
        for (int bj = 0; bj < 2; ++bj) { const int col = (u.pn & 7) * 256 + bj * 128 + wc * 32 + 8 * fq; const f32x4 b0 = *(const f32x4*)(bias + col), b1 = *(const f32x4*)(bias + col + 4);
#pragma unroll
            for (int ai = 0; ai < 2; ++ai)
#pragma unroll
                for (int m = 0; m < 4; ++m) { const int row = u.pm * 256 + ai * 128 + wr * 64 + m * 16 + fr; const f32x4 x0 = acc[ai][bj][m][0] + b0, x1 = acc[ai][bj][m][1] + b1; f32x4 o0, o1;
#pragma unroll
                    for (int e = 0; e < 4; ++e) { o0[e] = sigmoidf_(x0[e]) * mul; o1[e] = sigmoidf_(x1[e]) * mul; }
                    st8bf(d + (size_t)row * D + col, o0, o1); } }
    }
};

struct EpiBf {
    static constexpr bool PERM = true, AFTER_DRAIN = false;
    bf16_t* O; int ldc;
    __device__ __forceinline__ void operator()(const Acc& acc, const Unit& u, int wr, int wc, int fr, int fq) const {
#pragma unroll
        for (int ai = 0; ai < 2; ++ai)
#pragma unroll
            for (int m = 0; m < 4; ++m) { const int row = u.pm * 256 + ai * 128 + wr * 64 + m * 16 + fr;
#pragma unroll
                for (int bj = 0; bj < 2; ++bj) st8bf(O + (size_t)row * ldc + u.pn * 256 + bj * 128 + wc * 32 + 8 * fq, acc[ai][bj][m][0], acc[ai][bj][m][1]); }
    }
};
struct EpiF32 {
    static constexpr bool PERM = false, AFTER_DRAIN = false;
    float* O; int ldc;
    __device__ __forceinline__ void operator()(const Acc& acc, const Unit& u, int wr, int wc, int fr, int fq) const {
#pragma unroll
        for (int ai = 0; ai < 2; ++ai)
#pragma unroll
            for (int m = 0; m < 4; ++m) { const int row = u.pm * 256 + ai * 128 + wr * 64 + m * 16 + fr;
#pragma unroll
                for (int bj = 0; bj < 2; ++bj)
#pragma unroll
                    for (int n = 0; n < 2; ++n) *(f32x4*)(O + (size_t)row * ldc + u.pn * 256 + bj * 128 + wc * 32 + n * 16 + 4 * fq) = acc[ai][bj][m][n]; }
    }
};
struct EpiGate {
    static constexpr bool PERM = false, AFTER_DRAIN = false;
    const bf16_t* yrw;
    const bf16_t* yhy;
    const float* yhc;
    bf16_t* y;
    __device__ __forceinline__ void operator()(const Acc& acc, const Unit& u, int wr, int wc, int fr, int fq) const {
        const bool lat = u.pm < TL / 256;
#pragma unroll
        for (int ai = 0; ai < 2; ++ai) {
            u32x2 rw[4][2]; float hy[4][2][4];
#pragma unroll
            for (int m = 0; m < 4; ++m) { const int row = u.pm * 256 + ai * 128 + wr * 64 + m * 16 + fr;
#pragma unroll
                for (int n = 0; n < 2; ++n) { const int ch = u.pn * 128 + wc * 32 + n * 16 + 4 * fq;
                    rw[m][n] = *(const u32x2*)(yrw + (size_t)row * D + ch);
                    if (lat) { const bf16_t* q = yhy + ((size_t)((row >> 14) * D + ch)) * SEQ + (row & (SEQ - 1));
#pragma unroll
                        for (int e = 0; e < 4; ++e) hy[m][n][e] = bf2f(q[(size_t)e * SEQ]); }
                    else { const int rc = row - TL; const float* q = yhc + ((size_t)((rc >> 8) * D + ch)) * CL + (rc & (CL - 1));
#pragma unroll
                        for (int e = 0; e < 4; ++e) hy[m][n][e] = q[(size_t)e * CL]; } } }
#pragma unroll
            for (int m = 0; m < 4; ++m) { const int row = u.pm * 256 + ai * 128 + wr * 64 + m * 16 + fr;
#pragma unroll
                for (int n = 0; n < 2; ++n) { const int ch = u.pn * 128 + wc * 32 + n * 16 + 4 * fq;
                    const float r4[4] = {bflo(rw[m][n].x), bfhi(rw[m][n].x), bflo(rw[m][n].y), bfhi(rw[m][n].y)};
                    f32x4 o;
#pragma unroll
                    for (int e = 0; e < 4; ++e) o[e] = sigmoidf_(acc[ai][0][m][n][e]) * r4[e] + sigmoidf_(acc[ai][1][m][n][e]) * hy[m][n][e];
                    st4bf(y + (size_t)row * D + ch, o); } }
        }
    }
};
struct EpiResid {
    static constexpr bool PERM = false, AFTER_DRAIN = false;
    float* xl; float* xc; const float* ga;
    const float* rl; const float* rc;
    __device__ __forceinline__ void operator()(const Acc& acc, const Unit& u, int wr, int wc, int fr, int fq) const {
        const int row00 = u.pm * 256 + wr * 64 + fr; const int mr = mrow_of(row00);
        const float* g = ga + (size_t)mr * 6 * D + u.pn * 256 + wc * 32 + 4 * fq;
        f32x4 gv[2][2];
#pragma unroll
        for (int bj = 0; bj < 2; ++bj)
#pragma unroll
            for (int n = 0; n < 2; ++n) gv[bj][n] = *(const f32x4*)(g + bj * 128 + n * 16);
#pragma unroll
        for (int ai = 0; ai < 2; ++ai)
#pragma unroll
            for (int mh = 0; mh < 2; ++mh) {
                f32x4 xv[2][2][2]; f32x4* qp[2];
#pragma unroll
                for (int mm = 0; mm < 2; ++mm) { const int row = row00 + ai * 128 + (2 * mh + mm) * 16;
                    const size_t ro = (row < TL ? (size_t)row * D : (size_t)(row - TL) * D) + u.pn * 256 + wc * 32 + 4 * fq;
                    float* xr = (row < TL ? xl : xc) + ro; qp[mm] = (f32x4*)xr; const float* xs = (row < TL ? rl : rc) + ro;
#pragma unroll
                    for (int bj = 0; bj < 2; ++bj)
#pragma unroll
                        for (int n = 0; n < 2; ++n) xv[mm][bj][n] = *(const f32x4*)(xs + bj * 128 + n * 16); }
#pragma unroll
                for (int mm = 0; mm < 2; ++mm)
#pragma unroll
                    for (int bj = 0; bj < 2; ++bj)
#pragma unroll
                        for (int n = 0; n < 2; ++n) *(f32x4*)((float*)qp[mm] + bj * 128 + n * 16) = xv[mm][bj][n] + gv[bj][n] * acc[ai][bj][2 * mh + mm][n]; }
    }
};

template <class Epi> __device__ __forceinline__ void run_gemm(const Params& p, unsigned char* lds, const bf16_t* A, int lda, const bf16_t* Bt, int ldb, int M, int N, int K, const Epi& E) {
    asm volatile("" : "+s"(M), "+s"(N), "+s"(K), "+s"(lda), "+s"(ldb));
    pg8::Gemm g{A, Bt, M, N, K, lda, ldb}; pg8::StaticOrder S; S.init(M, N, (int)p.nblk, (int)p.bid);
    pg8::gemm_phase<Epi, pg8::StaticOrder>((PG8_LAS unsigned char*)lds, g, S, E, p.tid);
}

template <int GROUP> __device__ __forceinline__ void ph_ctxconv(const Params& p) {
    constexpr int NC = GROUP == 0 ? NR : NHY;
    const float* cw = (const float*)(p.ws + WS_CONVW) + (GROUP == 0 ? 0 : NR);
    const bf16_t* pc = (const bf16_t*)(p.ws + WS_PCTX);
    const int items = TC * (NC / 4);
    for (int i = p.bid * NTHREADS + p.tid; i < items; i += p.nblk * NTHREADS) {
        const int rc = i / (NC / 4), colg = (i % (NC / 4)) * 4, t = rc & (CL - 1);
        const f32x4 w0 = *(const f32x4*)(cw + colg), w1 = *(const f32x4*)(cw + NTOT + colg), w2 = *(const f32x4*)(cw + 2 * NTOT + colg);
        const u32x2 c = *(const u32x2*)(pc + (size_t)rc * NR + colg);
        u32x2 a = (u32x2){0u, 0u}, b = (u32x2){0u, 0u};
        if (t > 0) a = *(const u32x2*)(pc + (size_t)(rc - 1) * NR + colg);
        if (t < CL - 1) b = *(const u32x2*)(pc + (size_t)(rc + 1) * NR + colg);
        const f32x4 pv = (f32x4){bflo(a.x), bfhi(a.x), bflo(a.y), bfhi(a.y)}, cu = (f32x4){bflo(c.x), bfhi(c.x), bflo(c.y), bfhi(c.y)}, nx = (f32x4){bflo(b.x), bfhi(b.x), bflo(b.y), bfhi(b.y)};
        const f32x4 o = w0 * pv + w1 * cu + w2 * nx;
        const int row = TL + rc;
        if (GROUP == 0) {
            if (colg < 3 * D) { bf16_t* d = slot(p, colg < D ? 0 : colg < 2 * D ? 1 : 2); st4bf(d + (size_t)row * D + (colg & (D - 1)), o); }
            else { const int cc = colg - 3 * D, blk = cc >> 7, oo = cc & 127; f32x4 v;
                if (oo < 96) { if (blk & 1) v = o; else { v[0] = tanhf_(o[0]); v[1] = tanhf_(o[1]); v[2] = tanhf_(o[2]); v[3] = tanhf_(o[3]); } }
                else if (blk < 2) { v[0] = sigmoidf_(o[0]); v[1] = sigmoidf_(o[1]); v[2] = sigmoidf_(o[2]); v[3] = sigmoidf_(o[3]); }
                else v = (f32x4){0.f, 0.f, 0.f, 0.f};
                st4bf((bf16_t*)(p.ws + WS_LORAIN) + (size_t)row * LORA_W + cc, v); }
        } else {
            float* d = (float*)(p.ws + WS_CV) + (size_t)(colg >> 11) * (NB * D * CL); const int c0 = colg & (D - 1), b_ = rc >> 8;
#pragma unroll
            for (int e = 0; e < 4; ++e) d[((size_t)(b_ * D + c0 + e)) * CL + t] = o[e];
        }
    }
}

constexpr int SC_CH = 32;
constexpr int SC_NCH = (CL + SEQ) / SC_CH;
constexpr int SC_BUF_F = 6 * SC_CH * 64;
__device__ __forceinline__ int scan_row(int b, int dir, int s) {
    if (s < CL) return TL + b * CL + (dir ? CL - 1 - s : s);
    const int t = s - CL; return b * SEQ + (dir ? SEQ - 1 - t : t);
}
__device__ __forceinline__ void ph_scan(const Params& p, int l, unsigned char* lds_raw) {
    float* lds = (float*)lds_raw;
    float* ybuf = lds + 2 * SC_BUF_F;
    const int tid = p.tid, tl = tid >> 4, jq = tid & 15, ip = tid >> 4;
    for (int unit = p.bid; unit < NB * NHEAD * 2; unit += p.nblk) {
        const int dir = unit & 1, h = (unit >> 1) & (NHEAD - 1), b = unit >> 6;
        const bf16_t* kb = slot(p, 0); const bf16_t* vb = slot(p, 1); const bf16_t* rb = slot(p, 2);
        bf16_t* lw = slot(p, 3 + 2 * dir); const bf16_t* ab = slot(p, 4 + 2 * dir);
        const int col0 = h * HN + 4 * jq;
        const f32x4 kkw = *(const f32x4*)(inp(p, I_KK) + l * D + col0), kaw = *(const f32x4*)(inp(p, I_KA) + l * D + col0);
        float S0[4] = {0.f, 0.f, 0.f, 0.f}, S1[4] = {0.f, 0.f, 0.f, 0.f};
        u32x2 gk, gv, gr, gw, ga;
        auto gload = [&](int c) { const size_t off = (size_t)scan_row(b, dir, c * SC_CH + tl) * D + col0;
            gk = *(const u32x2*)(kb + off); gv = *(const u32x2*)(vb + off); gr = *(const u32x2*)(rb + off); gw = *(const u32x2*)(lw + off); ga = *(const u32x2*)(ab + off); };
        auto gstage = [&](int buf) { float* B = lds + buf * SC_BUF_F + tl * 64 + 4 * jq;
            const f32x4 k4 = (f32x4){bflo(gk.x), bfhi(gk.x), bflo(gk.y), bfhi(gk.y)}, a4 = (f32x4){bflo(ga.x), bfhi(ga.x), bflo(ga.y), bfhi(ga.y)};
            const f32x4 w4 = (f32x4){__expf(bflo(gw.x)), __expf(bfhi(gw.x)), __expf(bflo(gw.y)), __expf(bfhi(gw.y))};
            const f32x4 kx = k4 * kkw; float ss = kx[0] * kx[0] + kx[1] * kx[1] + kx[2] * kx[2] + kx[3] * kx[3]; ss = red16(ss);
            const f32x4 kk = kx * rsqrtf(fmaxf(ss, 1e-24f));
            *(f32x4*)(B) = kk; *(f32x4*)(B + SC_CH * 64) = w4; *(f32x4*)(B + 2 * SC_CH * 64) = kk * a4; *(f32x4*)(B + 3 * SC_CH * 64) = k4 * ((a4 - 1.0f) * kaw + 1.0f);
            *(f32x4*)(B + 4 * SC_CH * 64) = (f32x4){bflo(gr.x), bfhi(gr.x), bflo(gr.y), bfhi(gr.y)}; *(f32x4*)(B + 5 * SC_CH * 64) = (f32x4){bflo(gv.x), bfhi(gv.x), bflo(gv.y), bfhi(gv.y)}; };
        __syncthreads();
        gload(0); gstage(0);
        __syncthreads();
        for (int c = 0; c < SC_NCH; ++c) {
            const int buf = c & 1;
            if (c + 1 < SC_NCH) gload(c + 1);
            if (c > 0) {
                const float* Y = ybuf + (buf ^ 1) * (SC_CH * 64) + tl * 64 + 4 * jq; const f32x4 yv = *(const f32x4*)Y;
                st4bf(lw + (size_t)scan_row(b, dir, (c - 1) * SC_CH + tl) * D + col0, yv); }
            const float* B = lds + buf * SC_BUF_F + 4 * jq; float* Yw = ybuf + buf * (SC_CH * 64);
#pragma unroll 4
            for (int s = 0; s < SC_CH; ++s) {
                const f32x4 kk = *(const f32x4*)(B + s * 64), w = *(const f32x4*)(B + SC_CH * 64 + s * 64), ka = *(const f32x4*)(B + 2 * SC_CH * 64 + s * 64),
                            kt = *(const f32x4*)(B + 3 * SC_CH * 64 + s * 64), rr = *(const f32x4*)(B + 4 * SC_CH * 64 + s * 64);
                const f32x2 vv = *(const f32x2*)(lds + buf * SC_BUF_F + 5 * SC_CH * 64 + s * 64 + 2 * ip);
                float d0 = S0[0] * kk[0] + S0[1] * kk[1] + S0[2] * kk[2] + S0[3] * kk[3];
                float d1 = S1[0] * kk[0] + S1[1] * kk[1] + S1[2] * kk[2] + S1[3] * kk[3];
                d0 = red16(d0); d1 = red16(d1);
#pragma unroll
                for (int e = 0; e < 4; ++e) { S0[e] = S0[e] * w[e] + vv.x * kt[e] - d0 * ka[e]; S1[e] = S1[e] * w[e] + vv.y * kt[e] - d1 * ka[e]; }
                float y0 = S0[0] * rr[0] + S0[1] * rr[1] + S0[2] * rr[2] + S0[3] * rr[3];
                float y1 = S1[0] * rr[0] + S1[1] * rr[1] + S1[2] * rr[2] + S1[3] * rr[3];
                y0 = red16(y0); y1 = red16(y1);
                if (jq == 0) *(f32x2*)(Yw + s * 64 + 2 * ip) = (f32x2){y0, y1};
            }
            if (c + 1 < SC_NCH) gstage(buf ^ 1);
            __syncthreads();
        }
        { const float* Y = ybuf + ((SC_NCH - 1) & 1) * (SC_CH * 64) + tl * 64 + 4 * jq; const f32x4 yv = *(const f32x4*)Y;
          st4bf(lw + (size_t)scan_row(b, dir, (SC_NCH - 1) * SC_CH + tl) * D + col0, yv); }
    }
}

__device__ __forceinline__ void ph_rwkv_out(const Params& p, int l, int M, unsigned char* lds_raw) {
    constexpr int RB = 8;
    float* sb = (float*)lds_raw;
    const int tid = p.tid, col = 4 * tid;
    const f32x4 lnw = *(const f32x4*)(inp(p, I_LNW) + l * D + col), lnb = *(const f32x4*)(inp(p, I_LNB) + l * D + col), rk = *(const f32x4*)(inp(p, I_RK) + l * D + col);
    const float* g2 = inp(p, I_G2) + (size_t)l * 64 * D;
    const bf16_t* kb = slot(p, 0); const bf16_t* vb = slot(p, 1); const bf16_t* rb = slot(p, 2); const bf16_t* yf = slot(p, 3); const bf16_t* yb = slot(p, 5);
    const bf16_t* lora = (const bf16_t*)(p.ws + WS_LORAIN); bf16_t* out = slot(p, 6);
    for (int row0 = p.bid * RB; row0 < M; row0 += p.nblk * RB) {
        __syncthreads();
        { const int r = tid >> 6, i = tid & 63; sb[i * RB + r] = bf2f(lora[(size_t)(row0 + r) * LORA_W + (i < 32 ? 96 + i : 224 + (i - 32))]); }
        __syncthreads();
        f32x4 g[RB];
#pragma unroll
        for (int r = 0; r < RB; ++r) g[r] = (f32x4){0.f, 0.f, 0.f, 0.f};
#pragma unroll 1
        for (int ib = 0; ib < 64; ib += 16) {
            f32x4 w[16];
#pragma unroll
            for (int i = 0; i < 16; ++i) w[i] = *(const f32x4*)(g2 + (size_t)(ib + i) * D + col);
#pragma unroll
            for (int i = 0; i < 16; ++i) { const f32x4 s0 = *(const f32x4*)(sb + (ib + i) * RB), s1 = *(const f32x4*)(sb + (ib + i) * RB + 4);
#pragma unroll
                for (int r = 0; r < 4; ++r) { g[r] += w[i] * s0[r]; g[4 + r] += w[i] * s1[r]; } } }
        u32x2 ya[RB], yb2[RB], kk2[RB], vv2[RB], rr2[RB];
#pragma unroll
        for (int r = 0; r < RB; ++r) { const size_t off = (size_t)(row0 + r) * D + col;
            ya[r] = *(const u32x2*)(yf + off); yb2[r] = *(const u32x2*)(yb + off); kk2[r] = *(const u32x2*)(kb + off); vv2[r] = *(const u32x2*)(vb + off); rr2[r] = *(const u32x2*)(rb + off); }
#pragma unroll
        for (int r = 0; r < RB; ++r) {
            const size_t off = (size_t)(row0 + r) * D + col;
            const u32x2 a = ya[r], b = yb2[r], k2 = kk2[r], v2 = vv2[r], r2 = rr2[r];
            const f32x4 y = (f32x4){bflo(a.x) + bflo(b.x), bfhi(a.x) + bfhi(b.x), bflo(a.y) + bflo(b.y), bfhi(a.y) + bfhi(b.y)};
            const f32x4 k4 = (f32x4){bflo(k2.x), bfhi(k2.x), bflo(k2.y), bfhi(k2.y)}, v4 = (f32x4){bflo(v2.x), bfhi(v2.x), bflo(v2.y), bfhi(v2.y)}, r4 = (f32x4){bflo(r2.x), bfhi(r2.x), bflo(r2.y), bfhi(r2.y)};
            const float mu = red16(y[0] + y[1] + y[2] + y[3]) * (1.0f / HN);
            const f32x4 dy = y - mu;
            const float var = red16(dy[0] * dy[0] + dy[1] * dy[1] + dy[2] * dy[2] + dy[3] * dy[3]) * (1.0f / HN);
            const f32x4 yn = dy * rsqrtf(var + GN_EPS) * lnw + lnb;
            const f32x4 rkk = r4 * k4 * rk;
            const float bon = red16(rkk[0] + rkk[1] + rkk[2] + rkk[3]);
            st4bf(out + off, (yn + v4 * bon) * g[r]);
        }
    }
}

constexpr int S3_NS = 5, S3_NCH = (CL + SEQ) / 16;
constexpr int S3_SLOT = 18432;
constexpr int S3_OXQ1 = 0, S3_OXY = 3328, S3_OKAP = 6656, S3_OVU = 11776, S3_OTX = 16896, S3_OG = 18176;
constexpr int S3_PSCR = 8192;
constexpr int S3_OAL = 0, S3_OKH = 2304, S3_OAF = 4608, S3_ORN = 5632;
constexpr int S3_CSCR = 3584;
constexpr int S3_RING = 0, S3_PBASE = S3_RING + S3_NS * S3_SLOT, S3_CBASE = S3_PBASE + 4 * S3_PSCR, S3_FLAGS = S3_CBASE + 4 * S3_CSCR, S3_END = S3_FLAGS + 64;
static_assert(S3_END <= LDS_BYTES - 64, "scan LDS layout");
constexpr unsigned S3_SPIN_CAP = 1u << 22;
typedef short bf16x8_t __attribute__((ext_vector_type(8)));
__device__ __forceinline__ bf16x8_t ldfrag(const bf16_t* p) { return *(const bf16x8_t*)p; }
__device__ __forceinline__ f32x4 mma(const bf16x8_t a, const bf16x8_t b, const f32x4 c) { return __builtin_amdgcn_mfma_f32_16x16x32_bf16(a, b, c, 0, 0, 0); }
__device__ __forceinline__ bf16_t cvbf(float x) { return (bf16_t)(pg8::cvt_pk_bf16(x, 0.f) & 0xFFFFu); }
#define S3_LGKM() asm volatile("s_waitcnt lgkmcnt(0)" ::: "memory")
__device__ __forceinline__ void ph_scan3(const Params& p, int l, unsigned char* lds) {
    const int tid = p.tid, lane = tid & 63, wid = __builtin_amdgcn_readfirstlane(tid >> 6), fr = lane & 15, fq = lane >> 4;
    LAS unsigned* flags = (LAS unsigned*)(lds + S3_FLAGS);
#define S3_FLD(i) __hip_atomic_load(flags + (i), __ATOMIC_RELAXED, __HIP_MEMORY_SCOPE_WORKGROUP)
#define S3_FST(i, v) __hip_atomic_store(flags + (i), (v), __ATOMIC_RELAXED, __HIP_MEMORY_SCOPE_WORKGROUP)
    const bf16_t* kb = slot(p, 0); const bf16_t* vb = slot(p, 1); const bf16_t* rb = slot(p, 2);
    const f32x4 zero4 = (f32x4){0.f, 0.f, 0.f, 0.f};
    for (int unit = p.bid; unit < NB * NHEAD * 2; unit += p.nblk) {
        const int dir = unit & 1, h = (unit >> 1) & (NHEAD - 1), b = unit >> 6;
        bf16_t* lwy = slot(p, 3 + 2 * dir); const bf16_t* ab = slot(p, 4 + 2 * dir);
        const long rstride = dir ? -(long)D : (long)D;
        __syncthreads();
        for (int i = tid; i < S3_END / 4; i += NTHREADS) ((unsigned*)lds)[i] = 0u;
        __syncthreads();
        if (wid >= 4) {
            const int pw = wid - 4;
            unsigned char* scr = lds + S3_PBASE + pw * S3_PSCR;
            bf16_t* AL = (bf16_t*)(scr + S3_OAL); bf16_t* KH = (bf16_t*)(scr + S3_OKH); float* AF = (float*)(scr + S3_OAF); float* RN = (float*)(scr + S3_ORN);
            const float kkj = inp(p, I_KK)[l * D + h * HN + lane], kaj = inp(p, I_KA)[l * D + h * HN + lane];
            const int rt = lane >> 2, rp = lane & 3;
            const float* kkp = inp(p, I_KK) + l * D + h * HN + 16 * rp;
            const f32x4 kc0 = *(const f32x4*)kkp, kc1 = *(const f32x4*)(kkp + 4), kc2 = *(const f32x4*)(kkp + 8), kc3 = *(const f32x4*)(kkp + 12);
            typedef unsigned short u16x2 __attribute__((ext_vector_type(2)));
            u16x2 kq[8], rq[8], lq[8], aq[8], vq[8]; u32x4 kn0, kn1;
#define S3_FETCH(cc, K_, R_, L_, A_, V_, N0_, N1_) do { const size_t o_ = (size_t)scan_row(b, dir, 16 * (cc)) * D + h * HN; \
                const bf16_t* kp_ = kb + o_ + lane; const bf16_t* rp_ = rb + o_ + lane; const bf16_t* lp_ = lwy + o_ + lane; const bf16_t* ap_ = ab + o_ + lane; const bf16_t* vp_ = vb + o_ + lane; \
                _Pragma("unroll") for (int t = 0; t < 16; ++t) { K_[t >> 1][t & 1] = *kp_; R_[t >> 1][t & 1] = *rp_; L_[t >> 1][t & 1] = *lp_; A_[t >> 1][t & 1] = *ap_; V_[t >> 1][t & 1] = *vp_; kp_ += rstride; rp_ += rstride; lp_ += rstride; ap_ += rstride; vp_ += rstride; } \
                const bf16_t* kr_ = kb + o_ + (long)rt * rstride + 16 * rp; N0_ = *(const u32x4*)kr_; N1_ = *(const u32x4*)(kr_ + 8); } while (0)
            S3_FETCH(pw, kq, rq, lq, aq, vq, kn0, kn1);
#pragma unroll 1
            for (int c = pw; c < S3_NCH; c += 4) {
                const int sl = c % S3_NS; unsigned char* sb = lds + S3_RING + sl * S3_SLOT;
                bf16_t* XQ1 = (bf16_t*)(sb + S3_OXQ1); bf16_t* XY = (bf16_t*)(sb + S3_OXY); bf16_t* KAP = (bf16_t*)(sb + S3_OKAP); bf16_t* VU = (bf16_t*)(sb + S3_OVU); bf16_t* TX = (bf16_t*)(sb + S3_OTX); float* G = (float*)(sb + S3_OG);
                u16x2 kq2[8], rq2[8], lq2[8], aq2[8], vq2[8]; u32x4 kn2, kn3;
                { const int cn = c + 4 < S3_NCH ? c + 4 : c; S3_FETCH(cn, kq2, rq2, lq2, aq2, vq2, kn2, kn3); }
                { const u32x4 w0 = kn0, w1 = kn1;
                  const float x0 = bflo(w0[0]) * kc0[0], x1 = bfhi(w0[0]) * kc0[1], x2 = bflo(w0[1]) * kc0[2], x3 = bfhi(w0[1]) * kc0[3], x4 = bflo(w0[2]) * kc1[0], x5 = bfhi(w0[2]) * kc1[1], x6 = bflo(w0[3]) * kc1[2], x7 = bfhi(w0[3]) * kc1[3];
                  const float y0 = bflo(w1[0]) * kc2[0], y1 = bfhi(w1[0]) * kc2[1], y2 = bflo(w1[1]) * kc2[2], y3 = bfhi(w1[1]) * kc2[3], y4 = bflo(w1[2]) * kc3[0], y5 = bfhi(w1[2]) * kc3[1], y6 = bflo(w1[3]) * kc3[2], y7 = bfhi(w1[3]) * kc3[3];
                  float ss = x0 * x0 + x1 * x1 + x2 * x2 + x3 * x3 + x4 * x4 + x5 * x5 + x6 * x6 + x7 * x7 + y0 * y0 + y1 * y1 + y2 * y2 + y3 * y3 + y4 * y4 + y5 * y5 + y6 * y6 + y7 * y7;
                  ss += dppf<0xB1>(ss); ss += dppf<0x4E>(ss);
                  if (rp == 0) RN[rt] = rsqrtf(fmaxf(ss, 1e-24f)); }
                if (c >= S3_NS) { const unsigned need = (unsigned)(c - S3_NS + 1); unsigned sp = 0;
                    for (;;) { const unsigned m0 = S3_FLD(8), m1 = S3_FLD(9), m2 = S3_FLD(10), m3 = S3_FLD(11); const unsigned mn = min(min(m0, m1), min(m2, m3));
                        if (mn >= need || ++sp > S3_SPIN_CAP) break; __builtin_amdgcn_s_sleep(1); } }
                asm volatile("" ::: "memory");
                S3_LGKM();
                { float cl[16]; float run = 0.f;
#pragma unroll
                  for (int t = 0; t < 16; ++t) { run += bf2f(lq[t >> 1][t & 1]); cl[t] = run; }
                  const float cend = cl[15], gend = __expf(cend); G[lane] = gend;
                  unsigned kp[8], ap[8], vv[8]; float epm1 = 1.0f;
#pragma unroll
                  for (int t = 0; t < 16; ++t) {
                      const float em = __expf(-cl[t]), ep = __builtin_amdgcn_rcpf(em), ee = gend * em;
                      const float kv = bf2f(kq[t >> 1][t & 1]), a = bf2f(aq[t >> 1][t & 1]), kap = kv * kkj * RN[t], al = a * kap, kt = kv * (1.0f + (a - 1.0f) * kaj);
                      XQ1[t * 104 + lane] = cvbf(epm1 * kap); AL[t * 72 + lane] = cvbf(al * em); KH[t * 72 + lane] = cvbf(kt * em); XY[t * 104 + lane] = cvbf(bf2f(rq[t >> 1][t & 1]) * ep);
                      const unsigned kpb = cvbf(kt * ee), apb = cvbf(al * ee);
                      if (t & 1) { kp[t >> 1] |= kpb << 16; ap[t >> 1] |= apb << 16; } else { kp[t >> 1] = kpb; ap[t >> 1] = apb; vv[t >> 1] = __builtin_bit_cast(unsigned, vq[t >> 1]); }
                      epm1 = ep; }
                  u32x4* d = (u32x4*)(KAP + lane * 40);
                  d[0] = (u32x4){kp[0], kp[1], kp[2], kp[3]}; d[1] = (u32x4){kp[4], kp[5], kp[6], kp[7]}; d[2] = (u32x4){ap[0], ap[1], ap[2], ap[3]}; d[3] = (u32x4){ap[4], ap[5], ap[6], ap[7]};
                  u32x4* dv = (u32x4*)(VU + lane * 40); dv[0] = (u32x4){vv[0], vv[1], vv[2], vv[3]}; dv[1] = (u32x4){vv[4], vv[5], vv[6], vv[7]}; }
                S3_LGKM();
                { const bf16_t* Xk = XQ1 + fr * 104 + 8 * fq; const bf16_t* Xr = XY + fr * 104 + 8 * fq; const bf16_t* Ya = AL + fr * 72 + 8 * fq; const bf16_t* Yk = KH + fr * 72 + 8 * fq;
                  f32x4 dA = zero4, dB = zero4, dE = zero4, dF = zero4;
#pragma unroll
                  for (int ks = 0; ks < 2; ++ks) { const bf16x8_t xk = ldfrag(Xk + 32 * ks), xr = ldfrag(Xr + 32 * ks), ya = ldfrag(Ya + 32 * ks), yk = ldfrag(Yk + 32 * ks);
                      dA = mma(xk, ya, dA); dB = mma(xk, yk, dB); dE = mma(xr, yk, dE); dF = mma(xr, ya, dF); }
#pragma unroll
                  for (int e = 0; e < 4; ++e) { const int t = 4 * fq + e; const bool lo = fr < t, le = fr <= t;
                      dA[e] = lo ? dA[e] : 0.f; XQ1[t * 104 + 64 + fr] = cvbf(lo ? dB[e] : 0.f); XY[t * 104 + 64 + fr] = cvbf(le ? dE[e] : 0.f); XY[t * 104 + 80 + fr] = cvbf(le ? dF[e] : 0.f); }
                  float tc[16];
#pragma unroll
                  for (int t = 0; t < 16; ++t) { float v0 = (t == fr) ? 1.0f : 0.0f, v1 = 0.f;
#pragma unroll
                      for (int s = 0; s < t; ++s) { const float a = rdlane(dA[t & 3], 16 * (t >> 2) + s); if (s & 1) v1 -= a * tc[s]; else v0 -= a * tc[s]; }
                      tc[t] = v0 + v1; }
                  if (fq == 0) {
#pragma unroll
                      for (int t = 0; t < 16; ++t) TX[t * 40 + fr] = cvbf(tc[t]); } }
                S3_LGKM();
                if (lane == 0) S3_FST(sl, (unsigned)(c + 1));
#pragma unroll
                for (int t = 0; t < 8; ++t) { kq[t] = kq2[t]; rq[t] = rq2[t]; lq[t] = lq2[t]; aq[t] = aq2[t]; vq[t] = vq2[t]; }
                kn0 = kn2; kn1 = kn3;
            }
#undef S3_FETCH
        } else {
            const int it = wid;
            unsigned char* scr = lds + S3_CBASE + it * S3_CSCR;
            bf16_t* SB = (bf16_t*)scr; bf16_t* RT = (bf16_t*)(scr + 2304);
            f32x4 Sacc[4] = {zero4, zero4, zero4, zero4};
#pragma unroll 1
            for (int c = 0; c < S3_NCH; ++c) {
                const int sl = c % S3_NS; unsigned char* sb = lds + S3_RING + sl * S3_SLOT;
                const bf16_t* XQ1 = (const bf16_t*)(sb + S3_OXQ1); const bf16_t* XY = (const bf16_t*)(sb + S3_OXY); const bf16_t* KAP = (const bf16_t*)(sb + S3_OKAP); bf16_t* VU = (bf16_t*)(sb + S3_OVU); const bf16_t* TX = (const bf16_t*)(sb + S3_OTX); const float* G = (const float*)(sb + S3_OG);
                { unsigned sp = 0; while (S3_FLD(sl) != (unsigned)(c + 1)) { if (++sp > S3_SPIN_CAP) break; __builtin_amdgcn_s_sleep(1); } }
                asm volatile("" ::: "memory");
                const bf16_t* Ys = SB + fr * 72 + 8 * fq; bf16_t* VUr = VU + (16 * it + fr) * 40;
                { const bf16_t* X = XQ1 + fr * 104 + 8 * fq;
                  f32x4 d = mma(ldfrag(X), ldfrag(Ys), zero4); d = mma(ldfrag(X + 32), ldfrag(Ys + 32), d); d = mma(ldfrag(X + 64), ldfrag(VUr + 8 * fq), d);
                  *(u32x2*)(RT + fr * 40 + 4 * fq) = (u32x2){pg8::cvt_pk_bf16(d[0], d[1]), pg8::cvt_pk_bf16(d[2], d[3])}; }
                S3_LGKM();
                { const f32x4 d = mma(ldfrag(TX + fr * 40 + 8 * fq), ldfrag(RT + fr * 40 + 8 * fq), zero4);
                  *(u32x2*)(VUr + 16 + 4 * fq) = (u32x2){pg8::cvt_pk_bf16(-d[0], -d[1]), pg8::cvt_pk_bf16(-d[2], -d[3])}; }
                S3_LGKM();
                const bf16x8_t vu = ldfrag(VUr + 8 * fq);
                { const bf16_t* X = XY + fr * 104 + 8 * fq;
                  f32x4 d = mma(ldfrag(X), ldfrag(Ys), zero4); d = mma(ldfrag(X + 32), ldfrag(Ys + 32), d); d = mma(ldfrag(X + 64), vu, d);
                  bf16_t* yo = lwy + (size_t)scan_row(b, dir, 16 * c + 4 * fq) * D + h * HN + 16 * it + fr;
#pragma unroll
                  for (int e = 0; e < 4; ++e) { *yo = cvbf(d[e]); yo += rstride; } }
#pragma unroll
                for (int jt = 0; jt < 4; ++jt) Sacc[jt] = mma(vu, ldfrag(KAP + (16 * jt + fr) * 40 + 8 * fq), Sacc[jt] * G[16 * jt + fr]);
#pragma unroll
                for (int jt = 0; jt < 4; ++jt)
#pragma unroll
                    for (int e = 0; e < 4; ++e) SB[(4 * fq + e) * 72 + 16 * jt + fr] = cvbf(Sacc[jt][e]);
                S3_LGKM();
                if (lane == 0) S3_FST(8 + it, (unsigned)(c + 1));
            }
        }
    }
    __syncthreads();
}

__device__ __forceinline__ float hy_delta(int c) { return 3.0701134573f + (float)c * ((15.3505672866f - 3.0701134573f) / 2047.0f); }
__device__ __forceinline__ void ph_ctxfilter(const Params& p, int l) {
    const bf16_t* hd = (const bf16_t*)(p.ws + WS_HDNC); const float* w3 = inp(p, I_HW3) + (size_t)l * 64 * 8192; float* hcf = (float*)(p.ws + WS_HCF);
    const int gt = p.bid * NTHREADS + p.tid, GT = p.nblk * NTHREADS;
    if (GT % 8192 == 0) {
        const int col = gt % 8192; float wc[64];
#pragma unroll
        for (int k = 0; k < 64; ++k) wc[k] = w3[(size_t)k * 8192 + col];
        const float dl = hy_delta(col & (D - 1));
        for (int n = gt / 8192; n < CL; n += GT / 8192) { u32x4 hv[8];
#pragma unroll
            for (int k8 = 0; k8 < 8; ++k8) hv[k8] = *(const u32x4*)(hd + n * 256 + 8 * k8);
            float s = 0.f;
#pragma unroll
            for (int k8 = 0; k8 < 8; ++k8)
#pragma unroll
                for (int e = 0; e < 4; ++e) s += bflo(hv[k8][e]) * wc[8 * k8 + 2 * e] + bfhi(hv[k8][e]) * wc[8 * k8 + 2 * e + 1];
            hcf[(size_t)col * CL + n] = s * __expf(-((float)n / (float)(CL - 1)) * dl); }
    } else {
        for (int i = gt; i < 8192 * CL; i += GT) {
            const int col = i % 8192, n = i / 8192; float s = 0.f;
            for (int k = 0; k < 64; ++k) s += bf2f(hd[n * 256 + k]) * w3[(size_t)k * 8192 + col];
            hcf[(size_t)col * CL + n] = s * __expf(-((float)n / (float)(CL - 1)) * hy_delta(col & (D - 1))); }
    }
}
__device__ __forceinline__ void ph_ctxhyena(const Params& p, int l, unsigned char* lds_raw) {
    const int lane = p.tid & 63, wid = p.tid >> 6, wv = p.bid * 8 + wid, NW = p.nblk * 8;
    float* L = (float*)lds_raw + wid * 768;
    const float* hcf = (const float*)(p.ws + WS_HCF); const float* cv = (const float*)(p.ws + WS_CV); float* yhc = (float*)(p.ws + WS_YHC);
    for (int u = wv; u < NB * D; u += NW) {
        const int c = u & (D - 1), b = u >> 11;
        f32x4 z = *(const f32x4*)(cv + ((size_t)(b * D + c)) * CL + 4 * lane);
#pragma unroll
        for (int o = 0; o < 2; ++o) {
            const f32x4 f = *(const f32x4*)(hcf + ((size_t)((o * 2 + 0) * D + c)) * CL + 4 * lane), g = *(const f32x4*)(hcf + ((size_t)((o * 2 + 1) * D + c)) * CL + 4 * lane);
            float ss = 0.f;
#pragma unroll
            for (int i = 0; i < 4; ++i) { const int n = 4 * lane + i; if (n == 0) L[256 + 255] = f[i] + g[i]; else { L[256 + 255 - n] = f[i]; L[256 + 255 + n] = g[i]; } ss += f[i] * f[i] + g[i] * g[i]; }
            *(f32x4*)(L + 4 * lane) = z;
            ss = wave_sum(ss); const float rn = rsqrtf(ss);
            const float sk = inp(p, I_HSKIP)[(l * 2 + o) * D + c];
            const float* gate = cv + (size_t)(o + 1) * (NB * D * CL) + ((size_t)(b * D + c)) * CL;
            f32x4 acc = (f32x4){0.f, 0.f, 0.f, 0.f};
            const float* hb = L + 256 + 252 - 4 * lane;
#pragma unroll 4
            for (int s0 = 0; s0 < CL; s0 += 4) { const f32x4 us = *(const f32x4*)(L + s0), wa = *(const f32x4*)(hb + s0), wb = *(const f32x4*)(hb + s0 + 4);
                const float W[8] = {wa[0], wa[1], wa[2], wa[3], wb[0], wb[1], wb[2], wb[3]};
#pragma unroll
                for (int i = 0; i < 4; ++i)
#pragma unroll
                    for (int q = 0; q < 4; ++q) acc[i] += W[3 - i + q] * us[q]; }
            const f32x4 gt = *(const f32x4*)(gate + 4 * lane);
            z = gt * (acc * rn + z * sk);
        }
        *(f32x4*)(yhc + ((size_t)(b * D + c)) * CL + 4 * lane) = z;
    }
}

__device__ __forceinline__ f32x2 cmul(const f32x2 a, const f32x2 b) {
    const f32x2 t = a * __builtin_shufflevector(b, b, 0, 0);
    return __builtin_elementwise_fma(__builtin_shufflevector(a, a, 1, 0), (f32x2){-b.y, b.y}, t); }
__device__ __forceinline__ f32x2 cconj(const f32x2 a) { return (f32x2){a.x, -a.y}; }
template <bool INV> __device__ __forceinline__ void dft4(f32x2& a, f32x2& b, f32x2& c, f32x2& d) {
    const f32x2 s0 = a + c, s1 = a - c, s2 = b + d, s3 = b - d;
    const f32x2 r = __builtin_shufflevector(s3, s3, 1, 0); const f32x2 sg = INV ? (f32x2){-1.f, 1.f} : (f32x2){1.f, -1.f};
    a = s0 + s2; c = s0 - s2; b = __builtin_elementwise_fma(r, sg, s1); d = __builtin_elementwise_fma(r, -sg, s1);
}
template <bool INV> __device__ __forceinline__ void dft16(f32x2 (&x)[16]) {
    constexpr float C[10] = {1.f, 0.92387953251f, 0.70710678119f, 0.38268343237f, 0.f, 0.f, -0.70710678119f, 0.f, 0.f, -0.92387953251f};
    constexpr float S[10] = {0.f, 0.38268343237f, 0.70710678119f, 0.92387953251f, 1.f, 0.f, 0.70710678119f, 0.f, 0.f, -0.38268343237f};
#pragma unroll
    for (int n1 = 0; n1 < 4; ++n1) dft4<INV>(x[n1], x[n1 + 4], x[n1 + 8], x[n1 + 12]);
#pragma unroll
    for (int n1 = 1; n1 < 4; ++n1)
#pragma unroll
        for (int k2 = 1; k2 < 4; ++k2) { const int m = n1 * k2; x[n1 + 4 * k2] = cmul(x[n1 + 4 * k2], (f32x2){C[m], INV ? S[m] : -S[m]}); }
#pragma unroll
    for (int k2 = 0; k2 < 4; ++k2) dft4<INV>(x[4 * k2], x[4 * k2 + 1], x[4 * k2 + 2], x[4 * k2 + 3]);
    f32x2 y[16];
#pragma unroll
    for (int k1 = 0; k1 < 4; ++k1)
#pragma unroll
        for (int k2 = 0; k2 < 4; ++k2) y[4 * k1 + k2] = x[4 * k2 + k1];
#pragma unroll
    for (int k = 0; k < 16; ++k) x[k] = y[k];
}
__device__ __forceinline__ int zpad(int pidx) { return pidx + 2 * (pidx >> 4); }
constexpr int ZN = 18432;

__device__ __forceinline__ f32x2 twf(int j) { float x = (float)j * (1.0f / 32768.0f); asm volatile("" : "+v"(x));
    return (f32x2){__builtin_amdgcn_cosf(x), -__builtin_amdgcn_sinf(x)}; }
struct HyRaw { f32x2 a, b, c; unsigned w; unsigned short s0, s1, s2, s3; };
template <bool INV> __device__ __forceinline__ void dft32(f32x2 (&x)[32]) {
    constexpr float C[16] = {1.f, 0.98078528040f, 0.92387953251f, 0.83146961230f, 0.70710678119f, 0.55557023302f, 0.38268343237f, 0.19509032202f,
                             0.f, -0.19509032202f, -0.38268343237f, -0.55557023302f, -0.70710678119f, -0.83146961230f, -0.92387953251f, -0.98078528040f};
    constexpr float S[16] = {0.f, 0.19509032202f, 0.38268343237f, 0.55557023302f, 0.70710678119f, 0.83146961230f, 0.92387953251f, 0.98078528040f,
                             1.f, 0.98078528040f, 0.92387953251f, 0.83146961230f, 0.70710678119f, 0.55557023302f, 0.38268343237f, 0.19509032202f};
    f32x2 e[16], o[16];
#pragma unroll
    for (int k = 0; k < 16; ++k) { e[k] = x[2 * k]; o[k] = x[2 * k + 1]; }
    __builtin_amdgcn_sched_barrier(0); dft16<INV>(e); __builtin_amdgcn_sched_barrier(0); dft16<INV>(o); __builtin_amdgcn_sched_barrier(0);
#pragma unroll
    for (int k = 0; k < 16; ++k) { const f32x2 t = cmul(o[k], (f32x2){C[k], INV ? S[k] : -S[k]}); x[k] = e[k] + t; x[k + 16] = e[k] - t; }
}
template <class Ld, class Mk> __device__ __forceinline__ void fft_fwdA(f32x2* Z, int tid, Ld ld, Mk mk) {
    __syncthreads();
    asm volatile("" : "+v"(tid));
    f32x2 x[32];
#pragma unroll
    for (int h = 0; h < 2; ++h) { HyRaw raw[16];
#pragma unroll
      for (int i = 0; i < 16; ++i) raw[i] = ld((16 * h + i) * 512 + tid);
#pragma unroll
      for (int i = 0; i < 16; ++i) x[16 * h + i] = mk((16 * h + i) * 512 + tid, raw[i]);
      __builtin_amdgcn_sched_barrier(0); }
    dft32<false>(x);
    const f32x2 w1 = twf(2 * tid); f32x2 wk = w1;
    Z[zpad(tid)] = x[0];
#pragma unroll
    for (int k = 1; k < 32; ++k) { Z[zpad(k * 512 + tid)] = cmul(x[k], wk); wk = cmul(wk, w1); }
    __syncthreads();
}
__device__ __forceinline__ void fft_fwdB(f32x2* Z, int tid) {
    asm volatile("" : "+v"(tid));
    const int blk = tid >> 4, n2 = tid & 15, base = blk * 512 + n2;
    const f32x2 w1 = twf(64 * n2);
    f32x2 x[32];
#pragma unroll
    for (int n1 = 0; n1 < 32; ++n1) x[n1] = Z[zpad(base + n1 * 16)];
    dft32<false>(x);
    f32x2 wk = w1;
    Z[zpad(base)] = x[0];
#pragma unroll
    for (int k = 1; k < 32; ++k) { Z[zpad(base + k * 16)] = cmul(x[k], wk); wk = cmul(wk, w1); }
    __syncthreads();
}
__device__ __forceinline__ void fft_invB(f32x2* Z, int tid) {
    asm volatile("" : "+v"(tid));
    const int blk = tid >> 4, n2 = tid & 15, base = blk * 512 + n2;
    const f32x2 w1 = cconj(twf(64 * n2)); f32x2 wk = w1;
    f32x2 x[32];
    x[0] = Z[zpad(base)];
#pragma unroll
    for (int k = 1; k < 32; ++k) { x[k] = cmul(Z[zpad(base + k * 16)], wk); wk = cmul(wk, w1); }
    dft32<true>(x);
#pragma unroll
    for (int n1 = 0; n1 < 32; ++n1) Z[zpad(base + n1 * 16)] = x[n1];
    __syncthreads();
}
__device__ __forceinline__ unsigned cpk(const f32x2 v) { return pg8::cvt_pk_bf16(v.x, v.y); }
__device__ __forceinline__ f32x2 cunpk(unsigned w) { return (f32x2){bflo(w), bfhi(w)}; }
__device__ __forceinline__ void fft_fwd_rest_to_stash(f32x2* Z, int tid, unsigned (&g)[32]) {
    fft_fwdB(Z, tid);
    asm volatile("" : "+v"(tid));
#pragma unroll
    for (int j = 0; j < 2; ++j) { const int q = tid + 512 * j; f32x2 x[16];
#pragma unroll
        for (int n1 = 0; n1 < 16; ++n1) x[n1] = Z[18 * q + n1];
        dft16<false>(x);
#pragma unroll
        for (int k = 0; k < 16; ++k) g[j * 16 + k] = cpk(x[k]);
        __builtin_amdgcn_sched_barrier(0); }
}
template <class Ld, class Out> __device__ __forceinline__ void fft_conv_rest(f32x2* Z, int tid, const unsigned (&g)[32], Ld ld, Out out) {
    fft_fwdB(Z, tid);
    asm volatile("" : "+v"(tid));
#pragma unroll
    for (int j = 0; j < 2; ++j) { const int q = tid + 512 * j; f32x2 x[16];
#pragma unroll
        for (int n1 = 0; n1 < 16; ++n1) x[n1] = Z[18 * q + n1];
        dft16<false>(x);
#pragma unroll
        for (int k = 0; k < 16; ++k) x[k] = cmul(x[k], cunpk(g[j * 16 + k]));
        dft16<true>(x);
#pragma unroll
        for (int n1 = 0; n1 < 16; ++n1) Z[18 * q + n1] = x[n1];
        __builtin_amdgcn_sched_barrier(0); }
    __syncthreads();
    fft_invB(Z, tid);
    asm volatile("" : "+v"(tid));
    { const f32x2 w1 = cconj(twf(2 * tid)); f32x2 wk = w1; f32x2 x[32];
      x[0] = Z[zpad(tid)];
#pragma unroll
      for (int k = 1; k < 32; ++k) { x[k] = cmul(Z[zpad(k * 512 + tid)], wk); wk = cmul(wk, w1); }
      dft32<true>(x);
#pragma unroll
      for (int h = 0; h < 4; ++h) { HyRaw raw[8];
#pragma unroll
          for (int i = 0; i < 8; ++i) raw[i] = ld((8 * h + i) * 512 + tid);
#pragma unroll
          for (int i = 0; i < 8; ++i) out(8 * h + i, (8 * h + i) * 512 + tid, x[8 * h + i], raw[i]);
          __builtin_amdgcn_sched_barrier(0); } }
}

template <int O> __device__ __forceinline__ void hy_order(const Params& p, int l, int c, f32x2* Z, float* red, const f32x2* tw, int tid, const bf16_t* Ht, bf16_t* hv, const bf16_t* gate, unsigned* zs) {
    unsigned gs[32];
    const float delta = hy_delta(c);
    const size_t cb0 = ((size_t)(0 * D + c)) * SEQ, cb1 = ((size_t)(1 * D + c)) * SEQ;
    const bf16_t* fw = Ht + ((size_t)((O * 2 + 0) * D + c)) * SEQ; const bf16_t* bw = Ht + ((size_t)((O * 2 + 1) * D + c)) * SEQ;
    float ssq = 0.f;
    auto ld_filt = [=](int n) { HyRaw r{}; const int nb = n == 0 ? 0 : SEQ - n; r.s0 = fw[n]; r.s1 = bw[nb]; return r; };

    auto ld_z = [=](int n) { HyRaw r{}; if (O == 0) { r.s0 = hv[cb0 + n]; r.s1 = hv[cb1 + n]; } else r.w = zs[n]; return r; };

    auto zval = [=](const HyRaw& r) { return O == 0 ? (f32x2){bf2f(r.s0), bf2f(r.s1)} : cunpk(r.w); };
    fft_fwdA(Z, tid, ld_filt, [&](int n, const HyRaw& r) { const int nb = n == 0 ? 0 : SEQ - n;
        const float f = bf2f(r.s0) * __expf(-((float)n * (1.0f / (SEQ - 1))) * delta), g = bf2f(r.s1) * __expf(-((float)nb * (1.0f / (SEQ - 1))) * delta);
        ssq += f * f + g * g; return (f32x2){f + g, 0.f}; });
    fft_fwd_rest_to_stash(Z, tid, gs);
    ssq = wave_sum(ssq); if ((tid & 63) == 0) red[tid >> 6] = ssq;
    fft_fwdA(Z, tid, ld_z, [=](int, const HyRaw& r) { return zval(r); });
    float tot = 0.f;
#pragma unroll
    for (int w = 0; w < 8; ++w) tot += red[w];
    const float scale = 0.5f * (1.0f / SEQ) * rsqrtf(tot);
    unsigned rsv[32];
    fft_conv_rest(Z, tid, gs, [=](int) { return HyRaw{}; }, [&](int i, int, f32x2 val, const HyRaw&) { rsv[i] = cpk(val * scale); });
    fft_fwdA(Z, tid, ld_filt, [=](int n, const HyRaw& r) { const int nb = n == 0 ? 0 : SEQ - n;
        const float f = bf2f(r.s0) * __expf(-((float)n * (1.0f / (SEQ - 1))) * delta), g = bf2f(r.s1) * __expf(-((float)nb * (1.0f / (SEQ - 1))) * delta);
        const float gd = n == 0 ? f + g : f - g; const f32x2 w = twf(n); return (f32x2){gd * w.x, gd * w.y}; });
    fft_fwd_rest_to_stash(Z, tid, gs);
    fft_fwdA(Z, tid, ld_z, [=](int n, const HyRaw& r) { return cmul(zval(r), twf(n)); });
    const float sk = inp(p, I_HSKIP)[(l * 2 + O) * D + c];
    fft_conv_rest(Z, tid, gs,
        [=](int n) { HyRaw r{}; if (O == 0) { r.s0 = hv[cb0 + n]; r.s1 = hv[cb1 + n]; } else r.w = zs[n]; r.s2 = gate[cb0 + n]; r.s3 = gate[cb1 + n]; return r; },
        [&](int i, int n, f32x2 val, const HyRaw& r) {
            const f32x2 cv = cunpk(rsv[i]) + cmul(val, cconj(twf(n))) * scale;
            const f32x2 zz = zval(r);
            const f32x2 res = (f32x2){bf2f(r.s2) * (cv.x + zz.x * sk), bf2f(r.s3) * (cv.y + zz.y * sk)};
            if (O == 0) zs[n] = cpk(res); else { hv[cb0 + n] = f2bf(res.x); hv[cb1 + n] = f2bf(res.y); } });
}

__device__ __forceinline__ void ph_hyena(const Params& p, int l, unsigned char* lds_raw) {
    f32x2* Z = (f32x2*)lds_raw; float* red = (float*)(lds_raw + (size_t)ZN * 8);
    const f32x2* tw = (const f32x2*)(p.ws + WS_TW);
    const int tid = p.tid;
    const bf16_t* Ht = (const bf16_t*)slot(p, 3);
    bf16_t* hv = slot(p, 0); const bf16_t* hx1 = slot(p, 1); const bf16_t* hx2 = slot(p, 2);
    unsigned* zs = (unsigned*)slot(p, 5) + (size_t)p.bid * SEQ;
#pragma unroll 1
    for (int c = p.bid; c < D; c += p.nblk) {
        hy_order<0>(p, l, c, Z, red, tw, tid, Ht, hv, hx1, zs);
        hy_order<1>(p, l, c, Z, red, tw, tid, Ht, hv, hx2, zs);
    }
}

constexpr float PEER_USCALE = 128.0f, PEER_VSCALE = 8.0f;
__device__ __forceinline__ void ph_prep2(const Params& p, int l, int M) {
    norm_rows(p, inp(p, I_N2G) + l * D, l, 3, 4, M);
}

__constant__ unsigned char c_cand[50] = {
    0x00,0x01,0x02,0x03,0x04,0x05,0x06,0x07,0x08,0x09,0x0A,0x0B,0x0C,0x0D,0x0E,0x0F, 0x10,0x11,0x12,0x13,0x14,0x15,0x16,0x17, 0x20,0x21,0x22,0x23,0x24, 0x30,0x31,0x32,0x33,
    0x40,0x41,0x42, 0x50,0x51, 0x60,0x61, 0x70,0x71, 0x80,0x90,0xA0,0xB0,0xC0,0xD0,0xE0,0xF0};
__device__ __forceinline__ unsigned fkey(float x) { const unsigned u = __float_as_uint(x); return (u & 0x80000000u) ? ~u : (u | 0x80000000u); }
__device__ __forceinline__ int mbcnt64(unsigned long long m) { return (int)__builtin_amdgcn_mbcnt_hi((unsigned)(m >> 32), __builtin_amdgcn_mbcnt_lo((unsigned)m, 0u)); }
__device__ __forceinline__ int cnt_ge2(unsigned ka, unsigned kb, unsigned c) {
    unsigned long long m; int n0, n1;
    asm volatile("v_cmp_le_u32_e64 %0, %3, %4\n\tv_cmp_le_u32_e32 vcc, %3, %5\n\ts_bcnt1_i32_b64 %1, vcc\n\ts_bcnt1_i32_b64 %2, %0"
                 : "=&s"(m), "=&s"(n0), "=&s"(n1) : "s"(c), "v"(ka), "v"(kb) : "vcc", "scc");
    return n0 + n1;
}
__device__ __forceinline__ void ph_topk(const Params& p, int M, unsigned char* lds_raw) {
    constexpr int U = 2;
    const int lane = p.tid & 63, wid = p.tid >> 6, wv = p.bid * 8 + wid, NW = p.nblk * 8, total = M * 8;
    const float* sc = (const float*)slot(p, 3); int* idx = (int*)slot(p, 2); float* gate = (float*)slot(p, 2) + (size_t)MR * 128;
    const int cand_ab = lane < 50 ? (int)c_cand[lane] : 0;
    float fn[U][4];
#pragma unroll
    for (int u = 0; u < U; ++u) { int it0 = wv + u * NW; it0 = it0 < total ? it0 : wv; if (wv < total) { const float* s = sc + (size_t)(it0 >> 3) * D + (it0 & 7) * 256;
#pragma unroll
        for (int j = 0; j < 4; ++j) fn[u][j] = s[lane + 64 * j]; } }
    for (int it = wv; it < total; it += U * NW) {
        int itu[U]; float f[U][4]; unsigned k[U][4];
#pragma unroll
        for (int u = 0; u < U; ++u) { itu[u] = it + u * NW < total ? it + u * NW : it;
#pragma unroll
            for (int j = 0; j < 4; ++j) { f[u][j] = fn[u][j]; k[u][j] = fkey(f[u][j]); } }
#pragma unroll
        for (int u = 0; u < U; ++u) { int itn = itu[u] + U * NW; itn = itn < total ? itn : itu[u]; const float* s = sc + (size_t)(itn >> 3) * D + (itn & 7) * 256;
#pragma unroll
            for (int j = 0; j < 4; ++j) fn[u][j] = s[lane + 64 * j]; }
        unsigned th[U][2];
#pragma unroll
        for (int u = 0; u < U; ++u) { th[u][0] = 0u; th[u][1] = 0u; }
#pragma unroll
        for (int bit = 31; bit >= 16; --bit)
#pragma unroll
            for (int u = 0; u < U; ++u)
#pragma unroll
                for (int pp = 0; pp < 2; ++pp) { const unsigned c = th[u][pp] | (1u << bit);
                    const int n = cnt_ge2(k[u][2 * pp], k[u][2 * pp + 1], c); th[u][pp] = n >= 16 ? c : th[u][pp]; }
#pragma unroll
        for (int u = 0; u < U; ++u)
#pragma unroll
            for (int pp = 0; pp < 2; ++pp) {
                const bool more = __popcll(__ballot(k[u][2 * pp] >= th[u][pp])) + __popcll(__ballot(k[u][2 * pp + 1] >= th[u][pp])) != 16;
                if (more) { unsigned t = th[u][pp];
#pragma unroll
                    for (int bit = 15; bit >= 0; --bit) { const unsigned c = t | (1u << bit);
                        const int n = __popcll(__ballot(k[u][2 * pp] >= c)) + __popcll(__ballot(k[u][2 * pp + 1] >= c)); t = n >= 16 ? c : t; }
                    th[u][pp] = t; } }
        float cv[U]; unsigned key[U]; int ca[U], cb[U];
#pragma unroll
        for (int u = 0; u < U; ++u) {
            unsigned* L = (unsigned*)lds_raw + (wid * U + u) * 192;
            unsigned* ck = L; unsigned* cvl = L + 32; unsigned* ci = L + 64; float* topv = (float*)(L + 96); int* topi = (int*)(L + 128);
#pragma unroll
            for (int pp = 0; pp < 2; ++pp) { const unsigned t = th[u][pp], ka = k[u][2 * pp], kb = k[u][2 * pp + 1];
                const unsigned long long ga = __ballot(ka > t), gb = __ballot(kb > t), ea = __ballot(ka == t), eb = __ballot(kb == t);
                const int need = 16 - __popcll(ga) - __popcll(gb);
                const bool sa = (ka > t) || (ka == t && mbcnt64(ea) < need), sb = (kb > t) || (kb == t && __popcll(ea) + mbcnt64(eb) < need);
                const unsigned long long ma = __ballot(sa), mb = __ballot(sb);
                const int pa = mbcnt64(ma), pb = __popcll(ma) + mbcnt64(mb);
                if (sa) { ck[pp * 16 + pa] = ka; cvl[pp * 16 + pa] = __float_as_uint(f[u][2 * pp]); ci[pp * 16 + pa] = (unsigned)lane; }
                if (sb) { ck[pp * 16 + pb] = kb; cvl[pp * 16 + pb] = __float_as_uint(f[u][2 * pp + 1]); ci[pp * 16 + pb] = (unsigned)(lane + 64); } }
            if (lane < 32) { const int pp = lane >> 4, me = lane & 15; const unsigned my = ck[lane]; int rk = 0;
#pragma unroll
                for (int j = 0; j < 16; ++j) { const unsigned o = ck[pp * 16 + j]; rk += (o > my || (o == my && j < me)) ? 1 : 0; }
                topv[pp * 16 + rk] = __uint_as_float(cvl[lane]); topi[pp * 16 + rk] = (int)ci[lane]; }
            cv[u] = 0.f; key[u] = 0u; ca[u] = 0; cb[u] = 0;
            if (lane < 50) { const int ab = cand_ab; ca[u] = ab >> 4; cb[u] = ab & 15; cv[u] = topv[ca[u]] + topv[16 + cb[u]]; key[u] = fkey(cv[u]); }
        }
        unsigned tc[U];
#pragma unroll
        for (int u = 0; u < U; ++u) tc[u] = 0u;
#pragma unroll
        for (int bit = 31; bit >= 14; --bit)
#pragma unroll
            for (int u = 0; u < U; ++u) { const unsigned c = tc[u] | (1u << bit); tc[u] = __popcll(__ballot(key[u] >= c)) >= 16 ? c : tc[u]; }
#pragma unroll
        for (int u = 0; u < U; ++u) {
            const bool more2 = __popcll(__ballot(key[u] >= tc[u])) != 16;
            if (more2) { unsigned t = tc[u];
#pragma unroll
                for (int bit = 13; bit >= 0; --bit) { const unsigned c = t | (1u << bit); t = __popcll(__ballot(key[u] >= c)) >= 16 ? c : t; }
                tc[u] = t; } }
#pragma unroll
        for (int u = 0; u < U; ++u) {
            const int* topi = (const int*)((unsigned*)lds_raw + (wid * U + u) * 192 + 128);
            const int row = itu[u] >> 3, h = itu[u] & 7; const unsigned t = tc[u];
            const unsigned long long g = __ballot(key[u] > t), e_ = __ballot(key[u] == t);
            const int need = 16 - __popcll(g);
            const bool win = (key[u] > t) || (key[u] == t && mbcnt64(e_) < need);
            const unsigned long long wm = __ballot(win);
            const float v16 = rdlane(cv[u], __builtin_amdgcn_readfirstlane(__ffsll(e_) - 1));
            const float ex = win ? __expf(cv[u] - v16) : 0.f;
            const float den = wave_sum(ex);
            if (win) { const int sl = mbcnt64(wm); idx[(size_t)row * 128 + h * 16 + sl] = topi[ca[u]] * 128 + topi[16 + cb[u]]; gate[(size_t)row * 128 + h * 16 + sl] = ex / den; }
        }
    }
}

__device__ __forceinline__ float gelu_exact(float v) {
    const float av = fabsf(v), t = __builtin_amdgcn_rcpf(av * 0.2316418882f + 1.0f);
    float q = t * 0.5307027145f + (-0.7265760135f); q = q * t + 0.7107068705f; q = q * t + (-0.142248368f); q = q * t + 0.127414796f; q = q * t;
    const float e = __builtin_amdgcn_exp2f((v * v) * (-0.72134752044f));
    const float m = v * (q * e);
    return v < 0.f ? m : v - m;
}
__device__ __forceinline__ void ph_expert(const Params& p, int l, int M) {
    const int lane = p.tid & 63, wv = p.bid * 8 + (p.tid >> 6), NW = p.nblk * 8;
    const unsigned char* U = (const unsigned char*)(p.ws + WS_PEER8); const unsigned char* V = U + (size_t)NEXP * D; const bf16_t* hb = (const bf16_t*)(p.ws + WS_H);
    const int* idx = (const int*)slot(p, 2); const float* gate = (const float*)slot(p, 2) + (size_t)MR * 128;
    for (int row = wv; row < M; row += NW) {
        float x[32], acc[32];
#pragma unroll
        for (int c = 0; c < 2; ++c)
#pragma unroll
            for (int q = 0; q < 2; ++q) { const u32x4 w = *(const u32x4*)(hb + (size_t)row * D + c * 1024 + lane * 16 + q * 8);
#pragma unroll
                for (int e = 0; e < 4; ++e) { x[c * 16 + q * 8 + 2 * e] = bflo(w[e]); x[c * 16 + q * 8 + 2 * e + 1] = bfhi(w[e]); } }
#pragma unroll
        for (int i = 0; i < 32; ++i) acc[i] = 0.f;
        const int id0 = idx[(size_t)row * 128 + lane], id1 = idx[(size_t)row * 128 + 64 + lane];
        const float g0 = gate[(size_t)row * 128 + lane], g1 = gate[(size_t)row * 128 + 64 + lane];
#pragma unroll 4
        for (int e = 0; e < 128; ++e) {
            const int id = __builtin_amdgcn_readlane(e < 64 ? id0 : id1, e & 63);
            const float g = __builtin_bit_cast(float, __builtin_amdgcn_readlane(__builtin_bit_cast(int, e < 64 ? g0 : g1), e & 63));
            const unsigned char* ur = U + (size_t)id * D + lane * 16; const unsigned char* vr = V + (size_t)id * D + lane * 16;
            u32x4 uw[2], vw[2];
#pragma unroll
            for (int c = 0; c < 2; ++c) { uw[c] = *(const u32x4*)(ur + c * 1024); vw[c] = *(const u32x4*)(vr + c * 1024); }
            float d = 0.f;
#pragma unroll
            for (int c = 0; c < 2; ++c)
#pragma unroll
                for (int q = 0; q < 4; ++q) { const f32x2 lo = __builtin_amdgcn_cvt_pk_f32_fp8((int)uw[c][q], false), hi = __builtin_amdgcn_cvt_pk_f32_fp8((int)uw[c][q], true);
                    d += lo.x * x[c * 16 + 4 * q] + lo.y * x[c * 16 + 4 * q + 1] + hi.x * x[c * 16 + 4 * q + 2] + hi.y * x[c * 16 + 4 * q + 3]; }
            d = wave_sum(d) * (1.0f / PEER_USCALE);
            const float a = g * gelu_exact(d) * (1.0f / PEER_VSCALE);
#pragma unroll
            for (int c = 0; c < 2; ++c)
#pragma unroll
                for (int q = 0; q < 4; ++q) { const f32x2 lo = __builtin_amdgcn_cvt_pk_f32_fp8((int)vw[c][q], false), hi = __builtin_amdgcn_cvt_pk_f32_fp8((int)vw[c][q], true);
                    acc[c * 16 + 4 * q] += a * lo.x; acc[c * 16 + 4 * q + 1] += a * lo.y; acc[c * 16 + 4 * q + 2] += a * hi.x; acc[c * 16 + 4 * q + 3] += a * hi.y; }
        }
        float* xr = xrow(p, row); const int mr = mrow_of(row); const float* ga = modp(p, l, mr, 5);
        f32x4 xv[8], gv[8];
#pragma unroll
        for (int c = 0; c < 2; ++c)
#pragma unroll
            for (int q = 0; q < 4; ++q) { const int col = c * 1024 + lane * 16 + 4 * q; xv[c * 4 + q] = *(const f32x4*)(xr + col); gv[c * 4 + q] = *(const f32x4*)(ga + col); }
        float ss = 0.f;
#pragma unroll
        for (int i = 0; i < 8; ++i) { xv[i] = xv[i] + gv[i] * (f32x4){acc[4 * i], acc[4 * i + 1], acc[4 * i + 2], acc[4 * i + 3]}; ss += xv[i][0] * xv[i][0] + xv[i][1] * xv[i][1] + xv[i][2] * xv[i][2] + xv[i][3] * xv[i][3]; }
        ss = wave_sum(ss);
        const float rs = rsqrtf(ss * (1.0f / D) + NORM_EPS);
        if (l == 1) {
            const float* fg = inp(p, I_FING);
#pragma unroll
            for (int c = 0; c < 2; ++c)
#pragma unroll
                for (int q = 0; q < 4; ++q) { const int col = c * 1024 + lane * 16 + 4 * q; *(f32x4*)(xr + col) = (xv[c * 4 + q] * rs) * *(const f32x4*)(fg + col); }
        } else {
            const float* g1 = inp(p, I_N1G) + (l + 1) * D; const float* sh = modp(p, l + 1, mr, 0); const float* sc = modp(p, l + 1, mr, 1);
            bf16_t* hrow = (bf16_t*)(p.ws + WS_H) + (size_t)row * D;
#pragma unroll
            for (int c = 0; c < 2; ++c) { unsigned w[8];
#pragma unroll
                for (int q = 0; q < 4; ++q) { const int col = c * 1024 + lane * 16 + 4 * q; *(f32x4*)(xr + col) = xv[c * 4 + q];
                    const f32x4 y = (xv[c * 4 + q] * rs) * *(const f32x4*)(g1 + col) * (*(const f32x4*)(sc + col) + 1.0f) + *(const f32x4*)(sh + col);
                    w[2 * q] = pack2(y[0], y[1]); w[2 * q + 1] = pack2(y[2], y[3]); }
                u32x4* d = (u32x4*)(hrow + c * 1024 + lane * 16); d[0] = (u32x4){w[0], w[1], w[2], w[3]}; d[1] = (u32x4){w[4], w[5], w[6], w[7]}; }
        }
    }
}

__device__ __forceinline__ void ph_final(const Params& p) {
    const int lane = p.tid & 63, wv = p.bid * 8 + (p.tid >> 6), NW = p.nblk * 8;
    const float* g = inp(p, I_FING);
    for (int r = wv; r < TL; r += NW) {
        float* xr = p.out + (size_t)r * D; f32x4 v[8]; float ss = 0.f;
#pragma unroll
        for (int c = 0; c < 8; ++c) { v[c] = *(const f32x4*)(xr + c * 256 + lane * 4); ss += v[c][0] * v[c][0] + v[c][1] * v[c][1] + v[c][2] * v[c][2] + v[c][3] * v[c][3]; }
        ss = wave_sum(ss); const float rs = rsqrtf(ss * (1.0f / D) + NORM_EPS);
#pragma unroll
        for (int c = 0; c < 8; ++c) { const int col = c * 256 + lane * 4; *(f32x4*)(xr + col) = (v[c] * rs) * *(const f32x4*)(g + col); }
    }
}

__global__ void __launch_bounds__(NTHREADS, 2) mega(KArgs a) {
    extern __shared__ __attribute__((aligned(16))) unsigned char shm[];
    volatile LAS unsigned* st = (volatile LAS unsigned*)(shm + LDS_BYTES - 16);
    if (threadIdx.x == 0) { st[0] = 0u; st[1] = 0u; st[2] = 0u; st[3] = 0u; }
    __syncthreads();
    unsigned char* const k_ws = a.ws; float* const k_out = a.out; const int k_wid = __builtin_amdgcn_readfirstlane(threadIdx.x >> 6), k_bid = blockIdx.x, k_nblk = gridDim.x;
#define CTX(q) Params q; { GAS unsigned char* w_ = (GAS unsigned char*)k_ws; GAS float* o_ = (GAS float*)k_out;     int b_ = k_bid, n_ = k_nblk, wv_ = k_wid; unsigned m_ = 0xFFFFFFFFu; asm volatile("; PHP_MARK" : "+s"(w_), "+s"(o_), "+s"(wv_), "+s"(b_), "+s"(n_), "+s"(m_)); int t_ = wv_ * 64 + (int)__builtin_amdgcn_mbcnt_hi(m_, __builtin_amdgcn_mbcnt_lo(m_, 0u)); q.ws = (unsigned char*)w_; q.out = (float*)o_; q.tid = t_; q.bid = b_; q.nblk = n_; }
#define GBAR() do { unsigned char* w_ = k_ws; asm volatile("" : "+s"(w_)); XcdBarrier b_; b_.bar = (unsigned*)(w_ + WS_BAR); b_.x = xb_xcc_id(); b_.st = st; xcd_barrier(b_); } while (0)
    (void)xcd_barrier_post((unsigned*)(k_ws + WS_BAR), st);
    { unsigned char* ws = k_ws;
    if (blockIdx.x == 0 && threadIdx.x == 0) { const float** tab = (const float**)(ws + WS_PTRS);
#pragma unroll
        for (int i = 0; i < 33; ++i) tab[i] = a.in[i]; } }
    { CTX(q); ph_init(q, a.in[I_X], a.in[I_CTX], a.in[I_C], a.in[I_CCTX], a.in[I_ADAW]); }
    GBAR();
    { CTX(q); ph_modred(q); }
    GBAR();
    { CTX(q); ph_prepA(q, 0); norm_rows(q, inp(q, I_N1G), 0, 0, 1, MR, inp(q, I_X), inp(q, I_CTX)); } GBAR();
#pragma unroll 1
    for (int l = 0; l < 2; ++l) {
        const bool last = (l == 1);
        const int ML = last ? TL : MR;
        { CTX(q); unsigned char* ws = q.ws; EpiConv<0> E{(const float*)(ws + WS_CONVW), (bf16_t*)(ws + WS_PCTX), slot(q, 0), (bf16_t*)(ws + WS_LORAIN)};
          run_gemm(q, shm, (const bf16_t*)(ws + WS_H), D, (const bf16_t*)(ws + WS_WTIN), D, MR, NR, D, E); } GBAR();
        { CTX(q); ph_ctxconv<0>(q); } GBAR();
        { CTX(q); unsigned char* ws = q.ws;
          { EpiLora E{(const float*)(ws + WS_LBIAS), 0, slot(q, 3)};
            run_gemm(q, shm, (const bf16_t*)(ws + WS_LORAIN), LORA_W, (const bf16_t*)(ws + WS_WTLORA), LORA_W, MR, 2 * D, 256, E); }
          { EpiLora E{(const float*)(ws + WS_LBIAS), 2, slot(q, 3)}; Params q2 = q; q2.bid = (q.bid + 32) % q.nblk;
            run_gemm(q2, shm, (const bf16_t*)(ws + WS_LORAIN) + 256, LORA_W, (const bf16_t*)(ws + WS_WTLORA) + (size_t)2 * D * LORA_W + 256, LORA_W, MR, 2 * D, 256, E); } } GBAR();
        { CTX(q); constexpr int NU = NB * NHEAD * 2;
          if (q.bid < NU) ph_scan3(q, l, shm); else { Params g = q; g.bid = q.bid - NU; g.nblk = q.nblk - NU; ph_prepB(g, l); ph_prep_bg(g, l); if (!last) ph_prepA(g, l + 1); } } GBAR();
        { CTX(q); ph_rwkv_out(q, l, ML, shm); } GBAR();
        { CTX(q); unsigned char* ws = q.ws; EpiConv<1> E{(const float*)(ws + WS_CONVW) + NR, (bf16_t*)(ws + WS_PCTX), slot(q, 0), nullptr};
          run_gemm(q, shm, (const bf16_t*)(ws + WS_H), D, (const bf16_t*)(ws + WS_WTIN) + (size_t)NR * D, D, ML, NHY, D, E); }
        { CTX(q); unsigned char* ws = q.ws; EpiBf E{slot(q, 3), SEQ};
          run_gemm(q, shm, (const bf16_t*)(ws + WS_W3T), 256, (const bf16_t*)(ws + WS_HDN), 256, 8192, SEQ, 256, E); } GBAR();
        if (!last) { { CTX(q); ph_ctxconv<1>(q); } { CTX(q); ph_ctxfilter(q, l); } GBAR(); { CTX(q); ph_ctxhyena(q, l, shm); } }
        { CTX(q); ph_hyena(q, l, shm); } GBAR();
        { CTX(q); unsigned char* ws = q.ws; EpiGate E{slot(q, 6), slot(q, 0), (const float*)(ws + WS_YHC), slot(q, 5)};
          run_gemm(q, shm, (const bf16_t*)(ws + WS_H), D, (const bf16_t*)(ws + WS_WTIN) + (size_t)(NR + NHY) * D, D, ML, NG, D, E); } GBAR();
        { CTX(q); unsigned char* ws = q.ws; EpiResid E{q.out, (float*)(ws + WS_CTXRES), (const float*)(ws + WS_MOD) + (size_t)(l * 18 + 2) * D, l == 0 ? inp(q, I_X) : (const float*)q.out, l == 0 ? inp(q, I_CTX) : (const float*)(ws + WS_CTXRES)};
          run_gemm(q, shm, slot(q, 5), D, (const bf16_t*)(ws + WS_WTOUT), D, ML, D, D, E); } GBAR();
        { CTX(q); ph_prep2(q, l, ML); } GBAR();
        { CTX(q); unsigned char* ws = q.ws; EpiF32 E{(float*)slot(q, 3), D};
          run_gemm(q, shm, (const bf16_t*)(ws + WS_H), D, (const bf16_t*)(ws + WS_WTSC), D, ML, D, D, E); } GBAR();
        { CTX(q); ph_topk(q, ML, shm); } GBAR();
        { CTX(q); ph_expert(q, l, ML); } GBAR();
    }
}

extern "C" void kernel_launch(void* const* d_in, const int* in_sizes, int n_in, void* d_out, int out_size, void* d_ws, size_t ws_size, hipStream_t stream) {
    static int grid = 0;
    if (grid == 0) {
        if (n_in != 33 || out_size != TL * D || ws_size < WS_END) { fprintf(stderr, "kernel_launch: unexpected shapes / workspace (%d inputs, out %d, ws %zu < %zu)\n", n_in, out_size, ws_size, (size_t)WS_END); grid = -1; return; }
        int dev = 0, cus = 0;
        if (hipGetDevice(&dev) != hipSuccess || hipDeviceGetAttribute(&cus, hipDeviceAttributeMultiprocessorCount, dev) != hipSuccess) { grid = -1; return; }
        if (hipFuncSetAttribute((const void*)mega, hipFuncAttributeMaxDynamicSharedMemorySize, LDS_BYTES) != hipSuccess) { fprintf(stderr, "kernel_launch: hipFuncSetAttribute failed\n"); grid = -1; return; }
        int per_cu = 0;
        if (hipOccupancyMaxActiveBlocksPerMultiprocessor(&per_cu, (const void*)mega, NTHREADS, LDS_BYTES) != hipSuccess || per_cu < 1) { fprintf(stderr, "kernel_launch: occupancy query says %d\n", per_cu); (void)hipGetLastError(); }
        grid = cus;
        if (grid <= NB * NHEAD * 2) { fprintf(stderr, "kernel_launch: needs more than %d compute units\n", NB * NHEAD * 2); grid = -1; return; }
    }
    if (grid < 0) return;
    (void)hipMemsetAsync((char*)d_ws + WS_BAR, 0, XCD_BAR_WORDS * sizeof(unsigned), stream);
    KArgs a{};
    for (int i = 0; i < 33; ++i) a.in[i] = (const float*)d_in[i];
    a.out = (float*)d_out; a.ws = (unsigned char*)d_ws;
    hipLaunchKernelGGL(mega, dim3(grid), dim3(NTHREADS), LDS_BYTES, stream, a);
}
```

```cpp
#include <hip/hip_runtime.h>
#include <cstdio>
#include <cstdint>

typedef unsigned short bf16_t;
typedef float f32x4 __attribute__((ext_vector_type(4)));
typedef float f32x2 __attribute__((ext_vector_type(2)));
typedef unsigned u32x4 __attribute__((ext_vector_type(4)));
typedef unsigned u32x2 __attribute__((ext_vector_type(2)));
#define LAS __attribute__((address_space(3)))

#define XB_TMO      128
#define XB_XCNT(j)  (256  + 64 * (j))
#define XB_XSUB(j)  (1280 + 64 * (j))
#define XB_XGEN(j)  (2304 + 64 * (j))
#define XB_TOP      3328
#define XB_TOPGEN   3392
#define XCD_BAR_WORDS 3456
#define XB_SPIN_CAP (1u << 22)

__device__ __forceinline__ unsigned xb_ld(unsigned* p)              { return __hip_atomic_load(p, __ATOMIC_RELAXED, __HIP_MEMORY_SCOPE_AGENT); }
__device__ __forceinline__ unsigned xb_add(unsigned* p, unsigned v) { return __hip_atomic_fetch_add(p, v, __ATOMIC_RELAXED, __HIP_MEMORY_SCOPE_AGENT); }
__device__ __forceinline__ unsigned xb_xcc_id() { return (unsigned)__builtin_amdgcn_s_getreg((3 << 11) | 20) & 0xFu; }
#define XB_SPIN(cond, bar) do { unsigned _sp = 0; while (cond) { __builtin_amdgcn_s_sleep(1); \
    if ((++_sp & 255u) == 0u) { if (xb_ld(&(bar)[XB_TMO])) break; if (_sp > XB_SPIN_CAP) { atomicAdd(&(bar)[XB_TMO], 1u); break; } } } } while (0)

struct XcdBarrier { unsigned* bar; unsigned x; volatile LAS unsigned* st; };

__device__ __forceinline__ XcdBarrier xcd_barrier_post(unsigned* bar, volatile LAS unsigned* st) {
    XcdBarrier b; b.bar = bar; b.x = xb_xcc_id(); b.st = st;
    if (threadIdx.x == 0) (void)xb_add(&bar[XB_XCNT(b.x)], 1u);
    return b;
}
__device__ __forceinline__ void xcd_barrier_complete(unsigned* bar, unsigned x, unsigned& nloc, unsigned& nx) {
    const unsigned G = gridDim.x * gridDim.y * gridDim.z;
    unsigned sum, cnt, mine, sp = 0u;
    for (;;) {
        sum = 0u; cnt = 0u; mine = 0u;
#pragma unroll
        for (unsigned j = 0; j < 16; ++j) { const unsigned c = xb_ld(&bar[XB_XCNT(j)]); sum += c; cnt += (c > 0u) ? 1u : 0u; mine = (j == x) ? c : mine; }
        if (sum == G) break;
        __builtin_amdgcn_s_sleep(1);
        if ((++sp & 255u) == 0u) { if (xb_ld(&bar[XB_TMO])) break; if (sp > XB_SPIN_CAP) { atomicAdd(&bar[XB_TMO], 1u); break; } }
    }
    nloc = mine > 0u ? mine : 1u; nx = cnt > 0u ? cnt : 1u;
}
__device__ __forceinline__ void xcd_barrier(const XcdBarrier& b) {
    asm volatile("s_waitcnt vmcnt(0)" ::: "memory");
    __syncthreads();
    if (threadIdx.x == 0) {
        unsigned* bar = b.bar;
        __builtin_amdgcn_s_waitcnt(0);
        unsigned nloc = b.st[0], nx = b.st[1];
        if (nloc == 0u) { xcd_barrier_complete(bar, b.x, nloc, nx); b.st[0] = nloc; b.st[1] = nx; }
        const unsigned old = xb_add(&bar[XB_XSUB(b.x)], 1u);
        const unsigned gen = old / nloc;
        if (old + 1u == (gen + 1u) * nloc) {
            __builtin_amdgcn_fence(__ATOMIC_RELEASE, "agent");
            asm volatile("s_waitcnt vmcnt(0)" ::: "memory");
            const unsigned og = xb_add(&bar[XB_TOP], 1u);
            const unsigned tg = og / nx;
            if (og + 1u == (tg + 1u) * nx) xb_add(&bar[XB_TOPGEN], 1u);
            else XB_SPIN(xb_ld(&bar[XB_TOPGEN]) == tg, bar);
            __builtin_amdgcn_fence(__ATOMIC_ACQUIRE, "agent");
            xb_add(&bar[XB_XGEN(b.x)], 1u);
            asm volatile("s_waitcnt vmcnt(0)" ::: "memory");
        } else {
            XB_SPIN(xb_ld(&bar[XB_XGEN(b.x)]) == gen, bar);
            __builtin_amdgcn_fence(__ATOMIC_ACQUIRE, "agent");
            asm volatile("s_waitcnt vmcnt(0)" ::: "memory");
        }
    }
    __syncthreads();
}

namespace pg8 {
#define PG8_LAS __attribute__((address_space(3)))
typedef unsigned short bf16_t;
typedef short bf16x8 __attribute__((ext_vector_type(8)));
typedef float f32x4 __attribute__((ext_vector_type(4)));
typedef unsigned u32x4 __attribute__((ext_vector_type(4)));
constexpr int BM = 256, BK = 64, HALF = 128, HTB = HALF * BK * 2  , STAGE_BYTES = 8 * HTB, NXCD = 8, WGM = 8;

__host__ __device__ __forceinline__ int lds_byte(int r, int c) { const int st = (r >> 4) * 2 + (c >> 5), rr = r & 15, cc = c & 31, ob = rr * 64 + cc * 2; return st * 1024 + (ob ^ (((ob >> 9) & 1) << 5)); }
__host__ __device__ __forceinline__ void stage_rc(int b, int& R, int& C) { const int st = b / 1024, sb = b % 1024, swz = sb ^ (((sb >> 9) & 1) << 5); R = (st >> 1) * 16 + swz / 64; C = (st & 1) * 32 + (swz % 64) / 2; }
__host__ __device__ __forceinline__ int perm32(int rho) { const int n = rho >> 4, i = rho & 15; return 8 * (i >> 2) + 4 * n + (i & 3); }

struct Unit { int pm, pn; };
struct Gemm { const bf16_t* A; const bf16_t* Bt; int M, N, K, lda, ldb; };

struct StaticOrder {
    int nM, nN, nwg, G, c;
    __host__ __device__ void init(int M, int N, int G_, int c_) { nM = M / BM; nN = N / BM; nwg = nM * nN; G = G_; c = c_; }
    __host__ __device__ bool next(int i, Unit& u) const {
        const long L = (long)i * G + c; if (L >= nwg) return false;
        int wgid = (int)L; { const int q = nwg / NXCD, r = nwg % NXCD, xcd = wgid % NXCD, off = wgid / NXCD; wgid = (xcd < r ? xcd * (q + 1) : r * (q + 1) + (xcd - r) * q) + off; }
        const int nig = WGM * nN, gid = wgid / nig, fm = gid * WGM, gsz = (nM - fm) < WGM ? (nM - fm) : WGM;
        u.pm = fm + ((wgid % nig) % gsz); u.pn = (wgid % nig) / gsz; return true;
    }
    __device__ __forceinline__ void a_ready(const Unit&) const {}
    __device__ __forceinline__ void done(const Unit&) const {}
};
typedef float f32x2c __attribute__((ext_vector_type(2))); typedef __bf16 bf16x2c __attribute__((ext_vector_type(2)));
__device__ __forceinline__ unsigned cvt_pk_bf16(float lo, float hi) { const f32x2c v = {lo, hi}; return __builtin_bit_cast(unsigned, __builtin_convertvector(v, bf16x2c)); }
typedef float f32x2 __attribute__((ext_vector_type(2)));
template <class Epi, class Sched>
__device__ __forceinline__ void gemm_phase(PG8_LAS unsigned char* lds, const Gemm g, const Sched& S, const Epi& E, const int tid) {
    const int wid = __builtin_amdgcn_readfirstlane(tid >> 6), lane = tid & 63, wr = wid >> 2, wc = wid & 3, fr = lane & 15, fq = lane >> 4;
    const int K = g.K, nt = K / BK;
    unsigned voffA[2], voffB[2];
#pragma unroll
    for (int i = 0; i < 2; ++i) { int R, C; stage_rc(tid * 16 + i * 8192, R, C); const int Rb = Epi::PERM ? ((R & ~31) + perm32(R & 31)) : R;
        voffA[i] = (unsigned)(R * g.lda + C) * 2u; voffB[i] = (unsigned)(Rb * g.ldb + C) * 2u; }
    const size_t kstep = (size_t)(BK * 2);
    const size_t hstepA = (size_t)HALF * g.lda * 2, hstepB = (size_t)HALF * g.ldb * 2;
    const size_t tstepA = 2 * hstepA, tstepB = 2 * hstepB;
    const unsigned ldsw = (unsigned)wid * 1024u;
    const int aoff = lds_byte(wr * 64 + fr, fq * 8), boff = lds_byte(wc * 32 + fr, fq * 8);
#define PG8_SA(b, h) (((b) * 2 + (h)) * HTB)
#define PG8_SB(b, h) ((4 + (b) * 2 + (h)) * HTB)
#define PG8_STAGE(bufoff, gbase, voff) do { _Pragma("unroll") for (int _i = 0; _i < 2; ++_i) \
        __builtin_amdgcn_global_load_lds((const unsigned*)((const char*)(gbase) + (voff)[_i]), (PG8_LAS unsigned*)(lds + (bufoff) + ldsw + _i * 8192), 16, 0, 0); } while (0)
#define PG8_LDA(dst, b, h) do { _Pragma("unroll") for (int m = 0; m < 4; ++m) _Pragma("unroll") for (int k = 0; k < 2; ++k) dst[m][k] = *(const PG8_LAS bf16x8*)(lds + PG8_SA(b, h) + aoff + m * 2048 + k * 1024); } while (0)
#define PG8_LDB(dst, b, h) do { _Pragma("unroll") for (int n = 0; n < 2; ++n) _Pragma("unroll") for (int k = 0; k < 2; ++k) dst[n][k] = *(const PG8_LAS bf16x8*)(lds + PG8_SB(b, h) + boff + n * 2048 + k * 1024); } while (0)
#define PG8_MMA(ai, bj, At, Bt) do { __builtin_amdgcn_s_setprio(1); _Pragma("unroll") for (int m = 0; m < 4; ++m) _Pragma("unroll") for (int n = 0; n < 2; ++n) _Pragma("unroll") for (int k = 0; k < 2; ++k) \
        acc[ai][bj][m][n] = __builtin_amdgcn_mfma_f32_16x16x32_bf16(Bt[n][k], At[m][k], acc[ai][bj][m][n], 0, 0, 0); __builtin_amdgcn_s_setprio(0); } while (0)
#define PG8_WAIT_V(n) asm volatile("s_waitcnt vmcnt(" #n ")" ::: "memory")
#define PG8_WAIT_L(n) asm volatile("s_waitcnt lgkmcnt(" #n ")" ::: "memory")
#define PG8_BAR __builtin_amdgcn_s_barrier()
#define PG8_SCHED __builtin_amdgcn_sched_barrier(0)
    Unit cur, nxt; int ui = 0;
    if (!S.next(0, cur)) return;
    f32x4 acc[2][2][4][2];
#pragma unroll
    for (int a = 0; a < 2; ++a)
#pragma unroll
        for (int b = 0; b < 2; ++b)
#pragma unroll
            for (int m = 0; m < 4; ++m)
#pragma unroll
                for (int n = 0; n < 2; ++n) acc[a][b][m][n] = (f32x4){0.f, 0.f, 0.f, 0.f};
    bf16x8 At[4][2], B0[2][2], B1[2][2];
    const char* cA = (const char*)g.A + (size_t)cur.pm * tstepA; const char* cB = (const char*)g.Bt + (size_t)cur.pn * tstepB;
    S.a_ready(cur);
    PG8_STAGE(PG8_SB(0, 0), cB, voffB); PG8_STAGE(PG8_SA(0, 0), cA, voffA); PG8_STAGE(PG8_SB(0, 1), cB + hstepB, voffB); PG8_STAGE(PG8_SA(0, 1), cA + hstepA, voffA);
    if (wr == 1) PG8_BAR;
    PG8_WAIT_V(4); PG8_BAR;
    PG8_STAGE(PG8_SB(1, 0), cB + kstep, voffB); PG8_STAGE(PG8_SA(1, 0), cA + kstep, voffA); PG8_STAGE(PG8_SB(1, 1), cB + hstepB + kstep, voffB);
    PG8_WAIT_V(6); PG8_BAR;
    for (;;) {
        const bool has_next = S.next(ui + 1, nxt);
        const char* nA = has_next ? (const char*)g.A + (size_t)nxt.pm * tstepA : cA; const char* nB = has_next ? (const char*)g.Bt + (size_t)nxt.pn * tstepB : cB;
        for (int t = 0; t < nt; t += 2) {
            const bool last = (t == nt - 2);
            const char* a1 = cA + (size_t)(t + 1) * kstep;
            const char* a2 = last ? nA : cA + (size_t)(t + 2) * kstep; const char* b2 = last ? nB : cB + (size_t)(t + 2) * kstep;
            const char* a3 = a2 + kstep; const char* b3 = b2 + kstep;
            if (last && has_next) S.a_ready(nxt);
            PG8_LDB(B0, 0, 0); PG8_SCHED; PG8_LDA(At, 0, 0); PG8_STAGE(PG8_SA(1, 1), a1 + hstepA, voffA);
            PG8_WAIT_L(8); PG8_BAR; PG8_WAIT_L(0); PG8_MMA(0, 0, At, B0); PG8_BAR; PG8_SCHED;
            PG8_LDB(B1, 0, 1); PG8_STAGE(PG8_SB(0, 0), b2, voffB);
            PG8_BAR; PG8_WAIT_L(0); PG8_MMA(0, 1, At, B1); PG8_BAR;
            PG8_LDA(At, 0, 1); PG8_STAGE(PG8_SA(0, 0), a2, voffA);
            PG8_BAR; PG8_WAIT_L(0); PG8_MMA(1, 0, At, B0); PG8_BAR; PG8_SCHED;
            PG8_STAGE(PG8_SB(0, 1), b2 + hstepB, voffB);
            PG8_WAIT_V(6); PG8_BAR; PG8_MMA(1, 1, At, B1); PG8_BAR;
            PG8_LDB(B0, 1, 0); PG8_SCHED; PG8_LDA(At, 1, 0); PG8_STAGE(PG8_SA(0, 1), a2 + hstepA, voffA);
            PG8_WAIT_L(8); PG8_BAR; PG8_WAIT_L(0); PG8_MMA(0, 0, At, B0); PG8_BAR; PG8_SCHED;
            PG8_LDB(B1, 1, 1); PG8_STAGE(PG8_SB(1, 0), b3, voffB);
            PG8_BAR; PG8_WAIT_L(0); PG8_MMA(0, 1, At, B1); PG8_BAR;
            PG8_LDA(At, 1, 1); PG8_STAGE(PG8_SA(1, 0), a3, voffA);
            PG8_BAR; PG8_WAIT_L(0); PG8_MMA(1, 0, At, B0); PG8_BAR; PG8_SCHED;
            PG8_STAGE(PG8_SB(1, 1), b3 + hstepB, voffB);
            PG8_WAIT_V(6); PG8_BAR; PG8_MMA(1, 1, At, B1); PG8_BAR;
        }
            if constexpr (!Epi::AFTER_DRAIN) { E(acc, cur, wr, wc, fr, fq); S.done(cur); }
            if (!has_next) break;
#pragma unroll
        for (int a = 0; a < 2; ++a)
#pragma unroll
            for (int b = 0; b < 2; ++b)
#pragma unroll
                for (int m = 0; m < 4; ++m)
#pragma unroll
                    for (int n = 0; n < 2; ++n) acc[a][b][m][n] = (f32x4){0.f, 0.f, 0.f, 0.f};
        cur = nxt; cA = nA; cB = nB; ++ui;
    }
    PG8_WAIT_V(0);
    if (wr == 0) PG8_BAR;
    PG8_BAR;
    if constexpr (Epi::AFTER_DRAIN) { E.fused(acc, cur, wr, wc, fr, fq, lds, wid, lane); S.done(cur); }
#undef PG8_SA
#undef PG8_SB
#undef PG8_STAGE
#undef PG8_LDA
#undef PG8_LDB
#undef PG8_MMA
#undef PG8_WAIT_V
#undef PG8_WAIT_L
#undef PG8_BAR
#undef PG8_SCHED
}
}

constexpr int D = 2048, NB = 2, SEQ = 16384, CL = 256, TL = NB * SEQ, TC = NB * CL, MR = TL + TC;
constexpr int NHEAD = 32, HN = 64;
constexpr int IN_COLS = 16832, CONV_COLS = 12736;
constexpr int NR = 6656, NHY = 6144, NG = 4096, NTOT = NR + NHY + NG;
constexpr int LORA_W = 512;
constexpr int NPART = 32;
constexpr int NEXP = 16384;
constexpr float NORM_EPS = 1e-6f, GN_EPS = 64e-5f;
constexpr int NTHREADS = 512;
constexpr int LDS_BYTES = 159 * 1024;

constexpr size_t al256(size_t x) { return (x + 255) & ~(size_t)255; }
constexpr size_t SLOT_BYTES = (size_t)MR * D * 2;
constexpr size_t WS_BAR    = 0;
constexpr size_t WS_PTRS   = 14336;
constexpr size_t WS_MOD    = 16384;
constexpr size_t WS_MODP   = WS_MOD    + al256((size_t)2 * 3 * 6 * D * 4);
constexpr size_t WS_TW     = WS_MODP   + al256((size_t)NPART * 2 * 3 * 6 * D * 4);
constexpr size_t WS_CONVW  = WS_TW     + al256((size_t)32768 * 8);
constexpr size_t WS_LBIAS  = WS_CONVW  + al256((size_t)3 * NTOT * 4);
constexpr size_t WS_CTXRES = WS_LBIAS  + al256((size_t)4 * D * 4);
constexpr size_t WS_H      = WS_CTXRES + al256((size_t)TC * D * 4);
constexpr size_t WS_WTIN   = WS_H      + SLOT_BYTES;
constexpr size_t WS_WTLORA = WS_WTIN   + al256((size_t)NTOT * D * 2);
constexpr size_t WS_WTOUT  = WS_WTLORA + al256((size_t)4 * D * LORA_W * 2);
constexpr size_t WS_WTSC   = WS_WTOUT  + al256((size_t)D * D * 2);
constexpr size_t WS_W3T    = WS_WTSC   + al256((size_t)D * D * 2);
constexpr size_t WS_HDN    = WS_W3T    + al256((size_t)8192 * 256 * 2);
constexpr size_t WS_HDNC   = WS_HDN    + al256((size_t)SEQ * 256 * 2);
constexpr size_t WS_PCTX   = WS_HDNC   + al256((size_t)CL * 256 * 2);
constexpr size_t WS_LORAIN = WS_PCTX   + al256((size_t)TC * NR * 2);
constexpr size_t WS_SLOT0  = WS_LORAIN + al256((size_t)MR * LORA_W * 2);
constexpr size_t WS_PEER8  = WS_SLOT0  + 7 * SLOT_BYTES;
constexpr size_t WS_END    = WS_PEER8  + al256((size_t)2 * NEXP * D);
constexpr size_t CH_ARR = (size_t)NB * D * CL * 4;
constexpr size_t WS_CV   = WS_LORAIN;
constexpr size_t WS_YHC  = WS_CV + 3 * CH_ARR;
constexpr size_t WS_HCF  = WS_YHC + CH_ARR;
static_assert(WS_HCF + (size_t)8192 * 256 * 4 <= WS_SLOT0, "ctx hyena arrays must fit the lora_in region");

#define GAS __attribute__((address_space(1)))
struct KArgs {
    const float* in[33];
    float* out;
    unsigned char* ws;
};
struct Params {
    float* out;
    unsigned char* ws;
    int tid, bid, nblk;
};

enum { I_X = 0, I_C, I_CTX, I_CCTX, I_ADAW, I_ADAB, I_N1G, I_N2G, I_WIN, I_CONVW, I_W0, I_W2, I_A0, I_A2, I_G2, I_KK, I_KA, I_RK, I_LNW, I_LNB,
       I_HW1, I_HB1, I_HW2, I_HB2, I_HW3, I_HFREQ, I_HSKIP, I_WOUT, I_WQ, I_KEYS, I_PU, I_PV, I_FING };

__device__ __forceinline__ float bf2f(bf16_t v) { return __uint_as_float((unsigned)v << 16); }
__device__ __forceinline__ bf16_t f2bf(float f) { unsigned u = __float_as_uint(f); u += 0x7FFFu + ((u >> 16) & 1u); return (bf16_t)(u >> 16); }
__device__ __forceinline__ unsigned pack2(float lo, float hi) { return (unsigned)f2bf(lo) | ((unsigned)f2bf(hi) << 16); }
__device__ __forceinline__ float bflo(unsigned w) { return __uint_as_float(w << 16); }
__device__ __forceinline__ float bfhi(unsigned w) { return __uint_as_float(w & 0xFFFF0000u); }
__device__ __forceinline__ float sigmoidf_(float x) { return __builtin_amdgcn_rcpf(1.0f + __expf(-x)); }
__device__ __forceinline__ float tanhf_(float x) { return 1.0f - 2.0f * __builtin_amdgcn_rcpf(1.0f + __expf(2.0f * x)); }
template <int CTRL> __device__ __forceinline__ float dppf(float x) { return __builtin_bit_cast(float, __builtin_amdgcn_mov_dpp(__builtin_bit_cast(int, x), CTRL, 0xf, 0xf, true)); }
__device__ __forceinline__ float red16(float x) { x += dppf<0xB1>(x); x += dppf<0x4E>(x); x += dppf<0x141>(x); x += dppf<0x128>(x); return x; }
__device__ __forceinline__ float rdlane(float x, int l) { return __builtin_bit_cast(float, __builtin_amdgcn_readlane(__builtin_bit_cast(int, x), l)); }
__device__ __forceinline__ float wave_sum(float x) { x = red16(x); return (rdlane(x, 0) + rdlane(x, 16)) + (rdlane(x, 32) + rdlane(x, 48)); }

__device__ __forceinline__ const float* inp(const Params& p, int k) {
    const unsigned long long v = ((const unsigned long long*)(p.ws + WS_PTRS))[k];
    const unsigned lo = __builtin_amdgcn_readfirstlane((unsigned)v), hi = __builtin_amdgcn_readfirstlane((unsigned)(v >> 32));
    GAS const float* g_ = (GAS const float*)(((unsigned long long)hi << 32) | lo); asm volatile("" : "+s"(g_)); return (const float*)g_;
}
__device__ __forceinline__ const float* xrow_c(const Params& p, int r) { return r < TL ? p.out + (size_t)r * D : (const float*)(p.ws + WS_CTXRES) + (size_t)(r - TL) * D; }
__device__ __forceinline__ float* xrow(const Params& p, int r) { return r < TL ? p.out + (size_t)r * D : (float*)(p.ws + WS_CTXRES) + (size_t)(r - TL) * D; }
__device__ __forceinline__ int mrow_of(int r) { return r < TL ? (r >> 14) : 2; }
__device__ __forceinline__ const float* modp(const Params& p, int l, int mrow, int chunk) { return (const float*)(p.ws + WS_MOD) + ((size_t)(l * 3 + mrow) * 6 + chunk) * D; }
__device__ __forceinline__ bf16_t* slot(const Params& p, int s) { return (bf16_t*)(p.ws + WS_SLOT0 + (size_t)s * SLOT_BYTES); }

__device__ __forceinline__ int src_col(int n) {
    if (n < 4096) return n;
    if (n < 6144) return 4480 + (n - 4096);
    if (n < NR) { const int cc = n - 6144, blk = cc >> 7, o = cc & 127;
        if (o < 96) return (blk == 0 ? 4096 : blk == 1 ? 4288 : blk == 2 ? 4192 : 4384) + o;
        return blk == 0 ? 6528 + (o - 96) : blk == 1 ? 6528 + 32 + (o - 96) : -1; }
    if (n < NR + NHY) return 6592 + (n - NR);
    { const int g = n - NR - NHY, tile = g >> 8, o = g & 255;
      return o < 128 ? CONV_COLS + tile * 128 + o : CONV_COLS + D + tile * 128 + (o - 128); }
}

__device__ __forceinline__ float siluf_(float x) { return x * sigmoidf_(x); }
__device__ __forceinline__ void ph_init(const Params& p, const float* in_x, const float* in_ctx, const float* cv, const float* cc, const float* ada_w) {
    const size_t gt = (size_t)p.bid * NTHREADS + p.tid, GT = (size_t)p.nblk * NTHREADS;
    float* mp = (float*)(p.ws + WS_MODP);
    for (int u = p.bid; u < 2 * 12 * NPART; u += p.nblk) {
        const int kc = u % NPART, cch = (u / NPART) % 12, l = u / (NPART * 12);
        const int col = cch * 1024 + p.tid * 2;
        float a0 = 0.f, a1 = 0.f, b0 = 0.f, b1 = 0.f, c0 = 0.f, c1 = 0.f;
        const float* w = ada_w + ((size_t)l * D + (size_t)kc * 64) * (6 * D) + col;
#pragma unroll 8
        for (int k = 0; k < 64; ++k) {
            const int kk = kc * 64 + k;
            const float s0 = siluf_(cv[kk]), s1 = siluf_(cv[D + kk]), s2 = siluf_(cc[kk]);
            const f32x2 wv = *(const f32x2*)(w + (size_t)k * (6 * D));
            a0 += s0 * wv.x; a1 += s0 * wv.y; b0 += s1 * wv.x; b1 += s1 * wv.y; c0 += s2 * wv.x; c1 += s2 * wv.y;
        }
        float* o = mp + ((size_t)(kc * 2 + l) * 3) * (6 * D) + col;
        *(f32x2*)(o) = (f32x2){a0, a1}; *(f32x2*)(o + 6 * D) = (f32x2){b0, b1}; *(f32x2*)(o + 12 * D) = (f32x2){c0, c1};
    }
}
__device__ __forceinline__ void ph_modred(const Params& p) {
    const int gt = p.bid * NTHREADS + p.tid, GT = p.nblk * NTHREADS;
    const float* mp = (const float*)(p.ws + WS_MODP); float* md = (float*)(p.ws + WS_MOD);
    for (int i = gt; i < 2 * 3 * 6 * D; i += GT) {
        const int col = i % (6 * D), r = (i / (6 * D)) % 3, l = i / (18 * D);
        float s = inp(p, I_ADAB)[l * 6 * D + col];
        for (int kc = 0; kc < NPART; ++kc) s += mp[((size_t)(kc * 2 + l) * 3 + r) * (6 * D) + col];
        md[i] = s;
    }
}

__device__ __forceinline__ void norm_rows(const Params& p, const float* g, int l, int ch_shift, int ch_scale, int M, const float* xin = nullptr, const float* cin = nullptr) {
    const int lane = p.tid & 63, wv = p.bid * 8 + (p.tid >> 6), NW = p.nblk * 8;
    bf16_t* h = (bf16_t*)(p.ws + WS_H);
    f32x4 gg[8];
#pragma unroll
    for (int c = 0; c < 8; ++c) gg[c] = *(const f32x4*)(g + c * 256 + lane * 4);
    auto rowp = [&](int r) { return xin ? (r < TL ? xin + (size_t)r * D : cin + (size_t)(r - TL) * D) : xrow_c(p, r); };
    f32x4 v[8];
    if (wv < M) { const float* xr = rowp(wv);
#pragma unroll
        for (int c = 0; c < 8; ++c) v[c] = *(const f32x4*)(xr + c * 256 + lane * 4); }
    for (int r = wv; r < M; r += NW) {
        const int mr = mrow_of(r);
        const float* sh = modp(p, l, mr, ch_shift); const float* sc = modp(p, l, mr, ch_scale);
        f32x4 vn[8];
        { const int rn = r + NW < M ? r + NW : r; const float* xn = rowp(rn);
#pragma unroll
          for (int c = 0; c < 8; ++c) vn[c] = *(const f32x4*)(xn + c * 256 + lane * 4); }
        float ss = 0.f;
#pragma unroll
        for (int c = 0; c < 8; ++c) ss += v[c][0] * v[c][0] + v[c][1] * v[c][1] + v[c][2] * v[c][2] + v[c][3] * v[c][3];
        ss = wave_sum(ss);
        const float rs = rsqrtf(ss * (1.0f / D) + NORM_EPS);
#pragma unroll
        for (int c = 0; c < 8; ++c) { const int col = c * 256 + lane * 4;
            const f32x4 s1 = *(const f32x4*)(sc + col), s0 = *(const f32x4*)(sh + col);
            const f32x4 y = (v[c] * rs) * gg[c] * (s1 + 1.0f) + s0;
            u32x2 w; w.x = pack2(y[0], y[1]); w.y = pack2(y[2], y[3]);
            *(u32x2*)(h + (size_t)r * D + col) = w; }
#pragma unroll
        for (int c = 0; c < 8; ++c) v[c] = vn[c];
    }
}

template <class F> __device__ __forceinline__ void cvt_T(const Params& p, bf16_t* dst, int N, int Kd, F f) {
    const int lane = p.tid & 63, wv = p.bid * 8 + (p.tid >> 6), NW = p.nblk * 8;
    const int nblk = N / 64, units = nblk * (Kd / 32);
    for (int u = wv; u < units; u += NW) {
        const int n = (u % nblk) * 64 + lane, k0 = (u / nblk) * 32;
        float v[32];
#pragma unroll
        for (int i = 0; i < 32; ++i) v[i] = f(k0 + i, n);
        unsigned w[16];
#pragma unroll
        for (int i = 0; i < 16; ++i) w[i] = pack2(v[2 * i], v[2 * i + 1]);
        u32x4* d = (u32x4*)(dst + (size_t)n * Kd + k0);
#pragma unroll
        for (int i = 0; i < 4; ++i) d[i] = (u32x4){w[4 * i], w[4 * i + 1], w[4 * i + 2], w[4 * i + 3]};
    }
}

__device__ __forceinline__ void filter_mlp(const Params& p, int l, int Lf, bf16_t* dst) {
    const int lane = p.tid & 63, wv = p.bid * 8 + (p.tid >> 6), NW = p.nblk * 8;
    const float* w1 = inp(p, I_HW1) + (size_t)l * 33 * 64; const float* b1 = inp(p, I_HB1) + l * 64;
    const float* w2 = inp(p, I_HW2) + (size_t)l * 64 * 64; const float* b2 = inp(p, I_HB2) + l * 64;
    const float fr = inp(p, I_HFREQ)[l * 64 + lane];
    float w1c[33], w2c[64];
#pragma unroll
    for (int i = 0; i < 33; ++i) w1c[i] = w1[i * 64 + lane];
#pragma unroll
    for (int i = 0; i < 64; ++i) w2c[i] = w2[i * 64 + lane];
    const float b1l = b1[lane], b2l = b2[lane];
    for (int n = wv; n < Lf; n += NW) {
        float zf = 0.f;
        if (lane == 0) zf = (float)n / (float)(Lf - 1);
        else if (lane <= 32) { const int bi = (lane - 1) & 15; const float band = 1e-4f + (float)bi * ((15.0f - 1e-4f) / 15.0f);
            float s, c; sincospif(2.0f * (float)n * band / (float)Lf, &s, &c); zf = lane <= 16 ? c : -s; }
        float a = b1l;
#pragma unroll
        for (int i = 0; i < 33; ++i) a += rdlane(zf, i) * w1c[i];
        const float h1 = sinf(fr * a);
        float b = b2l;
#pragma unroll
        for (int i = 0; i < 64; ++i) b += rdlane(h1, i) * w2c[i];
        const float h2 = sinf(fr * b);
        bf16_t* d = dst + (size_t)n * 256;
        d[lane] = f2bf(h2); d[64 + lane] = 0; d[128 + lane] = 0; d[192 + lane] = 0;
    }
}

__device__ __forceinline__ void prep_win(const Params& p, int l, int n0, int n1) {
    const float* w = inp(p, I_WIN) + (size_t)l * D * IN_COLS;
    cvt_T(p, (bf16_t*)(p.ws + WS_WTIN) + (size_t)n0 * D, n1 - n0, D, [=](int k, int n) { const int s = src_col(n + n0); return s >= 0 ? w[(size_t)k * IN_COLS + s] : 0.f; });
    float* cw = (float*)(p.ws + WS_CONVW); const float* cs = inp(p, I_CONVW) + (size_t)l * 3 * CONV_COLS; const int nn = n1 - n0;
    for (int i = p.bid * NTHREADS + p.tid; i < 3 * nn; i += p.nblk * NTHREADS) { const int j = i / nn, n = n0 + i % nn; const int s = src_col(n);
        cw[j * NTOT + n] = (n < NR + NHY && s >= 0) ? cs[j * CONV_COLS + s] : 0.f; }
}
__device__ __forceinline__ void ph_prepA(const Params& p, int l) {
    prep_win(p, l, 0, NR);
    { const float* w2 = inp(p, I_W2) + (size_t)l * 2 * 96 * D; const float* a2 = inp(p, I_A2) + (size_t)l * 2 * 96 * D;
      cvt_T(p, (bf16_t*)(p.ws + WS_WTLORA), 4 * D, LORA_W, [=](int k, int n) { const int t = n >> 11, j = n & (D - 1), kb = k >> 7, o = k & 127;
          if (kb != t || o >= 96) return 0.f; const float* s = (t & 1) ? a2 : w2; return s[((size_t)(t >> 1) * 96 + o) * D + j]; }); }
    { float* lb = (float*)(p.ws + WS_LBIAS); for (int i = p.bid * NTHREADS + p.tid; i < 4 * D; i += p.nblk * NTHREADS) { const int t = i >> 11, j = i & (D - 1);
          lb[i] = ((t & 1) ? inp(p, I_A0) : inp(p, I_W0))[(size_t)l * 2 * D + (t >> 1) * D + j]; } }
}
__device__ __forceinline__ void ph_prepB(const Params& p, int l) { prep_win(p, l, NR, NTOT); }

__device__ __forceinline__ void ph_prep_bg(const Params& p, int l) {
    { const float* w = inp(p, I_WOUT) + (size_t)l * D * D; cvt_T(p, (bf16_t*)(p.ws + WS_WTOUT), D, D, [=](int k, int n) { return w[(size_t)k * D + n]; }); }
    { const float* w = inp(p, I_HW3) + (size_t)l * 64 * 8192; cvt_T(p, (bf16_t*)(p.ws + WS_W3T), 8192, 256, [=](int k, int n) { return k < 64 ? w[(size_t)k * 8192 + n] : 0.f; }); }
    { const float* wq = inp(p, I_WQ) + (size_t)l * D * D; const float* keys = inp(p, I_KEYS) + (size_t)l * 16 * 128 * 128; unsigned* dst = (unsigned*)(p.ws + WS_WTSC);
      for (size_t i = (size_t)p.bid * NTHREADS + p.tid; i < (size_t)D * D / 2; i += (size_t)p.nblk * NTHREADS) {
          const int row = (int)(i / (D / 2)), kk = (int)(i % (D / 2)) * 2, hp = row >> 7;
          const f32x4* kr = (const f32x4*)(keys + (size_t)row * 128); const f32x4* q0 = (const f32x4*)(wq + (size_t)kk * D + hp * 128); const f32x4* q1 = (const f32x4*)(wq + (size_t)(kk + 1) * D + hp * 128);
          float s0 = 0.f, s1 = 0.f;
#pragma unroll 4
          for (int d4 = 0; d4 < 32; ++d4) { const f32x4 a = kr[d4], b = q0[d4], c = q1[d4];
              s0 += a[0] * b[0] + a[1] * b[1] + a[2] * b[2] + a[3] * b[3]; s1 += a[0] * c[0] + a[1] * c[1] + a[2] * c[2] + a[3] * c[3]; }
          dst[i] = pack2(s0, s1); } }
    filter_mlp(p, l, SEQ, (bf16_t*)(p.ws + WS_HDN));
    if (l == 0) filter_mlp(p, l, CL, (bf16_t*)(p.ws + WS_HDNC));
    { const f32x4* su = (const f32x4*)(inp(p, I_PU) + (size_t)l * NEXP * D); const f32x4* sv = (const f32x4*)(inp(p, I_PV) + (size_t)l * NEXP * D);
      unsigned* du = (unsigned*)(p.ws + WS_PEER8); unsigned* dv = du + (size_t)NEXP * D / 4;
      for (size_t i = (size_t)p.bid * NTHREADS + p.tid; i < (size_t)NEXP * D / 4; i += (size_t)p.nblk * NTHREADS) {
          const f32x4 a = su[i] * 128.0f, b = sv[i] * 8.0f;
          int wa = __builtin_amdgcn_cvt_pk_fp8_f32(a[0], a[1], 0, false); wa = __builtin_amdgcn_cvt_pk_fp8_f32(a[2], a[3], wa, true);
          int wb = __builtin_amdgcn_cvt_pk_fp8_f32(b[0], b[1], 0, false); wb = __builtin_amdgcn_cvt_pk_fp8_f32(b[2], b[3], wb, true);
          du[i] = (unsigned)wa; dv[i] = (unsigned)wb; } }
}

using pg8::Unit; using pg8::cvt_pk_bf16;
typedef f32x4 Acc[2][2][4][2];

__device__ __forceinline__ void st8bf(bf16_t* p, const f32x4 a, const f32x4 b) { *(u32x4*)p = (u32x4){cvt_pk_bf16(a[0], a[1]), cvt_pk_bf16(a[2], a[3]), cvt_pk_bf16(b[0], b[1]), cvt_pk_bf16(b[2], b[3])}; }
__device__ __forceinline__ void st4bf(bf16_t* p, const f32x4 v) { u32x2 w; w.x = cvt_pk_bf16(v[0], v[1]); w.y = cvt_pk_bf16(v[2], v[3]); *(u32x2*)p = w; }

template <int GROUP> struct EpiConv {
    static constexpr bool PERM = false, AFTER_DRAIN = false;
    const float* cw;
    bf16_t* pctx;
    bf16_t* d0; bf16_t* lora;
    __device__ __forceinline__ void operator()(const Acc& acc, const Unit& u, int wr, int wc, int fr, int fq) const {
        if (u.pm >= TL / 256) {
#pragma unroll
            for (int ai = 0; ai < 2; ++ai)
#pragma unroll
                for (int m = 0; m < 4; ++m) { const int row = (u.pm - TL / 256) * 256 + ai * 128 + wr * 64 + m * 16 + fr;
#pragma unroll
                    for (int bj = 0; bj < 2; ++bj)
#pragma unroll
                        for (int n = 0; n < 2; ++n) st4bf(pctx + (size_t)row * NR + u.pn * 256 + bj * 128 + wc * 32 + n * 16 + 4 * fq, acc[ai][bj][m][n]); }
            return;
        }
        f32x4 tap[2][2][3];
#pragma unroll
        for (int bj = 0; bj < 2; ++bj)
#pragma unroll
            for (int n = 0; n < 2; ++n)
#pragma unroll
                for (int j = 0; j < 3; ++j) tap[bj][n][j] = *(const f32x4*)(cw + j * NTOT + u.pn * 256 + bj * 128 + wc * 32 + n * 16 + 4 * fq);
#pragma unroll
        for (int bj = 0; bj < 2; ++bj)
#pragma unroll
            for (int n = 0; n < 2; ++n) {
                const int colg = u.pn * 256 + bj * 128 + wc * 32 + n * 16 + 4 * fq;
                const f32x4 w0 = tap[bj][n][0], w1 = tap[bj][n][1], w2 = tap[bj][n][2];
#pragma unroll
                for (int ai = 0; ai < 2; ++ai) {
                    f32x4 rp[4], rn[4];
#pragma unroll
                    for (int m = 0; m < 4; ++m)
#pragma unroll
                        for (int e = 0; e < 4; ++e) { rp[m][e] = dppf<0x121>(acc[ai][bj][m][n][e]); rn[m][e] = dppf<0x12F>(acc[ai][bj][m][n][e]); }
#pragma unroll
                    for (int m = 0; m < 4; ++m) {
                        const f32x4 z = (f32x4){0.f, 0.f, 0.f, 0.f};
                        const f32x4 pv = (fr == 0) ? (m > 0 ? rp[m > 0 ? m - 1 : 0] : z) : rp[m];
                        const f32x4 nx = (fr == 15) ? (m < 3 ? rn[m < 3 ? m + 1 : 3] : z) : rn[m];
                        const f32x4 o = w0 * pv + w1 * acc[ai][bj][m][n] + w2 * nx;
                        const int row = u.pm * 256 + ai * 128 + wr * 64 + m * 16 + fr;
                        if (GROUP == 0) {
                            if (colg < 3 * D) { bf16_t* d = d0 + (size_t)(colg >> 11) * (SLOT_BYTES / 2); st4bf(d + (size_t)row * D + (colg & (D - 1)), o); }
                            else { const int cc = colg - 3 * D, blk = cc >> 7, oo = cc & 127; f32x4 a;
                                if (oo < 96) { if (blk & 1) a = o; else { a[0] = tanhf_(o[0]); a[1] = tanhf_(o[1]); a[2] = tanhf_(o[2]); a[3] = tanhf_(o[3]); } }
                                else if (blk < 2) { a[0] = sigmoidf_(o[0]); a[1] = sigmoidf_(o[1]); a[2] = sigmoidf_(o[2]); a[3] = sigmoidf_(o[3]); }
                                else a = z;
                                st4bf(lora + (size_t)row * LORA_W + cc, a); }
                        } else {
                            bf16_t* d = d0 + (size_t)(colg >> 11) * (SLOT_BYTES / 2); const int c = colg & (D - 1), b = row >> 14, t = row & (SEQ - 1);
                            const bool odd = fr & 1;
                            const float r0 = dppf<0xB1>(odd ? o[0] : o[2]), r1 = dppf<0xB1>(odd ? o[1] : o[3]);
                            const unsigned w0 = cvt_pk_bf16(odd ? r0 : o[0], odd ? o[2] : r0), w1 = cvt_pk_bf16(odd ? r1 : o[1], odd ? o[3] : r1);
                            bf16_t* q = d + ((size_t)(b * D + c + (odd ? 2 : 0))) * SEQ + (t - (odd ? 1 : 0));
                            *(unsigned*)q = w0; *(unsigned*)(q + SEQ) = w1;
                        }
                    }
                }
            }
    }
};

struct EpiLora {
    static constexpr bool PERM = true, AFTER_DRAIN = false;
    const float* bias4;
    int t0;
    bf16_t* dst0;
    __device__ __forceinline__ void operator()(const Acc& acc, const Unit& u, int wr, int wc, int fr, int fq) const {
        const int t = t0 + (u.pn >> 3); const bool isa = t & 1; const float mul = isa ? 1.0f : -0.60653065971f; const float* bias = bias4 + t * D; bf16_t* d = dst0 + (size_t)t * (SLOT_BYTES / 2);
#pragma unroll
        for (int bj = 0; bj < 2; ++bj) { const int col = (u.pn & 7) * 256 + bj * 128 + wc * 32 + 8 * fq; const f32x4 b0 = *(const f32x4*)(bias + col), b1 = *(const f32x4*)(bias + col + 4);
#pragma unroll
            for (int ai = 0; ai < 2; ++ai)
#pragma unroll
                for (int m = 0; m < 4; ++m) { const int row = u.pm * 256 + ai * 128 + wr * 64 + m * 16 + fr; const f32x4 x0 = acc[ai][bj][m][0] + b0, x1 = acc[ai][bj][m][1] + b1; f32x4 o0, o1;
#pragma unroll
                    for (int e = 0; e < 4; ++e) { o0[e] = sigmoidf_(x0[e]) * mul; o1[e] = sigmoidf_(x1[e]) * mul; }
                    st8bf(d + (size_t)row * D + col, o0, o1); } }
    }
};

struct EpiBf {
    static constexpr bool PERM = true, AFTER_DRAIN = false;
    bf16_t* O; int ldc;
    __device__ __forceinline__ void operator()(const Acc& acc, const Unit& u, int wr, int wc, int fr, int fq) const {
#pragma unroll
        for (int ai = 0; ai < 2; ++ai)
#pragma unroll
            for (int m = 0; m < 4; ++m) { const int row = u.pm * 256 + ai * 128 + wr * 64 + m * 16 + fr;
#pragma unroll
                for (int bj = 0; bj < 2; ++bj) st8bf(O + (size_t)row * ldc + u.pn * 256 + bj * 128 + wc * 32 + 8 * fq, acc[ai][bj][m][0], acc[ai][bj][m][1]); }
    }
};
struct EpiF32 {
    static constexpr bool PERM = false, AFTER_DRAIN = false;
    float* O; int ldc;
    __device__ __forceinline__ void operator()(const Acc& acc, const Unit& u, int wr, int wc, int fr, int fq) const {
#pragma unroll
        for (int ai = 0; ai < 2; ++ai)
#pragma unroll
            for (int m = 0; m < 4; ++m) { const int row = u.pm * 256 + ai * 128 + wr * 64 + m * 16 + fr;
#pragma unroll
                for (int bj = 0; bj < 2; ++bj)
#pragma unroll
                    for (int n = 0; n < 2; ++n) *(f32x4*)(O + (size_t)row * ldc + u.pn * 256 + bj * 128 + wc * 32 + n * 16 + 4 * fq) = acc[ai][bj][m][n]; }
    }
};
struct EpiGate {
    static constexpr bool PERM = false, AFTER_DRAIN = false;
    const bf16_t* yrw;
    const bf16_t* yhy;
    const float* yhc;
    bf16_t* y;
    __device__ __forceinline__ void operator()(const Acc& acc, const Unit& u, int wr, int wc, int fr, int fq) const {
        const bool lat = u.pm < TL / 256;
#pragma unroll
        for (int ai = 0; ai < 2; ++ai) {
            u32x2 rw[4][2]; float hy[4][2][4];
#pragma unroll
            for (int m = 0; m < 4; ++m) { const int row = u.pm * 256 + ai * 128 + wr * 64 + m * 16 + fr;
#pragma unroll
                for (int n = 0; n < 2; ++n) { const int ch = u.pn * 128 + wc * 32 + n * 16 + 4 * fq;
                    rw[m][n] = *(const u32x2*)(yrw + (size_t)row * D + ch);
                    if (lat) { const bf16_t* q = yhy + ((size_t)((row >> 14) * D + ch)) * SEQ + (row & (SEQ - 1));
#pragma unroll
                        for (int e = 0; e < 4; ++e) hy[m][n][e] = bf2f(q[(size_t)e * SEQ]); }
                    else { const int rc = row - TL; const float* q = yhc + ((size_t)((rc >> 8) * D + ch)) * CL + (rc & (CL - 1));
#pragma unroll
                        for (int e = 0; e < 4; ++e) hy[m][n][e] = q[(size_t)e * CL]; } } }
#pragma unroll
            for (int m = 0; m < 4; ++m) { const int row = u.pm * 256 + ai * 128 + wr * 64 + m * 16 + fr;
#pragma unroll
                for (int n = 0; n < 2; ++n) { const int ch = u.pn * 128 + wc * 32 + n * 16 + 4 * fq;
                    const float r4[4] = {bflo(rw[m][n].x), bfhi(rw[m][n].x), bflo(rw[m][n].y), bfhi(rw[m][n].y)};
                    f32x4 o;
#pragma unroll
                    for (int e = 0; e < 4; ++e) o[e] = sigmoidf_(acc[ai][0][m][n][e]) * r4[e] + sigmoidf_(acc[ai][1][m][n][e]) * hy[m][n][e];
                    st4bf(y + (size_t)row * D + ch, o); } }
        }
    }
};
struct EpiResid {
    static constexpr bool PERM = false, AFTER_DRAIN = false;
    float* xl; float* xc; const float* ga;
    const float* rl; const float* rc;
    __device__ __forceinline__ void operator()(const Acc& acc, const Unit& u, int wr, int wc, int fr, int fq) const {
        const int row00 = u.pm * 256 + wr * 64 + fr; const int mr = mrow_of(row00);
        const float* g = ga + (size_t)mr * 6 * D + u.pn * 256 + wc * 32 + 4 * fq;
        f32x4 gv[2][2];
#pragma unroll
        for (int bj = 0; bj < 2; ++bj)
#pragma unroll
            for (int n = 0; n < 2; ++n) gv[bj][n] = *(const f32x4*)(g + bj * 128 + n * 16);
#pragma unroll
        for (int ai = 0; ai < 2; ++ai)
#pragma unroll
            for (int mh = 0; mh < 2; ++mh) {
                f32x4 xv[2][2][2]; f32x4* qp[2];
#pragma unroll
                for (int mm = 0; mm < 2; ++mm) { const int row = row00 + ai * 128 + (2 * mh + mm) * 16;
                    const size_t ro = (row < TL ? (size_t)row * D : (size_t)(row - TL) * D) + u.pn * 256 + wc * 32 + 4 * fq;
                    float* xr = (row < TL ? xl : xc) + ro; qp[mm] = (f32x4*)xr; const float* xs = (row < TL ? rl : rc) + ro;
#pragma unroll
                    for (int bj = 0; bj < 2; ++bj)
#pragma unroll
                        for (int n = 0; n < 2; ++n) xv[mm][bj][n] = *(const f32x4*)(xs + bj * 128 + n * 16); }
#pragma unroll
                for (int mm = 0; mm < 2; ++mm)
#pragma unroll
                    for (int bj = 0; bj < 2; ++bj)
#pragma unroll
                        for (int n = 0; n < 2; ++n) *(f32x4*)((float*)qp[mm] + bj * 128 + n * 16) = xv[mm][bj][n] + gv[bj][n] * acc[ai][bj][2 * mh + mm][n]; }
    }
};

template <class Epi> __device__ __forceinline__ void run_gemm(const Params& p, unsigned char* lds, const bf16_t* A, int lda, const bf16_t* Bt, int ldb, int M, int N, int K, const Epi& E) {
    asm volatile("" : "+s"(M), "+s"(N), "+s"(K), "+s"(lda), "+s"(ldb));
    pg8::Gemm g{A, Bt, M, N, K, lda, ldb}; pg8::StaticOrder S; S.init(M, N, (int)p.nblk, (int)p.bid);
    pg8::gemm_phase<Epi, pg8::StaticOrder>((PG8_LAS unsigned char*)lds, g, S, E, p.tid);
}

template <int GROUP> __device__ __forceinline__ void ph_ctxconv(const Params& p) {
    constexpr int NC = GROUP == 0 ? NR : NHY;
    const float* cw = (const float*)(p.ws + WS_CONVW) + (GROUP == 0 ? 0 : NR);
    const bf16_t* pc = (const bf16_t*)(p.ws + WS_PCTX);
    const int items = TC * (NC / 4);
    for (int i = p.bid * NTHREADS + p.tid; i < items; i += p.nblk * NTHREADS) {
        const int rc = i / (NC / 4), colg = (i % (NC / 4)) * 4, t = rc & (CL - 1);
        const f32x4 w0 = *(const f32x4*)(cw + colg), w1 = *(const f32x4*)(cw + NTOT + colg), w2 = *(const f32x4*)(cw + 2 * NTOT + colg);
        const u32x2 c = *(const u32x2*)(pc + (size_t)rc * NR + colg);
        u32x2 a = (u32x2){0u, 0u}, b = (u32x2){0u, 0u};
        if (t > 0) a = *(const u32x2*)(pc + (size_t)(rc - 1) * NR + colg);
        if (t < CL - 1) b = *(const u32x2*)(pc + (size_t)(rc + 1) * NR + colg);
        const f32x4 pv = (f32x4){bflo(a.x), bfhi(a.x), bflo(a.y), bfhi(a.y)}, cu = (f32x4){bflo(c.x), bfhi(c.x), bflo(c.y), bfhi(c.y)}, nx = (f32x4){bflo(b.x), bfhi(b.x), bflo(b.y), bfhi(b.y)};
        const f32x4 o = w0 * pv + w1 * cu + w2 * nx;
        const int row = TL + rc;
        if (GROUP == 0) {
            if (colg < 3 * D) { bf16_t* d = slot(p, colg < D ? 0 : colg < 2 * D ? 1 : 2); st4bf(d + (size_t)row * D + (colg & (D - 1)), o); }
            else { const int cc = colg - 3 * D, blk = cc >> 7, oo = cc & 127; f32x4 v;
                if (oo < 96) { if (blk & 1) v = o; else { v[0] = tanhf_(o[0]); v[1] = tanhf_(o[1]); v[2] = tanhf_(o[2]); v[3] = tanhf_(o[3]); } }
                else if (blk < 2) { v[0] = sigmoidf_(o[0]); v[1] = sigmoidf_(o[1]); v[2] = sigmoidf_(o[2]); v[3] = sigmoidf_(o[3]); }
                else v = (f32x4){0.f, 0.f, 0.f, 0.f};
                st4bf((bf16_t*)(p.ws + WS_LORAIN) + (size_t)row * LORA_W + cc, v); }
        } else {
            float* d = (float*)(p.ws + WS_CV) + (size_t)(colg >> 11) * (NB * D * CL); const int c0 = colg & (D - 1), b_ = rc >> 8;
#pragma unroll
            for (int e = 0; e < 4; ++e) d[((size_t)(b_ * D + c0 + e)) * CL + t] = o[e];
        }
    }
}

constexpr int SC_CH = 32;
constexpr int SC_NCH = (CL + SEQ) / SC_CH;
constexpr int SC_BUF_F = 6 * SC_CH * 64;
__device__ __forceinline__ int scan_row(int b, int dir, int s) {
    if (s < CL) return TL + b * CL + (dir ? CL - 1 - s : s);
    const int t = s - CL; return b * SEQ + (dir ? SEQ - 1 - t : t);
}
__device__ __forceinline__ void ph_scan(const Params& p, int l, unsigned char* lds_raw) {
    float* lds = (float*)lds_raw;
    float* ybuf = lds + 2 * SC_BUF_F;
    const int tid = p.tid, tl = tid >> 4, jq = tid & 15, ip = tid >> 4;
    for (int unit = p.bid; unit < NB * NHEAD * 2; unit += p.nblk) {
        const int dir = unit & 1, h = (unit >> 1) & (NHEAD - 1), b = unit >> 6;
        const bf16_t* kb = slot(p, 0); const bf16_t* vb = slot(p, 1); const bf16_t* rb = slot(p, 2);
        bf16_t* lw = slot(p, 3 + 2 * dir); const bf16_t* ab = slot(p, 4 + 2 * dir);
        const int col0 = h * HN + 4 * jq;
        const f32x4 kkw = *(const f32x4*)(inp(p, I_KK) + l * D + col0), kaw = *(const f32x4*)(inp(p, I_KA) + l * D + col0);
        float S0[4] = {0.f, 0.f, 0.f, 0.f}, S1[4] = {0.f, 0.f, 0.f, 0.f};
        u32x2 gk, gv, gr, gw, ga;
        auto gload = [&](int c) { const size_t off = (size_t)scan_row(b, dir, c * SC_CH + tl) * D + col0;
            gk = *(const u32x2*)(kb + off); gv = *(const u32x2*)(vb + off); gr = *(const u32x2*)(rb + off); gw = *(const u32x2*)(lw + off); ga = *(const u32x2*)(ab + off); };
        auto gstage = [&](int buf) { float* B = lds + buf * SC_BUF_F + tl * 64 + 4 * jq;
            const f32x4 k4 = (f32x4){bflo(gk.x), bfhi(gk.x), bflo(gk.y), bfhi(gk.y)}, a4 = (f32x4){bflo(ga.x), bfhi(ga.x), bflo(ga.y), bfhi(ga.y)};
            const f32x4 w4 = (f32x4){__expf(bflo(gw.x)), __expf(bfhi(gw.x)), __expf(bflo(gw.y)), __expf(bfhi(gw.y))};
            const f32x4 kx = k4 * kkw; float ss = kx[0] * kx[0] + kx[1] * kx[1] + kx[2] * kx[2] + kx[3] * kx[3]; ss = red16(ss);
            const f32x4 kk = kx * rsqrtf(fmaxf(ss, 1e-24f));
            *(f32x4*)(B) = kk; *(f32x4*)(B + SC_CH * 64) = w4; *(f32x4*)(B + 2 * SC_CH * 64) = kk * a4; *(f32x4*)(B + 3 * SC_CH * 64) = k4 * ((a4 - 1.0f) * kaw + 1.0f);
            *(f32x4*)(B + 4 * SC_CH * 64) = (f32x4){bflo(gr.x), bfhi(gr.x), bflo(gr.y), bfhi(gr.y)}; *(f32x4*)(B + 5 * SC_CH * 64) = (f32x4){bflo(gv.x), bfhi(gv.x), bflo(gv.y), bfhi(gv.y)}; };
        __syncthreads();
        gload(0); gstage(0);
        __syncthreads();
        for (int c = 0; c < SC_NCH; ++c) {
            const int buf = c & 1;
            if (c + 1 < SC_NCH) gload(c + 1);
            if (c > 0) {
                const float* Y = ybuf + (buf ^ 1) * (SC_CH * 64) + tl * 64 + 4 * jq; const f32x4 yv = *(const f32x4*)Y;
                st4bf(lw + (size_t)scan_row(b, dir, (c - 1) * SC_CH + tl) * D + col0, yv); }
            const float* B = lds + buf * SC_BUF_F + 4 * jq; float* Yw = ybuf + buf * (SC_CH * 64);
#pragma unroll 4
            for (int s = 0; s < SC_CH; ++s) {
                const f32x4 kk = *(const f32x4*)(B + s * 64), w = *(const f32x4*)(B + SC_CH * 64 + s * 64), ka = *(const f32x4*)(B + 2 * SC_CH * 64 + s * 64),
                            kt = *(const f32x4*)(B + 3 * SC_CH * 64 + s * 64), rr = *(const f32x4*)(B + 4 * SC_CH * 64 + s * 64);
                const f32x2 vv = *(const f32x2*)(lds + buf * SC_BUF_F + 5 * SC_CH * 64 + s * 64 + 2 * ip);
                float d0 = S0[0] * kk[0] + S0[1] * kk[1] + S0[2] * kk[2] + S0[3] * kk[3];
                float d1 = S1[0] * kk[0] + S1[1] * kk[1] + S1[2] * kk[2] + S1[3] * kk[3];
                d0 = red16(d0); d1 = red16(d1);
#pragma unroll
                for (int e = 0; e < 4; ++e) { S0[e] = S0[e] * w[e] + vv.x * kt[e] - d0 * ka[e]; S1[e] = S1[e] * w[e] + vv.y * kt[e] - d1 * ka[e]; }
                float y0 = S0[0] * rr[0] + S0[1] * rr[1] + S0[2] * rr[2] + S0[3] * rr[3];
                float y1 = S1[0] * rr[0] + S1[1] * rr[1] + S1[2] * rr[2] + S1[3] * rr[3];
                y0 = red16(y0); y1 = red16(y1);
                if (jq == 0) *(f32x2*)(Yw + s * 64 + 2 * ip) = (f32x2){y0, y1};
            }
            if (c + 1 < SC_NCH) gstage(buf ^ 1);
            __syncthreads();
        }
        { const float* Y = ybuf + ((SC_NCH - 1) & 1) * (SC_CH * 64) + tl * 64 + 4 * jq; const f32x4 yv = *(const f32x4*)Y;
          st4bf(lw + (size_t)scan_row(b, dir, (SC_NCH - 1) * SC_CH + tl) * D + col0, yv); }
    }
}

__device__ __forceinline__ void ph_rwkv_out(const Params& p, int l, int M, unsigned char* lds_raw) {
    constexpr int RB = 8;
    float* sb = (float*)lds_raw;
    const int tid = p.tid, col = 4 * tid;
    const f32x4 lnw = *(const f32x4*)(inp(p, I_LNW) + l * D + col), lnb = *(const f32x4*)(inp(p, I_LNB) + l * D + col), rk = *(const f32x4*)(inp(p, I_RK) + l * D + col);
    const float* g2 = inp(p, I_G2) + (size_t)l * 64 * D;
    const bf16_t* kb = slot(p, 0); const bf16_t* vb = slot(p, 1); const bf16_t* rb = slot(p, 2); const bf16_t* yf = slot(p, 3); const bf16_t* yb = slot(p, 5);
    const bf16_t* lora = (const bf16_t*)(p.ws + WS_LORAIN); bf16_t* out = slot(p, 6);
    for (int row0 = p.bid * RB; row0 < M; row0 += p.nblk * RB) {
        __syncthreads();
        { const int r = tid >> 6, i = tid & 63; sb[i * RB + r] = bf2f(lora[(size_t)(row0 + r) * LORA_W + (i < 32 ? 96 + i : 224 + (i - 32))]); }
        __syncthreads();
        f32x4 g[RB];
#pragma unroll
        for (int r = 0; r < RB; ++r) g[r] = (f32x4){0.f, 0.f, 0.f, 0.f};
#pragma unroll 1
        for (int ib = 0; ib < 64; ib += 16) {
            f32x4 w[16];
#pragma unroll
            for (int i = 0; i < 16; ++i) w[i] = *(const f32x4*)(g2 + (size_t)(ib + i) * D + col);
#pragma unroll
            for (int i = 0; i < 16; ++i) { const f32x4 s0 = *(const f32x4*)(sb + (ib + i) * RB), s1 = *(const f32x4*)(sb + (ib + i) * RB + 4);
#pragma unroll
                for (int r = 0; r < 4; ++r) { g[r] += w[i] * s0[r]; g[4 + r] += w[i] * s1[r]; } } }
        u32x2 ya[RB], yb2[RB], kk2[RB], vv2[RB], rr2[RB];
#pragma unroll
        for (int r = 0; r < RB; ++r) { const size_t off = (size_t)(row0 + r) * D + col;
            ya[r] = *(const u32x2*)(yf + off); yb2[r] = *(const u32x2*)(yb + off); kk2[r] = *(const u32x2*)(kb + off); vv2[r] = *(const u32x2*)(vb + off); rr2[r] = *(const u32x2*)(rb + off); }
#pragma unroll
        for (int r = 0; r < RB; ++r) {
            const size_t off = (size_t)(row0 + r) * D + col;
            const u32x2 a = ya[r], b = yb2[r], k2 = kk2[r], v2 = vv2[r], r2 = rr2[r];
            const f32x4 y = (f32x4){bflo(a.x) + bflo(b.x), bfhi(a.x) + bfhi(b.x), bflo(a.y) + bflo(b.y), bfhi(a.y) + bfhi(b.y)};
            const f32x4 k4 = (f32x4){bflo(k2.x), bfhi(k2.x), bflo(k2.y), bfhi(k2.y)}, v4 = (f32x4){bflo(v2.x), bfhi(v2.x), bflo(v2.y), bfhi(v2.y)}, r4 = (f32x4){bflo(r2.x), bfhi(r2.x), bflo(r2.y), bfhi(r2.y)};
            const float mu = red16(y[0] + y[1] + y[2] + y[3]) * (1.0f / HN);
            const f32x4 dy = y - mu;
            const float var = red16(dy[0] * dy[0] + dy[1] * dy[1] + dy[2] * dy[2] + dy[3] * dy[3]) * (1.0f / HN);
            const f32x4 yn = dy * rsqrtf(var + GN_EPS) * lnw + lnb;
            const f32x4 rkk = r4 * k4 * rk;
            const float bon = red16(rkk[0] + rkk[1] + rkk[2] + rkk[3]);
            st4bf(out + off, (yn + v4 * bon) * g[r]);
        }
    }
}

constexpr int S3_NS = 5, S3_NCH = (CL + SEQ) / 16;
constexpr int S3_SLOT = 18432;
constexpr int S3_OXQ1 = 0, S3_OXY = 3328, S3_OKAP = 6656, S3_OVU = 11776, S3_OTX = 16896, S3_OG = 18176;
constexpr int S3_PSCR = 8192;
constexpr int S3_OAL = 0, S3_OKH = 2304, S3_OAF = 4608, S3_ORN = 5632;
constexpr int S3_CSCR = 3584;
constexpr int S3_RING = 0, S3_PBASE = S3_RING + S3_NS * S3_SLOT, S3_CBASE = S3_PBASE + 4 * S3_PSCR, S3_FLAGS = S3_CBASE + 4 * S3_CSCR, S3_END = S3_FLAGS + 64;
static_assert(S3_END <= LDS_BYTES - 64, "scan LDS layout");
constexpr unsigned S3_SPIN_CAP = 1u << 22;
typedef short bf16x8_t __attribute__((ext_vector_type(8)));
__device__ __forceinline__ bf16x8_t ldfrag(const bf16_t* p) { return *(const bf16x8_t*)p; }
__device__ __forceinline__ f32x4 mma(const bf16x8_t a, const bf16x8_t b, const f32x4 c) { return __builtin_amdgcn_mfma_f32_16x16x32_bf16(a, b, c, 0, 0, 0); }
__device__ __forceinline__ bf16_t cvbf(float x) { return (bf16_t)(pg8::cvt_pk_bf16(x, 0.f) & 0xFFFFu); }
#define S3_LGKM() asm volatile("s_waitcnt lgkmcnt(0)" ::: "memory")
__device__ __forceinline__ void ph_scan3(const Params& p, int l, unsigned char* lds) {
    const int tid = p.tid, lane = tid & 63, wid = __builtin_amdgcn_readfirstlane(tid >> 6), fr = lane & 15, fq = lane >> 4;
    LAS unsigned* flags = (LAS unsigned*)(lds + S3_FLAGS);
#define S3_FLD(i) __hip_atomic_load(flags + (i), __ATOMIC_RELAXED, __HIP_MEMORY_SCOPE_WORKGROUP)
#define S3_FST(i, v) __hip_atomic_store(flags + (i), (v), __ATOMIC_RELAXED, __HIP_MEMORY_SCOPE_WORKGROUP)
    const bf16_t* kb = slot(p, 0); const bf16_t* vb = slot(p, 1); const bf16_t* rb = slot(p, 2);
    const f32x4 zero4 = (f32x4){0.f, 0.f, 0.f, 0.f};
    for (int unit = p.bid; unit < NB * NHEAD * 2; unit += p.nblk) {
        const int dir = unit & 1, h = (unit >> 1) & (NHEAD - 1), b = unit >> 6;
        bf16_t* lwy = slot(p, 3 + 2 * dir); const bf16_t* ab = slot(p, 4 + 2 * dir);
        const long rstride = dir ? -(long)D : (long)D;
        __syncthreads();
        for (int i = tid; i < S3_END / 4; i += NTHREADS) ((unsigned*)lds)[i] = 0u;
        __syncthreads();
        if (wid >= 4) {
            const int pw = wid - 4;
            unsigned char* scr = lds + S3_PBASE + pw * S3_PSCR;
            bf16_t* AL = (bf16_t*)(scr + S3_OAL); bf16_t* KH = (bf16_t*)(scr + S3_OKH); float* AF = (float*)(scr + S3_OAF); float* RN = (float*)(scr + S3_ORN);
            const float kkj = inp(p, I_KK)[l * D + h * HN + lane], kaj = inp(p, I_KA)[l * D + h * HN + lane];
            const int rt = lane >> 2, rp = lane & 3;
            const float* kkp = inp(p, I_KK) + l * D + h * HN + 16 * rp;
            const f32x4 kc0 = *(const f32x4*)kkp, kc1 = *(const f32x4*)(kkp + 4), kc2 = *(const f32x4*)(kkp + 8), kc3 = *(const f32x4*)(kkp + 12);
            typedef unsigned short u16x2 __attribute__((ext_vector_type(2)));
            u16x2 kq[8], rq[8], lq[8], aq[8], vq[8]; u32x4 kn0, kn1;
#define S3_FETCH(cc, K_, R_, L_, A_, V_, N0_, N1_) do { const size_t o_ = (size_t)scan_row(b, dir, 16 * (cc)) * D + h * HN; \
                const bf16_t* kp_ = kb + o_ + lane; const bf16_t* rp_ = rb + o_ + lane; const bf16_t* lp_ = lwy + o_ + lane; const bf16_t* ap_ = ab + o_ + lane; const bf16_t* vp_ = vb + o_ + lane; \
                _Pragma("unroll") for (int t = 0; t < 16; ++t) { K_[t >> 1][t & 1] = *kp_; R_[t >> 1][t & 1] = *rp_; L_[t >> 1][t & 1] = *lp_; A_[t >> 1][t & 1] = *ap_; V_[t >> 1][t & 1] = *vp_; kp_ += rstride; rp_ += rstride; lp_ += rstride; ap_ += rstride; vp_ += rstride; } \
                const bf16_t* kr_ = kb + o_ + (long)rt * rstride + 16 * rp; N0_ = *(const u32x4*)kr_; N1_ = *(const u32x4*)(kr_ + 8); } while (0)
            S3_FETCH(pw, kq, rq, lq, aq, vq, kn0, kn1);
#pragma unroll 1
            for (int c = pw; c < S3_NCH; c += 4) {
                const int sl = c % S3_NS; unsigned char* sb = lds + S3_RING + sl * S3_SLOT;
                bf16_t* XQ1 = (bf16_t*)(sb + S3_OXQ1); bf16_t* XY = (bf16_t*)(sb + S3_OXY); bf16_t* KAP = (bf16_t*)(sb + S3_OKAP); bf16_t* VU = (bf16_t*)(sb + S3_OVU); bf16_t* TX = (bf16_t*)(sb + S3_OTX); float* G = (float*)(sb + S3_OG);
                u16x2 kq2[8], rq2[8], lq2[8], aq2[8], vq2[8]; u32x4 kn2, kn3;
                { const int cn = c + 4 < S3_NCH ? c + 4 : c; S3_FETCH(cn, kq2, rq2, lq2, aq2, vq2, kn2, kn3); }
                { const u32x4 w0 = kn0, w1 = kn1;
                  const float x0 = bflo(w0[0]) * kc0[0], x1 = bfhi(w0[0]) * kc0[1], x2 = bflo(w0[1]) * kc0[2], x3 = bfhi(w0[1]) * kc0[3], x4 = bflo(w0[2]) * kc1[0], x5 = bfhi(w0[2]) * kc1[1], x6 = bflo(w0[3]) * kc1[2], x7 = bfhi(w0[3]) * kc1[3];
                  const float y0 = bflo(w1[0]) * kc2[0], y1 = bfhi(w1[0]) * kc2[1], y2 = bflo(w1[1]) * kc2[2], y3 = bfhi(w1[1]) * kc2[3], y4 = bflo(w1[2]) * kc3[0], y5 = bfhi(w1[2]) * kc3[1], y6 = bflo(w1[3]) * kc3[2], y7 = bfhi(w1[3]) * kc3[3];
                  float ss = x0 * x0 + x1 * x1 + x2 * x2 + x3 * x3 + x4 * x4 + x5 * x5 + x6 * x6 + x7 * x7 + y0 * y0 + y1 * y1 + y2 * y2 + y3 * y3 + y4 * y4 + y5 * y5 + y6 * y6 + y7 * y7;
                  ss += dppf<0xB1>(ss); ss += dppf<0x4E>(ss);
                  if (rp == 0) RN[rt] = rsqrtf(fmaxf(ss, 1e-24f)); }
                if (c >= S3_NS) { const unsigned need = (unsigned)(c - S3_NS + 1); unsigned sp = 0;
                    for (;;) { const unsigned m0 = S3_FLD(8), m1 = S3_FLD(9), m2 = S3_FLD(10), m3 = S3_FLD(11); const unsigned mn = min(min(m0, m1), min(m2, m3));
                        if (mn >= need || ++sp > S3_SPIN_CAP) break; __builtin_amdgcn_s_sleep(1); } }
                asm volatile("" ::: "memory");
                S3_LGKM();
                { float cl[16]; float run = 0.f;
#pragma unroll
                  for (int t = 0; t < 16; ++t) { run += bf2f(lq[t >> 1][t & 1]); cl[t] = run; }
                  const float cend = cl[15], gend = __expf(cend); G[lane] = gend;
                  unsigned kp[8], ap[8], vv[8]; float epm1 = 1.0f;
#pragma unroll
                  for (int t = 0; t < 16; ++t) {
                      const float em = __expf(-cl[t]), ep = __builtin_amdgcn_rcpf(em), ee = gend * em;
                      const float kv = bf2f(kq[t >> 1][t & 1]), a = bf2f(aq[t >> 1][t & 1]), kap = kv * kkj * RN[t], al = a * kap, kt = kv * (1.0f + (a - 1.0f) * kaj);
                      XQ1[t * 104 + lane] = cvbf(epm1 * kap); AL[t * 72 + lane] = cvbf(al * em); KH[t * 72 + lane] = cvbf(kt * em); XY[t * 104 + lane] = cvbf(bf2f(rq[t >> 1][t & 1]) * ep);
                      const unsigned kpb = cvbf(kt * ee), apb = cvbf(al * ee);
                      if (t & 1) { kp[t >> 1] |= kpb << 16; ap[t >> 1] |= apb << 16; } else { kp[t >> 1] = kpb; ap[t >> 1] = apb; vv[t >> 1] = __builtin_bit_cast(unsigned, vq[t >> 1]); }
                      epm1 = ep; }
                  u32x4* d = (u32x4*)(KAP + lane * 40);
                  d[0] = (u32x4){kp[0], kp[1], kp[2], kp[3]}; d[1] = (u32x4){kp[4], kp[5], kp[6], kp[7]}; d[2] = (u32x4){ap[0], ap[1], ap[2], ap[3]}; d[3] = (u32x4){ap[4], ap[5], ap[6], ap[7]};
                  u32x4* dv = (u32x4*)(VU + lane * 40); dv[0] = (u32x4){vv[0], vv[1], vv[2], vv[3]}; dv[1] = (u32x4){vv[4], vv[5], vv[6], vv[7]}; }
                S3_LGKM();
                { const bf16_t* Xk = XQ1 + fr * 104 + 8 * fq; const bf16_t* Xr = XY + fr * 104 + 8 * fq; const bf16_t* Ya = AL + fr * 72 + 8 * fq; const bf16_t* Yk = KH + fr * 72 + 8 * fq;
                  f32x4 dA = zero4, dB = zero4, dE = zero4, dF = zero4;
#pragma unroll
                  for (int ks = 0; ks < 2; ++ks) { const bf16x8_t xk = ldfrag(Xk + 32 * ks), xr = ldfrag(Xr + 32 * ks), ya = ldfrag(Ya + 32 * ks), yk = ldfrag(Yk + 32 * ks);
                      dA = mma(xk, ya, dA); dB = mma(xk, yk, dB); dE = mma(xr, yk, dE); dF = mma(xr, ya, dF); }
#pragma unroll
                  for (int e = 0; e < 4; ++e) { const int t = 4 * fq + e; const bool lo = fr < t, le = fr <= t;
                      dA[e] = lo ? dA[e] : 0.f; XQ1[t * 104 + 64 + fr] = cvbf(lo ? dB[e] : 0.f); XY[t * 104 + 64 + fr] = cvbf(le ? dE[e] : 0.f); XY[t * 104 + 80 + fr] = cvbf(le ? dF[e] : 0.f); }
                  float tc[16];
#pragma unroll
                  for (int t = 0; t < 16; ++t) { float v0 = (t == fr) ? 1.0f : 0.0f, v1 = 0.f;
#pragma unroll
                      for (int s = 0; s < t; ++s) { const float a = rdlane(dA[t & 3], 16 * (t >> 2) + s); if (s & 1) v1 -= a * tc[s]; else v0 -= a * tc[s]; }
                      tc[t] = v0 + v1; }
                  if (fq == 0) {
#pragma unroll
                      for (int t = 0; t < 16; ++t) TX[t * 40 + fr] = cvbf(tc[t]); } }
                S3_LGKM();
                if (lane == 0) S3_FST(sl, (unsigned)(c + 1));
#pragma unroll
                for (int t = 0; t < 8; ++t) { kq[t] = kq2[t]; rq[t] = rq2[t]; lq[t] = lq2[t]; aq[t] = aq2[t]; vq[t] = vq2[t]; }
                kn0 = kn2; kn1 = kn3;
            }
#undef S3_FETCH
        } else {
            const int it = wid;
            unsigned char* scr = lds + S3_CBASE + it * S3_CSCR;
            bf16_t* SB = (bf16_t*)scr; bf16_t* RT = (bf16_t*)(scr + 2304);
            f32x4 Sacc[4] = {zero4, zero4, zero4, zero4};
#pragma unroll 1
            for (int c = 0; c < S3_NCH; ++c) {
                const int sl = c % S3_NS; unsigned char* sb = lds + S3_RING + sl * S3_SLOT;
                const bf16_t* XQ1 = (const bf16_t*)(sb + S3_OXQ1); const bf16_t* XY = (const bf16_t*)(sb + S3_OXY); const bf16_t* KAP = (const bf16_t*)(sb + S3_OKAP); bf16_t* VU = (bf16_t*)(sb + S3_OVU); const bf16_t* TX = (const bf16_t*)(sb + S3_OTX); const float* G = (const float*)(sb + S3_OG);
                { unsigned sp = 0; while (S3_FLD(sl) != (unsigned)(c + 1)) { if (++sp > S3_SPIN_CAP) break; __builtin_amdgcn_s_sleep(1); } }
                asm volatile("" ::: "memory");
                const bf16_t* Ys = SB + fr * 72 + 8 * fq; bf16_t* VUr = VU + (16 * it + fr) * 40;
                { const bf16_t* X = XQ1 + fr * 104 + 8 * fq;
                  f32x4 d = mma(ldfrag(X), ldfrag(Ys), zero4); d = mma(ldfrag(X + 32), ldfrag(Ys + 32), d); d = mma(ldfrag(X + 64), ldfrag(VUr + 8 * fq), d);
                  *(u32x2*)(RT + fr * 40 + 4 * fq) = (u32x2){pg8::cvt_pk_bf16(d[0], d[1]), pg8::cvt_pk_bf16(d[2], d[3])}; }
                S3_LGKM();
                { const f32x4 d = mma(ldfrag(TX + fr * 40 + 8 * fq), ldfrag(RT + fr * 40 + 8 * fq), zero4);
                  *(u32x2*)(VUr + 16 + 4 * fq) = (u32x2){pg8::cvt_pk_bf16(-d[0], -d[1]), pg8::cvt_pk_bf16(-d[2], -d[3])}; }
                S3_LGKM();
                const bf16x8_t vu = ldfrag(VUr + 8 * fq);
                { const bf16_t* X = XY + fr * 104 + 8 * fq;
                  f32x4 d = mma(ldfrag(X), ldfrag(Ys), zero4); d = mma(ldfrag(X + 32), ldfrag(Ys + 32), d); d = mma(ldfrag(X + 64), vu, d);
                  bf16_t* yo = lwy + (size_t)scan_row(b, dir, 16 * c + 4 * fq) * D + h * HN + 16 * it + fr;
#pragma unroll
                  for (int e = 0; e < 4; ++e) { *yo = cvbf(d[e]); yo += rstride; } }
#pragma unroll
                for (int jt = 0; jt < 4; ++jt) Sacc[jt] = mma(vu, ldfrag(KAP + (16 * jt + fr) * 40 + 8 * fq), Sacc[jt] * G[16 * jt + fr]);
#pragma unroll
                for (int jt = 0; jt < 4; ++jt)
#pragma unroll
                    for (int e = 0; e < 4; ++e) SB[(4 * fq + e) * 72 + 16 * jt + fr] = cvbf(Sacc[jt][e]);
                S3_LGKM();
                if (lane == 0) S3_FST(8 + it, (unsigned)(c + 1));
            }
        }
    }
    __syncthreads();
}

__device__ __forceinline__ float hy_delta(int c) { return 3.0701134573f + (float)c * ((15.3505672866f - 3.0701134573f) / 2047.0f); }
__device__ __forceinline__ void ph_ctxfilter(const Params& p, int l) {
    const bf16_t* hd = (const bf16_t*)(p.ws + WS_HDNC); const float* w3 = inp(p, I_HW3) + (size_t)l * 64 * 8192; float* hcf = (float*)(p.ws + WS_HCF);
    const int gt = p.bid * NTHREADS + p.tid, GT = p.nblk * NTHREADS;
    if (GT % 8192 == 0) {
        const int col = gt % 8192; float wc[64];
#pragma unroll
        for (int k = 0; k < 64; ++k) wc[k] = w3[(size_t)k * 8192 + col];
        const float dl = hy_delta(col & (D - 1));
        for (int n = gt / 8192; n < CL; n += GT / 8192) { u32x4 hv[8];
#pragma unroll
            for (int k8 = 0; k8 < 8; ++k8) hv[k8] = *(const u32x4*)(hd + n * 256 + 8 * k8);
            float s = 0.f;
#pragma unroll
            for (int k8 = 0; k8 < 8; ++k8)
#pragma unroll
                for (int e = 0; e < 4; ++e) s += bflo(hv[k8][e]) * wc[8 * k8 + 2 * e] + bfhi(hv[k8][e]) * wc[8 * k8 + 2 * e + 1];
            hcf[(size_t)col * CL + n] = s * __expf(-((float)n / (float)(CL - 1)) * dl); }
    } else {
        for (int i = gt; i < 8192 * CL; i += GT) {
            const int col = i % 8192, n = i / 8192; float s = 0.f;
            for (int k = 0; k < 64; ++k) s += bf2f(hd[n * 256 + k]) * w3[(size_t)k * 8192 + col];
            hcf[(size_t)col * CL + n] = s * __expf(-((float)n / (float)(CL - 1)) * hy_delta(col & (D - 1))); }
    }
}
__device__ __forceinline__ void ph_ctxhyena(const Params& p, int l, unsigned char* lds_raw) {
    const int lane = p.tid & 63, wid = p.tid >> 6, wv = p.bid * 8 + wid, NW = p.nblk * 8;
    float* L = (float*)lds_raw + wid * 768;
    const float* hcf = (const float*)(p.ws + WS_HCF); const float* cv = (const float*)(p.ws + WS_CV); float* yhc = (float*)(p.ws + WS_YHC);
    for (int u = wv; u < NB * D; u += NW) {
        const int c = u & (D - 1), b = u >> 11;
        f32x4 z = *(const f32x4*)(cv + ((size_t)(b * D + c)) * CL + 4 * lane);
#pragma unroll
        for (int o = 0; o < 2; ++o) {
            const f32x4 f = *(const f32x4*)(hcf + ((size_t)((o * 2 + 0) * D + c)) * CL + 4 * lane), g = *(const f32x4*)(hcf + ((size_t)((o * 2 + 1) * D + c)) * CL + 4 * lane);
            float ss = 0.f;
#pragma unroll
            for (int i = 0; i < 4; ++i) { const int n = 4 * lane + i; if (n == 0) L[256 + 255] = f[i] + g[i]; else { L[256 + 255 - n] = f[i]; L[256 + 255 + n] = g[i]; } ss += f[i] * f[i] + g[i] * g[i]; }
            *(f32x4*)(L + 4 * lane) = z;
            ss = wave_sum(ss); const float rn = rsqrtf(ss);
            const float sk = inp(p, I_HSKIP)[(l * 2 + o) * D + c];
            const float* gate = cv + (size_t)(o + 1) * (NB * D * CL) + ((size_t)(b * D + c)) * CL;
            f32x4 acc = (f32x4){0.f, 0.f, 0.f, 0.f};
            const float* hb = L + 256 + 252 - 4 * lane;
#pragma unroll 4
            for (int s0 = 0; s0 < CL; s0 += 4) { const f32x4 us = *(const f32x4*)(L + s0), wa = *(const f32x4*)(hb + s0), wb = *(const f32x4*)(hb + s0 + 4);
                const float W[8] = {wa[0], wa[1], wa[2], wa[3], wb[0], wb[1], wb[2], wb[3]};
#pragma unroll
                for (int i = 0; i < 4; ++i)
#pragma unroll
                    for (int q = 0; q < 4; ++q) acc[i] += W[3 - i + q] * us[q]; }
            const f32x4 gt = *(const f32x4*)(gate + 4 * lane);
            z = gt * (acc * rn + z * sk);
        }
        *(f32x4*)(yhc + ((size_t)(b * D + c)) * CL + 4 * lane) = z;
    }
}

__device__ __forceinline__ f32x2 cmul(const f32x2 a, const f32x2 b) {
    const f32x2 t = a * __builtin_shufflevector(b, b, 0, 0);
    return __builtin_elementwise_fma(__builtin_shufflevector(a, a, 1, 0), (f32x2){-b.y, b.y}, t); }
__device__ __forceinline__ f32x2 cconj(const f32x2 a) { return (f32x2){a.x, -a.y}; }
template <bool INV> __device__ __forceinline__ void dft4(f32x2& a, f32x2& b, f32x2& c, f32x2& d) {
    const f32x2 s0 = a + c, s1 = a - c, s2 = b + d, s3 = b - d;
    const f32x2 r = __builtin_shufflevector(s3, s3, 1, 0); const f32x2 sg = INV ? (f32x2){-1.f, 1.f} : (f32x2){1.f, -1.f};
    a = s0 + s2; c = s0 - s2; b = __builtin_elementwise_fma(r, sg, s1); d = __builtin_elementwise_fma(r, -sg, s1);
}
template <bool INV> __device__ __forceinline__ void dft16(f32x2 (&x)[16]) {
    constexpr float C[10] = {1.f, 0.92387953251f, 0.70710678119f, 0.38268343237f, 0.f, 0.f, -0.70710678119f, 0.f, 0.f, -0.92387953251f};
    constexpr float S[10] = {0.f, 0.38268343237f, 0.70710678119f, 0.92387953251f, 1.f, 0.f, 0.70710678119f, 0.f, 0.f, -0.38268343237f};
#pragma unroll
    for (int n1 = 0; n1 < 4; ++n1) dft4<INV>(x[n1], x[n1 + 4], x[n1 + 8], x[n1 + 12]);
#pragma unroll
    for (int n1 = 1; n1 < 4; ++n1)
#pragma unroll
        for (int k2 = 1; k2 < 4; ++k2) { const int m = n1 * k2; x[n1 + 4 * k2] = cmul(x[n1 + 4 * k2], (f32x2){C[m], INV ? S[m] : -S[m]}); }
#pragma unroll
    for (int k2 = 0; k2 < 4; ++k2) dft4<INV>(x[4 * k2], x[4 * k2 + 1], x[4 * k2 + 2], x[4 * k2 + 3]);
    f32x2 y[16];
#pragma unroll
    for (int k1 = 0; k1 < 4; ++k1)
#pragma unroll
        for (int k2 = 0; k2 < 4; ++k2) y[4 * k1 + k2] = x[4 * k2 + k1];
#pragma unroll
    for (int k = 0; k < 16; ++k) x[k] = y[k];
}
__device__ __forceinline__ int zpad(int pidx) { return pidx + 2 * (pidx >> 4); }
constexpr int ZN = 18432;

__device__ __forceinline__ f32x2 twf(int j) { float x = (float)j * (1.0f / 32768.0f); asm volatile("" : "+v"(x));
    return (f32x2){__builtin_amdgcn_cosf(x), -__builtin_amdgcn_sinf(x)}; }
struct HyRaw { f32x2 a, b, c; unsigned w; unsigned short s0, s1, s2, s3; };
template <bool INV> __device__ __forceinline__ void dft32(f32x2 (&x)[32]) {
    constexpr float C[16] = {1.f, 0.98078528040f, 0.92387953251f, 0.83146961230f, 0.70710678119f, 0.55557023302f, 0.38268343237f, 0.19509032202f,
                             0.f, -0.19509032202f, -0.38268343237f, -0.55557023302f, -0.70710678119f, -0.83146961230f, -0.92387953251f, -0.98078528040f};
    constexpr float S[16] = {0.f, 0.19509032202f, 0.38268343237f, 0.55557023302f, 0.70710678119f, 0.83146961230f, 0.92387953251f, 0.98078528040f,
                             1.f, 0.98078528040f, 0.92387953251f, 0.83146961230f, 0.70710678119f, 0.55557023302f, 0.38268343237f, 0.19509032202f};
    f32x2 e[16], o[16];
#pragma unroll
    for (int k = 0; k < 16; ++k) { e[k] = x[2 * k]; o[k] = x[2 * k + 1]; }
    __builtin_amdgcn_sched_barrier(0); dft16<INV>(e); __builtin_amdgcn_sched_barrier(0); dft16<INV>(o); __builtin_amdgcn_sched_barrier(0);
#pragma unroll
    for (int k = 0; k < 16; ++k) { const f32x2 t = cmul(o[k], (f32x2){C[k], INV ? S[k] : -S[k]}); x[k] = e[k] + t; x[k + 16] = e[k] - t; }
}
template <class Ld, class Mk> __device__ __forceinline__ void fft_fwdA(f32x2* Z, int tid, Ld ld, Mk mk) {
    __syncthreads();
    asm volatile("" : "+v"(tid));
    f32x2 x[32];
#pragma unroll
    for (int h = 0; h < 2; ++h) { HyRaw raw[16];
#pragma unroll
      for (int i = 0; i < 16; ++i) raw[i] = ld((16 * h + i) * 512 + tid);
#pragma unroll
      for (int i = 0; i < 16; ++i) x[16 * h + i] = mk((16 * h + i) * 512 + tid, raw[i]);
      __builtin_amdgcn_sched_barrier(0); }
    dft32<false>(x);
    const f32x2 w1 = twf(2 * tid); f32x2 wk = w1;
    Z[zpad(tid)] = x[0];
#pragma unroll
    for (int k = 1; k < 32; ++k) { Z[zpad(k * 512 + tid)] = cmul(x[k], wk); wk = cmul(wk, w1); }
    __syncthreads();
}
__device__ __forceinline__ void fft_fwdB(f32x2* Z, int tid) {
    asm volatile("" : "+v"(tid));
    const int blk = tid >> 4, n2 = tid & 15, base = blk * 512 + n2;
    const f32x2 w1 = twf(64 * n2);
    f32x2 x[32];
#pragma unroll
    for (int n1 = 0; n1 < 32; ++n1) x[n1] = Z[zpad(base + n1 * 16)];
    dft32<false>(x);
    f32x2 wk = w1;
    Z[zpad(base)] = x[0];
#pragma unroll
    for (int k = 1; k < 32; ++k) { Z[zpad(base + k * 16)] = cmul(x[k], wk); wk = cmul(wk, w1); }
    __syncthreads();
}
__device__ __forceinline__ void fft_invB(f32x2* Z, int tid) {
    asm volatile("" : "+v"(tid));
    const int blk = tid >> 4, n2 = tid & 15, base = blk * 512 + n2;
    const f32x2 w1 = cconj(twf(64 * n2)); f32x2 wk = w1;
    f32x2 x[32];
    x[0] = Z[zpad(base)];
#pragma unroll
    for (int k = 1; k < 32; ++k) { x[k] = cmul(Z[zpad(base + k * 16)], wk); wk = cmul(wk, w1); }
    dft32<true>(x);
#pragma unroll
    for (int n1 = 0; n1 < 32; ++n1) Z[zpad(base + n1 * 16)] = x[n1];
    __syncthreads();
}
__device__ __forceinline__ unsigned cpk(const f32x2 v) { return pg8::cvt_pk_bf16(v.x, v.y); }
__device__ __forceinline__ f32x2 cunpk(unsigned w) { return (f32x2){bflo(w), bfhi(w)}; }
__device__ __forceinline__ void fft_fwd_rest_to_stash(f32x2* Z, int tid, unsigned (&g)[32]) {
    fft_fwdB(Z, tid);
    asm volatile("" : "+v"(tid));
#pragma unroll
    for (int j = 0; j < 2; ++j) { const int q = tid + 512 * j; f32x2 x[16];
#pragma unroll
        for (int n1 = 0; n1 < 16; ++n1) x[n1] = Z[18 * q + n1];
        dft16<false>(x);
#pragma unroll
        for (int k = 0; k < 16; ++k) g[j * 16 + k] = cpk(x[k]);
        __builtin_amdgcn_sched_barrier(0); }
}
template <class Ld, class Out> __device__ __forceinline__ void fft_conv_rest(f32x2* Z, int tid, const unsigned (&g)[32], Ld ld, Out out) {
    fft_fwdB(Z, tid);
    asm volatile("" : "+v"(tid));
#pragma unroll
    for (int j = 0; j < 2; ++j) { const int q = tid + 512 * j; f32x2 x[16];
#pragma unroll
        for (int n1 = 0; n1 < 16; ++n1) x[n1] = Z[18 * q + n1];
        dft16<false>(x);
#pragma unroll
        for (int k = 0; k < 16; ++k) x[k] = cmul(x[k], cunpk(g[j * 16 + k]));
        dft16<true>(x);
#pragma unroll
        for (int n1 = 0; n1 < 16; ++n1) Z[18 * q + n1] = x[n1];
        __builtin_amdgcn_sched_barrier(0); }
    __syncthreads();
    fft_invB(Z, tid);
    asm volatile("" : "+v"(tid));
    { const f32x2 w1 = cconj(twf(2 * tid)); f32x2 wk = w1; f32x2 x[32];
      x[0] = Z[zpad(tid)];
#pragma unroll
      for (int k = 1; k < 32; ++k) { x[k] = cmul(Z[zpad(k * 512 + tid)], wk); wk = cmul(wk, w1); }
      dft32<true>(x);
#pragma unroll
      for (int h = 0; h < 4; ++h) { HyRaw raw[8];
#pragma unroll
          for (int i = 0; i < 8; ++i) raw[i] = ld((8 * h + i) * 512 + tid);
#pragma unroll
          for (int i = 0; i < 8; ++i) out(8 * h + i, (8 * h + i) * 512 + tid, x[8 * h + i], raw[i]);
          __builtin_amdgcn_sched_barrier(0); } }
}

template <int O> __device__ __forceinline__ void hy_order(const Params& p, int l, int c, f32x2* Z, float* red, const f32x2* tw, int tid, const bf16_t* Ht, bf16_t* hv, const bf16_t* gate, unsigned* zs) {
    unsigned gs[32];
    const float delta = hy_delta(c);
    const size_t cb0 = ((size_t)(0 * D + c)) * SEQ, cb1 = ((size_t)(1 * D + c)) * SEQ;
    const bf16_t* fw = Ht + ((size_t)((O * 2 + 0) * D + c)) * SEQ; const bf16_t* bw = Ht + ((size_t)((O * 2 + 1) * D + c)) * SEQ;
    float ssq = 0.f;
    auto ld_filt = [=](int n) { HyRaw r{}; const int nb = n == 0 ? 0 : SEQ - n; r.s0 = fw[n]; r.s1 = bw[nb]; return r; };

    auto ld_z = [=](int n) { HyRaw r{}; if (O == 0) { r.s0 = hv[cb0 + n]; r.s1 = hv[cb1 + n]; } else r.w = zs[n]; return r; };

    auto zval = [=](const HyRaw& r) { return O == 0 ? (f32x2){bf2f(r.s0), bf2f(r.s1)} : cunpk(r.w); };
    fft_fwdA(Z, tid, ld_filt, [&](int n, const HyRaw& r) { const int nb = n == 0 ? 0 : SEQ - n;
        const float f = bf2f(r.s0) * __expf(-((float)n * (1.0f / (SEQ - 1))) * delta), g = bf2f(r.s1) * __expf(-((float)nb * (1.0f / (SEQ - 1))) * delta);
        ssq += f * f + g * g; return (f32x2){f + g, 0.f}; });
    fft_fwd_rest_to_stash(Z, tid, gs);
    ssq = wave_sum(ssq); if ((tid & 63) == 0) red[tid >> 6] = ssq;
    fft_fwdA(Z, tid, ld_z, [=](int, const HyRaw& r) { return zval(r); });
    float tot = 0.f;
#pragma unroll
    for (int w = 0; w < 8; ++w) tot += red[w];
    const float scale = 0.5f * (1.0f / SEQ) * rsqrtf(tot);
    unsigned rsv[32];
    fft_conv_rest(Z, tid, gs, [=](int) { return HyRaw{}; }, [&](int i, int, f32x2 val, const HyRaw&) { rsv[i] = cpk(val * scale); });
    fft_fwdA(Z, tid, ld_filt, [=](int n, const HyRaw& r) { const int nb = n == 0 ? 0 : SEQ - n;
        const float f = bf2f(r.s0) * __expf(-((float)n * (1.0f / (SEQ - 1))) * delta), g = bf2f(r.s1) * __expf(-((float)nb * (1.0f / (SEQ - 1))) * delta);
        const float gd = n == 0 ? f + g : f - g; const f32x2 w = twf(n); return (f32x2){gd * w.x, gd * w.y}; });
    fft_fwd_rest_to_stash(Z, tid, gs);
    fft_fwdA(Z, tid, ld_z, [=](int n, const HyRaw& r) { return cmul(zval(r), twf(n)); });
    const float sk = inp(p, I_HSKIP)[(l * 2 + O) * D + c];
    fft_conv_rest(Z, tid, gs,
        [=](int n) { HyRaw r{}; if (O == 0) { r.s0 = hv[cb0 + n]; r.s1 = hv[cb1 + n]; } else r.w = zs[n]; r.s2 = gate[cb0 + n]; r.s3 = gate[cb1 + n]; return r; },
        [&](int i, int n, f32x2 val, const HyRaw& r) {
            const f32x2 cv = cunpk(rsv[i]) + cmul(val, cconj(twf(n))) * scale;
            const f32x2 zz = zval(r);
            const f32x2 res = (f32x2){bf2f(r.s2) * (cv.x + zz.x * sk), bf2f(r.s3) * (cv.y + zz.y * sk)};
            if (O == 0) zs[n] = cpk(res); else { hv[cb0 + n] = f2bf(res.x); hv[cb1 + n] = f2bf(res.y); } });
}

__device__ __forceinline__ void ph_hyena(const Params& p, int l, unsigned char* lds_raw) {
    f32x2* Z = (f32x2*)lds_raw; float* red = (float*)(lds_raw + (size_t)ZN * 8);
    const f32x2* tw = (const f32x2*)(p.ws + WS_TW);
    const int tid = p.tid;
    const bf16_t* Ht = (const bf16_t*)slot(p, 3);
    bf16_t* hv = slot(p, 0); const bf16_t* hx1 = slot(p, 1); const bf16_t* hx2 = slot(p, 2);
    unsigned* zs = (unsigned*)slot(p, 5) + (size_t)p.bid * SEQ;
#pragma unroll 1
    for (int c = p.bid; c < D; c += p.nblk) {
        hy_order<0>(p, l, c, Z, red, tw, tid, Ht, hv, hx1, zs);
        hy_order<1>(p, l, c, Z, red, tw, tid, Ht, hv, hx2, zs);
    }
}

constexpr float PEER_USCALE = 128.0f, PEER_VSCALE = 8.0f;
__device__ __forceinline__ void ph_prep2(const Params& p, int l, int M) {
    norm_rows(p, inp(p, I_N2G) + l * D, l, 3, 4, M);
}

__constant__ unsigned char c_cand[50] = {
    0x00,0x01,0x02,0x03,0x04,0x05,0x06,0x07,0x08,0x09,0x0A,0x0B,0x0C,0x0D,0x0E,0x0F, 0x10,0x11,0x12,0x13,0x14,0x15,0x16,0x17, 0x20,0x21,0x22,0x23,0x24, 0x30,0x31,0x32,0x33,
    0x40,0x41,0x42, 0x50,0x51, 0x60,0x61, 0x70,0x71, 0x80,0x90,0xA0,0xB0,0xC0,0xD0,0xE0,0xF0};
__device__ __forceinline__ unsigned fkey(float x) { const unsigned u = __float_as_uint(x); return (u & 0x80000000u) ? ~u : (u | 0x80000000u); }
__device__ __forceinline__ int mbcnt64(unsigned long long m) { return (int)__builtin_amdgcn_mbcnt_hi((unsigned)(m >> 32), __builtin_amdgcn_mbcnt_lo((unsigned)m, 0u)); }
__device__ __forceinline__ void ph_topk(const Params& p, int M, unsigned char* lds_raw) {
    constexpr int U = 2;
    const int lane = p.tid & 63, wid = p.tid >> 6, wv = p.bid * 8 + wid, NW = p.nblk * 8, total = M * 8;
    const float* sc = (const float*)slot(p, 3); int* idx = (int*)slot(p, 2); float* gate = (float*)slot(p, 2) + (size_t)MR * 128;
    const int cand_ab = lane < 50 ? (int)c_cand[lane] : 0;
    float fn[U][4];
#pragma unroll
    for (int u = 0; u < U; ++u) { int it0 = wv + u * NW; it0 = it0 < total ? it0 : wv; if (wv < total) { const float* s = sc + (size_t)(it0 >> 3) * D + (it0 & 7) * 256;
#pragma unroll
        for (int j = 0; j < 4; ++j) fn[u][j] = s[lane + 64 * j]; } }
    for (int it = wv; it < total; it += U * NW) {
        int itu[U]; float f[U][4]; unsigned k[U][4];
#pragma unroll
        for (int u = 0; u < U; ++u) { itu[u] = it + u * NW < total ? it + u * NW : it;
#pragma unroll
            for (int j = 0; j < 4; ++j) { f[u][j] = fn[u][j]; k[u][j] = fkey(f[u][j]); } }
#pragma unroll
        for (int u = 0; u < U; ++u) { int itn = itu[u] + U * NW; itn = itn < total ? itn : itu[u]; const float* s = sc + (size_t)(itn >> 3) * D + (itn & 7) * 256;
#pragma unroll
            for (int j = 0; j < 4; ++j) fn[u][j] = s[lane + 64 * j]; }
        unsigned th[U][2];
#pragma unroll
        for (int u = 0; u < U; ++u) { th[u][0] = 0u; th[u][1] = 0u; }
#pragma unroll
        for (int bit = 31; bit >= 16; --bit)
#pragma unroll
            for (int u = 0; u < U; ++u)
#pragma unroll
                for (int pp = 0; pp < 2; ++pp) { const unsigned c = th[u][pp] | (1u << bit);
                    const int n = __popcll(__ballot(k[u][2 * pp] >= c)) + __popcll(__ballot(k[u][2 * pp + 1] >= c)); th[u][pp] = n >= 16 ? c : th[u][pp]; }
#pragma unroll
        for (int u = 0; u < U; ++u)
#pragma unroll
            for (int pp = 0; pp < 2; ++pp) {
                const bool more = __popcll(__ballot(k[u][2 * pp] >= th[u][pp])) + __popcll(__ballot(k[u][2 * pp + 1] >= th[u][pp])) != 16;
                if (more) { unsigned t = th[u][pp];
#pragma unroll
                    for (int bit = 15; bit >= 0; --bit) { const unsigned c = t | (1u << bit);
                        const int n = __popcll(__ballot(k[u][2 * pp] >= c)) + __popcll(__ballot(k[u][2 * pp + 1] >= c)); t = n >= 16 ? c : t; }
                    th[u][pp] = t; } }
        float cv[U]; unsigned key[U]; int ca[U], cb[U];
#pragma unroll
        for (int u = 0; u < U; ++u) {
            unsigned* L = (unsigned*)lds_raw + (wid * U + u) * 192;
            unsigned* ck = L; unsigned* cvl = L + 32; unsigned* ci = L + 64; float* topv = (float*)(L + 96); int* topi = (int*)(L + 128);
#pragma unroll
            for (int pp = 0; pp < 2; ++pp) { const unsigned t = th[u][pp], ka = k[u][2 * pp], kb = k[u][2 * pp + 1];
                const unsigned long long ga = __ballot(ka > t), gb = __ballot(kb > t), ea = __ballot(ka == t), eb = __ballot(kb == t);
                const int need = 16 - __popcll(ga) - __popcll(gb);
                const bool sa = (ka > t) || (ka == t && mbcnt64(ea) < need), sb = (kb > t) || (kb == t && __popcll(ea) + mbcnt64(eb) < need);
                const unsigned long long ma = __ballot(sa), mb = __ballot(sb);
                const int pa = mbcnt64(ma), pb = __popcll(ma) + mbcnt64(mb);
                if (sa) { ck[pp * 16 + pa] = ka; cvl[pp * 16 + pa] = __float_as_uint(f[u][2 * pp]); ci[pp * 16 + pa] = (unsigned)lane; }
                if (sb) { ck[pp * 16 + pb] = kb; cvl[pp * 16 + pb] = __float_as_uint(f[u][2 * pp + 1]); ci[pp * 16 + pb] = (unsigned)(lane + 64); } }
            if (lane < 32) { const int pp = lane >> 4, me = lane & 15; const unsigned my = ck[lane]; int rk = 0;
#pragma unroll
                for (int j = 0; j < 16; ++j) { const unsigned o = ck[pp * 16 + j]; rk += (o > my || (o == my && j < me)) ? 1 : 0; }
                topv[pp * 16 + rk] = __uint_as_float(cvl[lane]); topi[pp * 16 + rk] = (int)ci[lane]; }
            cv[u] = 0.f; key[u] = 0u; ca[u] = 0; cb[u] = 0;
            if (lane < 50) { const int ab = cand_ab; ca[u] = ab >> 4; cb[u] = ab & 15; cv[u] = topv[ca[u]] + topv[16 + cb[u]]; key[u] = fkey(cv[u]); }
        }
        unsigned tc[U];
#pragma unroll
        for (int u = 0; u < U; ++u) tc[u] = 0u;
#pragma unroll
        for (int bit = 31; bit >= 14; --bit)
#pragma unroll
            for (int u = 0; u < U; ++u) { const unsigned c = tc[u] | (1u << bit); tc[u] = __popcll(__ballot(key[u] >= c)) >= 16 ? c : tc[u]; }
#pragma unroll
        for (int u = 0; u < U; ++u) {
            const bool more2 = __popcll(__ballot(key[u] >= tc[u])) != 16;
            if (more2) { unsigned t = tc[u];
#pragma unroll
                for (int bit = 13; bit >= 0; --bit) { const unsigned c = t | (1u << bit); t = __popcll(__ballot(key[u] >= c)) >= 16 ? c : t; }
                tc[u] = t; } }
#pragma unroll
        for (int u = 0; u < U; ++u) {
            const int* topi = (const int*)((unsigned*)lds_raw + (wid * U + u) * 192 + 128);
            const int row = itu[u] >> 3, h = itu[u] & 7; const unsigned t = tc[u];
            const unsigned long long g = __ballot(key[u] > t), e_ = __ballot(key[u] == t);
            const int need = 16 - __popcll(g);
            const bool win = (key[u] > t) || (key[u] == t && mbcnt64(e_) < need);
            const unsigned long long wm = __ballot(win);
            const float v16 = rdlane(cv[u], __builtin_amdgcn_readfirstlane(__ffsll(e_) - 1));
            const float ex = win ? __expf(cv[u] - v16) : 0.f;
            const float den = wave_sum(ex);
            if (win) { const int sl = mbcnt64(wm); idx[(size_t)row * 128 + h * 16 + sl] = topi[ca[u]] * 128 + topi[16 + cb[u]]; gate[(size_t)row * 128 + h * 16 + sl] = ex / den; }
        }
    }
}

__device__ __forceinline__ float gelu_exact(float v) {
    const float av = fabsf(v), t = __builtin_amdgcn_rcpf(av * 0.2316418882f + 1.0f);
    float q = t * 0.5307027145f + (-0.7265760135f); q = q * t + 0.7107068705f; q = q * t + (-0.142248368f); q = q * t + 0.127414796f; q = q * t;
    const float e = __builtin_amdgcn_exp2f((v * v) * (-0.72134752044f));
    const float m = v * (q * e);
    return v < 0.f ? m : v - m;
}
__device__ __forceinline__ void ph_expert(const Params& p, int l, int M) {
    const int lane = p.tid & 63, wv = p.bid * 8 + (p.tid >> 6), NW = p.nblk * 8;
    const unsigned char* U = (const unsigned char*)(p.ws + WS_PEER8); const unsigned char* V = U + (size_t)NEXP * D; const bf16_t* hb = (const bf16_t*)(p.ws + WS_H);
    const int* idx = (const int*)slot(p, 2); const float* gate = (const float*)slot(p, 2) + (size_t)MR * 128;
    for (int row = wv; row < M; row += NW) {
        float x[32], acc[32];
#pragma unroll
        for (int c = 0; c < 2; ++c)
#pragma unroll
            for (int q = 0; q < 2; ++q) { const u32x4 w = *(const u32x4*)(hb + (size_t)row * D + c * 1024 + lane * 16 + q * 8);
#pragma unroll
                for (int e = 0; e < 4; ++e) { x[c * 16 + q * 8 + 2 * e] = bflo(w[e]); x[c * 16 + q * 8 + 2 * e + 1] = bfhi(w[e]); } }
#pragma unroll
        for (int i = 0; i < 32; ++i) acc[i] = 0.f;
        const int id0 = idx[(size_t)row * 128 + lane], id1 = idx[(size_t)row * 128 + 64 + lane];
        const float g0 = gate[(size_t)row * 128 + lane], g1 = gate[(size_t)row * 128 + 64 + lane];
#pragma unroll 4
        for (int e = 0; e < 128; ++e) {
            const int id = __builtin_amdgcn_readlane(e < 64 ? id0 : id1, e & 63);
            const float g = __builtin_bit_cast(float, __builtin_amdgcn_readlane(__builtin_bit_cast(int, e < 64 ? g0 : g1), e & 63));
            const unsigned char* ur = U + (size_t)id * D + lane * 16; const unsigned char* vr = V + (size_t)id * D + lane * 16;
            u32x4 uw[2], vw[2];
#pragma unroll
            for (int c = 0; c < 2; ++c) { uw[c] = *(const u32x4*)(ur + c * 1024); vw[c] = *(const u32x4*)(vr + c * 1024); }
            float d = 0.f;
#pragma unroll
            for (int c = 0; c < 2; ++c)
#pragma unroll
                for (int q = 0; q < 4; ++q) { const f32x2 lo = __builtin_amdgcn_cvt_pk_f32_fp8((int)uw[c][q], false), hi = __builtin_amdgcn_cvt_pk_f32_fp8((int)uw[c][q], true);
                    d += lo.x * x[c * 16 + 4 * q] + lo.y * x[c * 16 + 4 * q + 1] + hi.x * x[c * 16 + 4 * q + 2] + hi.y * x[c * 16 + 4 * q + 3]; }
            d = wave_sum(d) * (1.0f / PEER_USCALE);
            const float a = g * gelu_exact(d) * (1.0f / PEER_VSCALE);
#pragma unroll
            for (int c = 0; c < 2; ++c)
#pragma unroll
                for (int q = 0; q < 4; ++q) { const f32x2 lo = __builtin_amdgcn_cvt_pk_f32_fp8((int)vw[c][q], false), hi = __builtin_amdgcn_cvt_pk_f32_fp8((int)vw[c][q], true);
                    acc[c * 16 + 4 * q] += a * lo.x; acc[c * 16 + 4 * q + 1] += a * lo.y; acc[c * 16 + 4 * q + 2] += a * hi.x; acc[c * 16 + 4 * q + 3] += a * hi.y; }
        }
        float* xr = xrow(p, row); const int mr = mrow_of(row); const float* ga = modp(p, l, mr, 5);
        f32x4 xv[8], gv[8];
#pragma unroll
        for (int c = 0; c < 2; ++c)
#pragma unroll
            for (int q = 0; q < 4; ++q) { const int col = c * 1024 + lane * 16 + 4 * q; xv[c * 4 + q] = *(const f32x4*)(xr + col); gv[c * 4 + q] = *(const f32x4*)(ga + col); }
        float ss = 0.f;
#pragma unroll
        for (int i = 0; i < 8; ++i) { xv[i] = xv[i] + gv[i] * (f32x4){acc[4 * i], acc[4 * i + 1], acc[4 * i + 2], acc[4 * i + 3]}; ss += xv[i][0] * xv[i][0] + xv[i][1] * xv[i][1] + xv[i][2] * xv[i][2] + xv[i][3] * xv[i][3]; }
        ss = wave_sum(ss);
        const float rs = rsqrtf(ss * (1.0f / D) + NORM_EPS);
        if (l == 1) {
            const float* fg = inp(p, I_FING);
#pragma unroll
            for (int c = 0; c < 2; ++c)
#pragma unroll
                for (int q = 0; q < 4; ++q) { const int col = c * 1024 + lane * 16 + 4 * q; *(f32x4*)(xr + col) = (xv[c * 4 + q] * rs) * *(const f32x4*)(fg + col); }
        } else {
            const float* g1 = inp(p, I_N1G) + (l + 1) * D; const float* sh = modp(p, l + 1, mr, 0); const float* sc = modp(p, l + 1, mr, 1);
            bf16_t* hrow = (bf16_t*)(p.ws + WS_H) + (size_t)row * D;
#pragma unroll
            for (int c = 0; c < 2; ++c) { unsigned w[8];
#pragma unroll
                for (int q = 0; q < 4; ++q) { const int col = c * 1024 + lane * 16 + 4 * q; *(f32x4*)(xr + col) = xv[c * 4 + q];
                    const f32x4 y = (xv[c * 4 + q] * rs) * *(const f32x4*)(g1 + col) * (*(const f32x4*)(sc + col) + 1.0f) + *(const f32x4*)(sh + col);
                    w[2 * q] = pack2(y[0], y[1]); w[2 * q + 1] = pack2(y[2], y[3]); }
                u32x4* d = (u32x4*)(hrow + c * 1024 + lane * 16); d[0] = (u32x4){w[0], w[1], w[2], w[3]}; d[1] = (u32x4){w[4], w[5], w[6], w[7]}; }
        }
    }
}

__device__ __forceinline__ void ph_final(const Params& p) {
    const int lane = p.tid & 63, wv = p.bid * 8 + (p.tid >> 6), NW = p.nblk * 8;
    const float* g = inp(p, I_FING);
    for (int r = wv; r < TL; r += NW) {
        float* xr = p.out + (size_t)r * D; f32x4 v[8]; float ss = 0.f;
#pragma unroll
        for (int c = 0; c < 8; ++c) { v[c] = *(const f32x4*)(xr + c * 256 + lane * 4); ss += v[c][0] * v[c][0] + v[c][1] * v[c][1] + v[c][2] * v[c][2] + v[c][3] * v[c][3]; }
        ss = wave_sum(ss); const float rs = rsqrtf(ss * (1.0f / D) + NORM_EPS);
#pragma unroll
        for (int c = 0; c < 8; ++c) { const int col = c * 256 + lane * 4; *(f32x4*)(xr + col) = (v[c] * rs) * *(const f32x4*)(g + col); }
    }
}

__global__ void __launch_bounds__(NTHREADS, 2) mega(KArgs a) {
    extern __shared__ __attribute__((aligned(16))) unsigned char shm[];
    volatile LAS unsigned* st = (volatile LAS unsigned*)(shm + LDS_BYTES - 16);
    if (threadIdx.x == 0) { st[0] = 0u; st[1] = 0u; st[2] = 0u; st[3] = 0u; }
    __syncthreads();
    unsigned char* const k_ws = a.ws; float* const k_out = a.out; const int k_wid = __builtin_amdgcn_readfirstlane(threadIdx.x >> 6), k_bid = blockIdx.x, k_nblk = gridDim.x;
#define CTX(q) Params q; { GAS unsigned char* w_ = (GAS unsigned char*)k_ws; GAS float* o_ = (GAS float*)k_out;     int b_ = k_bid, n_ = k_nblk, wv_ = k_wid; unsigned m_ = 0xFFFFFFFFu; asm volatile("; PHP_MARK" : "+s"(w_), "+s"(o_), "+s"(wv_), "+s"(b_), "+s"(n_), "+s"(m_)); int t_ = wv_ * 64 + (int)__builtin_amdgcn_mbcnt_hi(m_, __builtin_amdgcn_mbcnt_lo(m_, 0u)); q.ws = (unsigned char*)w_; q.out = (float*)o_; q.tid = t_; q.bid = b_; q.nblk = n_; }
#define GBAR() do { unsigned char* w_ = k_ws; asm volatile("" : "+s"(w_)); XcdBarrier b_; b_.bar = (unsigned*)(w_ + WS_BAR); b_.x = xb_xcc_id(); b_.st = st; xcd_barrier(b_); } while (0)
    (void)xcd_barrier_post((unsigned*)(k_ws + WS_BAR), st);
    { unsigned char* ws = k_ws;
    if (blockIdx.x == 0 && threadIdx.x == 0) { const float** tab = (const float**)(ws + WS_PTRS);
#pragma unroll
        for (int i = 0; i < 33; ++i) tab[i] = a.in[i]; } }
    { CTX(q); ph_init(q, a.in[I_X], a.in[I_CTX], a.in[I_C], a.in[I_CCTX], a.in[I_ADAW]); }
    GBAR();
    { CTX(q); ph_modred(q); }
    GBAR();
    { CTX(q); ph_prepA(q, 0); norm_rows(q, inp(q, I_N1G), 0, 0, 1, MR, inp(q, I_X), inp(q, I_CTX)); } GBAR();
#pragma unroll 1
    for (int l = 0; l < 2; ++l) {
        const bool last = (l == 1);
        const int ML = last ? TL : MR;
        { CTX(q); unsigned char* ws = q.ws; EpiConv<0> E{(const float*)(ws + WS_CONVW), (bf16_t*)(ws + WS_PCTX), slot(q, 0), (bf16_t*)(ws + WS_LORAIN)};
          run_gemm(q, shm, (const bf16_t*)(ws + WS_H), D, (const bf16_t*)(ws + WS_WTIN), D, MR, NR, D, E); } GBAR();
        { CTX(q); ph_ctxconv<0>(q); } GBAR();
        { CTX(q); unsigned char* ws = q.ws;
          { EpiLora E{(const float*)(ws + WS_LBIAS), 0, slot(q, 3)};
            run_gemm(q, shm, (const bf16_t*)(ws + WS_LORAIN), LORA_W, (const bf16_t*)(ws + WS_WTLORA), LORA_W, MR, 2 * D, 256, E); }
          { EpiLora E{(const float*)(ws + WS_LBIAS), 2, slot(q, 3)}; Params q2 = q; q2.bid = (q.bid + 32) % q.nblk;
            run_gemm(q2, shm, (const bf16_t*)(ws + WS_LORAIN) + 256, LORA_W, (const bf16_t*)(ws + WS_WTLORA) + (size_t)2 * D * LORA_W + 256, LORA_W, MR, 2 * D, 256, E); } } GBAR();
        { CTX(q); constexpr int NU = NB * NHEAD * 2;
          if (q.bid < NU) ph_scan3(q, l, shm); else { Params g = q; g.bid = q.bid - NU; g.nblk = q.nblk - NU; ph_prepB(g, l); ph_prep_bg(g, l); if (!last) ph_prepA(g, l + 1); } } GBAR();
        { CTX(q); ph_rwkv_out(q, l, ML, shm); } GBAR();
        { CTX(q); unsigned char* ws = q.ws; EpiConv<1> E{(const float*)(ws + WS_CONVW) + NR, (bf16_t*)(ws + WS_PCTX), slot(q, 0), nullptr};
          run_gemm(q, shm, (const bf16_t*)(ws + WS_H), D, (const bf16_t*)(ws + WS_WTIN) + (size_t)NR * D, D, ML, NHY, D, E); }
        { CTX(q); unsigned char* ws = q.ws; EpiBf E{slot(q, 3), SEQ};
          run_gemm(q, shm, (const bf16_t*)(ws + WS_W3T), 256, (const bf16_t*)(ws + WS_HDN), 256, 8192, SEQ, 256, E); } GBAR();
        if (!last) { { CTX(q); ph_ctxconv<1>(q); } { CTX(q); ph_ctxfilter(q, l); } GBAR(); { CTX(q); ph_ctxhyena(q, l, shm); } }
        { CTX(q); ph_hyena(q, l, shm); } GBAR();
        { CTX(q); unsigned char* ws = q.ws; EpiGate E{slot(q, 6), slot(q, 0), (const float*)(ws + WS_YHC), slot(q, 5)};
          run_gemm(q, shm, (const bf16_t*)(ws + WS_H), D, (const bf16_t*)(ws + WS_WTIN) + (size_t)(NR + NHY) * D, D, ML, NG, D, E); } GBAR();
        { CTX(q); unsigned char* ws = q.ws; EpiResid E{q.out, (float*)(ws + WS_CTXRES), (const float*)(ws + WS_MOD) + (size_t)(l * 18 + 2) * D, l == 0 ? inp(q, I_X) : (const float*)q.out, l == 0 ? inp(q, I_CTX) : (const float*)(ws + WS_CTXRES)};
          run_gemm(q, shm, slot(q, 5), D, (const bf16_t*)(ws + WS_WTOUT), D, ML, D, D, E); } GBAR();
        { CTX(q); ph_prep2(q, l, ML); } GBAR();
        { CTX(q); unsigned char* ws = q.ws; EpiF32 E{(float*)slot(q, 3), D};
          run_gemm(q, shm, (const bf16_t*)(ws + WS_H), D, (const bf16_t*)(ws + WS_WTSC), D, ML, D, D, E); } GBAR();
        { CTX(q); ph_topk(q, ML, shm); } GBAR();
        { CTX(q); ph_expert(q, l, ML); } GBAR();
    }
}

extern "C" void kernel_launch(void* const* d_in, const int* in_sizes, int n_in, void* d_out, int out_size, void* d_ws, size_t ws_size, hipStream_t stream) {
    static int grid = 0;
    if (grid == 0) {
        if (n_in != 33 || out_size != TL * D || ws_size < WS_END) { fprintf(stderr, "kernel_launch: unexpected shapes / workspace (%d inputs, out %d, ws %zu < %zu)\n", n_in, out_size, ws_size, (size_t)WS_END); grid = -1; return; }
        int dev = 0, cus = 0;
        if (hipGetDevice(&dev) != hipSuccess || hipDeviceGetAttribute(&cus, hipDeviceAttributeMultiprocessorCount, dev) != hipSuccess) { grid = -1; return; }
        if (hipFuncSetAttribute((const void*)mega, hipFuncAttributeMaxDynamicSharedMemorySize, LDS_BYTES) != hipSuccess) { fprintf(stderr, "kernel_launch: hipFuncSetAttribute failed\n"); grid = -1; return; }
        int per_cu = 0;
        if (hipOccupancyMaxActiveBlocksPerMultiprocessor(&per_cu, (const void*)mega, NTHREADS, LDS_BYTES) != hipSuccess || per_cu < 1) { fprintf(stderr, "kernel_launch: occupancy query says %d\n", per_cu); (void)hipGetLastError(); }
        grid = cus;
        if (grid <= NB * NHEAD * 2) { fprintf(stderr, "kernel_launch: needs more than %d compute units\n", NB * NHEAD * 2); grid = -1; return; }
    }
    if (grid < 0) return;
    (void)hipMemsetAsync((char*)d_ws + WS_BAR, 0, XCD_BAR_WORDS * sizeof(unsigned), stream);
    KArgs a{};
    for (int i = 0; i < 33; ++i) a.in[i] = (const float*)d_in[i];
    a.out = (float*)d_out; a.ws = (unsigned char*)d_ws;
    hipLaunchKernelGGL(mega, dim3(grid), dim3(NTHREADS), LDS_BYTES, stream, a);
}
```

```cpp
#include <hip/hip_runtime.h>
#include <cstdio>
#include <cstdint>

typedef unsigned short bf16_t;
typedef float f32x4 __attribute__((ext_vector_type(4)));
typedef float f32x2 __attribute__((ext_vector_type(2)));
typedef unsigned u32x4 __attribute__((ext_vector_type(4)));
typedef unsigned u32x2 __attribute__((ext_vector_type(2)));
#define LAS __attribute__((address_space(3)))

#define XB_TMO      128
#define XB_XCNT(j)  (256  + 64 * (j))
#define XB_XSUB(j)  (1280 + 64 * (j))
#define XB_XGEN(j)  (2304 + 64 * (j))
#define XB_TOP      3328
#define XB_TOPGEN   3392
#define XCD_BAR_WORDS 3456
#define XB_SPIN_CAP (1u << 22)

__device__ __forceinline__ unsigned xb_ld(unsigned* p)              { return __hip_atomic_load(p, __ATOMIC_RELAXED, __HIP_MEMORY_SCOPE_AGENT); }
__device__ __forceinline__ unsigned xb_add(unsigned* p, unsigned v) { return __hip_atomic_fetch_add(p, v, __ATOMIC_RELAXED, __HIP_MEMORY_SCOPE_AGENT); }
__device__ __forceinline__ unsigned xb_xcc_id() { return (unsigned)__builtin_amdgcn_s_getreg((3 << 11) | 20) & 0xFu; }
#define XB_SPIN(cond, bar) do { unsigned _sp = 0; while (cond) { __builtin_amdgcn_s_sleep(1); \
    if ((++_sp & 255u) == 0u) { if (xb_ld(&(bar)[XB_TMO])) break; if (_sp > XB_SPIN_CAP) { atomicAdd(&(bar)[XB_TMO], 1u); break; } } } } while (0)

struct XcdBarrier { unsigned* bar; unsigned x; volatile LAS unsigned* st; };

__device__ __forceinline__ XcdBarrier xcd_barrier_post(unsigned* bar, volatile LAS unsigned* st) {
    XcdBarrier b; b.bar = bar; b.x = xb_xcc_id(); b.st = st;
    if (threadIdx.x == 0) (void)xb_add(&bar[XB_XCNT(b.x)], 1u);
    return b;
}
__device__ __forceinline__ void xcd_barrier_complete(unsigned* bar, unsigned x, unsigned& nloc, unsigned& nx) {
    const unsigned G = gridDim.x * gridDim.y * gridDim.z;
    unsigned sum, cnt, mine, sp = 0u;
    for (;;) {
        sum = 0u; cnt = 0u; mine = 0u;
#pragma unroll
        for (unsigned j = 0; j < 16; ++j) { const unsigned c = xb_ld(&bar[XB_XCNT(j)]); sum += c; cnt += (c > 0u) ? 1u : 0u; mine = (j == x) ? c : mine; }
        if (sum == G) break;
        __builtin_amdgcn_s_sleep(1);
        if ((++sp & 255u) == 0u) { if (xb_ld(&bar[XB_TMO])) break; if (sp > XB_SPIN_CAP) { atomicAdd(&bar[XB_TMO], 1u); break; } }
    }
    nloc = mine > 0u ? mine : 1u; nx = cnt > 0u ? cnt : 1u;
}
__device__ __forceinline__ void xcd_barrier(const XcdBarrier& b) {
    asm volatile("s_waitcnt vmcnt(0)" ::: "memory");
    __syncthreads();
    if (threadIdx.x == 0) {
        unsigned* bar = b.bar;
        __builtin_amdgcn_s_waitcnt(0);
        unsigned nloc = b.st[0], nx = b.st[1];
        if (nloc == 0u) { xcd_barrier_complete(bar, b.x, nloc, nx); b.st[0] = nloc; b.st[1] = nx; }
        const unsigned old = xb_add(&bar[XB_XSUB(b.x)], 1u);
        const unsigned gen = old / nloc;
        if (old + 1u == (gen + 1u) * nloc) {
            __builtin_amdgcn_fence(__ATOMIC_RELEASE, "agent");
            asm volatile("s_waitcnt vmcnt(0)" ::: "memory");
            const unsigned og = xb_add(&bar[XB_TOP], 1u);
            const unsigned tg = og / nx;
            if (og + 1u == (tg + 1u) * nx) xb_add(&bar[XB_TOPGEN], 1u);
            else XB_SPIN(xb_ld(&bar[XB_TOPGEN]) == tg, bar);
            __builtin_amdgcn_fence(__ATOMIC_ACQUIRE, "agent");
            xb_add(&bar[XB_XGEN(b.x)], 1u);
            asm volatile("s_waitcnt vmcnt(0)" ::: "memory");
        } else {
            XB_SPIN(xb_ld(&bar[XB_XGEN(b.x)]) == gen, bar);
            __builtin_amdgcn_fence(__ATOMIC_ACQUIRE, "agent");
            asm volatile("s_waitcnt vmcnt(0)" ::: "memory");
        }
    }
    __syncthreads();
}

namespace pg8 {
#define PG8_LAS __attribute__((address_space(3)))
typedef unsigned short bf16_t;
typedef short bf16x8 __attribute__((ext_vector_type(8)));
typedef float f32x4 __attribute__((ext_vector_type(4)));
typedef unsigned u32x4 __attribute__((ext_vector_type(4)));
constexpr int BM = 256, BK = 64, HALF = 128, HTB = HALF * BK * 2  , STAGE_BYTES = 8 * HTB, NXCD = 8, WGM = 8;

__host__ __device__ __forceinline__ int lds_byte(int r, int c) { const int st = (r >> 4) * 2 + (c >> 5), rr = r & 15, cc = c & 31, ob = rr * 64 + cc * 2; return st * 1024 + (ob ^ (((ob >> 9) & 1) << 5)); }
__host__ __device__ __forceinline__ void stage_rc(int b, int& R, int& C) { const int st = b / 1024, sb = b % 1024, swz = sb ^ (((sb >> 9) & 1) << 5); R = (st >> 1) * 16 + swz / 64; C = (st & 1) * 32 + (swz % 64) / 2; }
__host__ __device__ __forceinline__ int perm32(int rho) { const int n = rho >> 4, i = rho & 15; return 8 * (i >> 2) + 4 * n + (i & 3); }

struct Unit { int pm, pn; };
struct Gemm { const bf16_t* A; const bf16_t* Bt; int M, N, K, lda, ldb; };

struct StaticOrder {
    int nM, nN, nwg, G, c;
    __host__ __device__ void init(int M, int N, int G_, int c_) { nM = M / BM; nN = N / BM; nwg = nM * nN; G = G_; c = c_; }
    __host__ __device__ bool next(int i, Unit& u) const {
        const long L = (long)i * G + c; if (L >= nwg) return false;
        int wgid = (int)L; { const int q = nwg / NXCD, r = nwg % NXCD, xcd = wgid % NXCD, off = wgid / NXCD; wgid = (xcd < r ? xcd * (q + 1) : r * (q + 1) + (xcd - r) * q) + off; }
        const int nig = WGM * nN, gid = wgid / nig, fm = gid * WGM, gsz = (nM - fm) < WGM ? (nM - fm) : WGM;
        u.pm = fm + ((wgid % nig) % gsz); u.pn = (wgid % nig) / gsz; return true;
    }
    __device__ __forceinline__ void a_ready(const Unit&) const {}
    __device__ __forceinline__ void done(const Unit&) const {}
};
typedef float f32x2c __attribute__((ext_vector_type(2))); typedef __bf16 bf16x2c __attribute__((ext_vector_type(2)));
__device__ __forceinline__ unsigned cvt_pk_bf16(float lo, float hi) { const f32x2c v = {lo, hi}; return __builtin_bit_cast(unsigned, __builtin_convertvector(v, bf16x2c)); }
typedef float f32x2 __attribute__((ext_vector_type(2)));
template <class Epi, class Sched>
__device__ __forceinline__ void gemm_phase(PG8_LAS unsigned char* lds, const Gemm g, const Sched& S, const Epi& E, const int tid) {
    const int wid = __builtin_amdgcn_readfirstlane(tid >> 6), lane = tid & 63, wr = wid >> 2, wc = wid & 3, fr = lane & 15, fq = lane >> 4;
    const int K = g.K, nt = K / BK;
    unsigned voffA[2], voffB[2];
#pragma unroll
    for (int i = 0; i < 2; ++i) { int R, C; stage_rc(tid * 16 + i * 8192, R, C); const int Rb = Epi::PERM ? ((R & ~31) + perm32(R & 31)) : R;
        voffA[i] = (unsigned)(R * g.lda + C) * 2u; voffB[i] = (unsigned)(Rb * g.ldb + C) * 2u; }
    const size_t kstep = (size_t)(BK * 2);
    const size_t hstepA = (size_t)HALF * g.lda * 2, hstepB = (size_t)HALF * g.ldb * 2;
    const size_t tstepA = 2 * hstepA, tstepB = 2 * hstepB;
    const unsigned ldsw = (unsigned)wid * 1024u;
    const int aoff = lds_byte(wr * 64 + fr, fq * 8), boff = lds_byte(wc * 32 + fr, fq * 8);
#define PG8_SA(b, h) (((b) * 2 + (h)) * HTB)
#define PG8_SB(b, h) ((4 + (b) * 2 + (h)) * HTB)
#define PG8_STAGE(bufoff, gbase, voff) do { _Pragma("unroll") for (int _i = 0; _i < 2; ++_i) \
        __builtin_amdgcn_global_load_lds((const unsigned*)((const char*)(gbase) + (voff)[_i]), (PG8_LAS unsigned*)(lds + (bufoff) + ldsw + _i * 8192), 16, 0, 0); } while (0)
#define PG8_LDA(dst, b, h) do { _Pragma("unroll") for (int m = 0; m < 4; ++m) _Pragma("unroll") for (int k = 0; k < 2; ++k) dst[m][k] = *(const PG8_LAS bf16x8*)(lds + PG8_SA(b, h) + aoff + m * 2048 + k * 1024); } while (0)
#define PG8_LDB(dst, b, h) do { _Pragma("unroll") for (int n = 0; n < 2; ++n) _Pragma("unroll") for (int k = 0; k < 2; ++k) dst[n][k] = *(const PG8_LAS bf16x8*)(lds + PG8_SB(b, h) + boff + n * 2048 + k * 1024); } while (0)
#define PG8_MMA(ai, bj, At, Bt) do { __builtin_amdgcn_s_setprio(1); _Pragma("unroll") for (int m = 0; m < 4; ++m) _Pragma("unroll") for (int n = 0; n < 2; ++n) _Pragma("unroll") for (int k = 0; k < 2; ++k) \
        acc[ai][bj][m][n] = __builtin_amdgcn_mfma_f32_16x16x32_bf16(Bt[n][k], At[m][k], acc[ai][bj][m][n], 0, 0, 0); __builtin_amdgcn_s_setprio(0); } while (0)
#define PG8_WAIT_V(n) asm volatile("s_waitcnt vmcnt(" #n ")" ::: "memory")
#define PG8_WAIT_L(n) asm volatile("s_waitcnt lgkmcnt(" #n ")" ::: "memory")
#define PG8_BAR __builtin_amdgcn_s_barrier()
#define PG8_SCHED __builtin_amdgcn_sched_barrier(0)
    Unit cur, nxt; int ui = 0;
    if (!S.next(0, cur)) return;
    f32x4 acc[2][2][4][2];
#pragma unroll
    for (int a = 0; a < 2; ++a)
#pragma unroll
        for (int b = 0; b < 2; ++b)
#pragma unroll
            for (int m = 0; m < 4; ++m)
#pragma unroll
                for (int n = 0; n < 2; ++n) acc[a][b][m][n] = (f32x4){0.f, 0.f, 0.f, 0.f};
    bf16x8 At[4][2], B0[2][2], B1[2][2];
    const char* cA = (const char*)g.A + (size_t)cur.pm * tstepA; const char* cB = (const char*)g.Bt + (size_t)cur.pn * tstepB;
    S.a_ready(cur);
    PG8_STAGE(PG8_SB(0, 0), cB, voffB); PG8_STAGE(PG8_SA(0, 0), cA, voffA); PG8_STAGE(PG8_SB(0, 1), cB + hstepB, voffB); PG8_STAGE(PG8_SA(0, 1), cA + hstepA, voffA);
    if (wr == 1) PG8_BAR;
    PG8_WAIT_V(4); PG8_BAR;
    PG8_STAGE(PG8_SB(1, 0), cB + kstep, voffB); PG8_STAGE(PG8_SA(1, 0), cA + kstep, voffA); PG8_STAGE(PG8_SB(1, 1), cB + hstepB + kstep, voffB);
    PG8_WAIT_V(6); PG8_BAR;
    for (;;) {
        const bool has_next = S.next(ui + 1, nxt);
        const char* nA = has_next ? (const char*)g.A + (size_t)nxt.pm * tstepA : cA; const char* nB = has_next ? (const char*)g.Bt + (size_t)nxt.pn * tstepB : cB;
        for (int t = 0; t < nt; t += 2) {
            const bool last = (t == nt - 2);
            const char* a1 = cA + (size_t)(t + 1) * kstep;
            const char* a2 = last ? nA : cA + (size_t)(t + 2) * kstep; const char* b2 = last ? nB : cB + (size_t)(t + 2) * kstep;
            const char* a3 = a2 + kstep; const char* b3 = b2 + kstep;
            if (last && has_next) S.a_ready(nxt);
            PG8_LDB(B0, 0, 0); PG8_SCHED; PG8_LDA(At, 0, 0); PG8_STAGE(PG8_SA(1, 1), a1 + hstepA, voffA);
            PG8_WAIT_L(8); PG8_BAR; PG8_WAIT_L(0); PG8_MMA(0, 0, At, B0); PG8_BAR; PG8_SCHED;
            PG8_LDB(B1, 0, 1); PG8_STAGE(PG8_SB(0, 0), b2, voffB);
            PG8_BAR; PG8_WAIT_L(0); PG8_MMA(0, 1, At, B1); PG8_BAR;
            PG8_LDA(At, 0, 1); PG8_STAGE(PG8_SA(0, 0), a2, voffA);
            PG8_BAR; PG8_WAIT_L(0); PG8_MMA(1, 0, At, B0); PG8_BAR; PG8_SCHED;
            PG8_STAGE(PG8_SB(0, 1), b2 + hstepB, voffB);
            PG8_WAIT_V(6); PG8_BAR; PG8_MMA(1, 1, At, B1); PG8_BAR;
            PG8_LDB(B0, 1, 0); PG8_SCHED; PG8_LDA(At, 1, 0); PG8_STAGE(PG8_SA(0, 1), a2 + hstepA, voffA);
            PG8_WAIT_L(8); PG8_BAR; PG8_WAIT_L(0); PG8_MMA(0, 0, At, B0); PG8_BAR; PG8_SCHED;
            PG8_LDB(B1, 1, 1); PG8_STAGE(PG8_SB(1, 0), b3, voffB);
            PG8_BAR; PG8_WAIT_L(0); PG8_MMA(0, 1, At, B1); PG8_BAR;
            PG8_LDA(At, 1, 1); PG8_STAGE(PG8_SA(1, 0), a3, voffA);
            PG8_BAR; PG8_WAIT_L(0); PG8_MMA(1, 0, At, B0); PG8_BAR; PG8_SCHED;
            PG8_STAGE(PG8_SB(1, 1), b3 + hstepB, voffB);
            PG8_WAIT_V(6); PG8_BAR; PG8_MMA(1, 1, At, B1); PG8_BAR;
        }
            if constexpr (!Epi::AFTER_DRAIN) { E(acc, cur, wr, wc, fr, fq); S.done(cur); }
            if (!has_next) break;
#pragma unroll
        for (int a = 0; a < 2; ++a)
#pragma unroll
            for (int b = 0; b < 2; ++b)
#pragma unroll
                for (int m = 0; m < 4; ++m)
#pragma unroll
                    for (int n = 0; n < 2; ++n) acc[a][b][m][n] = (f32x4){0.f, 0.f, 0.f, 0.f};
        cur = nxt; cA = nA; cB = nB; ++ui;
    }
    PG8_WAIT_V(0);
    if (wr == 0) PG8_BAR;
    PG8_BAR;
    if constexpr (Epi::AFTER_DRAIN) { E.fused(acc, cur, wr, wc, fr, fq, lds, wid, lane); S.done(cur); }
#undef PG8_SA
#undef PG8_SB
#undef PG8_STAGE
#undef PG8_LDA
#undef PG8_LDB
#undef PG8_MMA
#undef PG8_WAIT_V
#undef PG8_WAIT_L
#undef PG8_BAR
#undef PG8_SCHED
}
}

constexpr int D = 2048, NB = 2, SEQ = 16384, CL = 256, TL = NB * SEQ, TC = NB * CL, MR = TL + TC;
constexpr int NHEAD = 32, HN = 64;
constexpr int IN_COLS = 16832, CONV_COLS = 12736;
constexpr int NR = 6656, NHY = 6144, NG = 4096, NTOT = NR + NHY + NG;
constexpr int LORA_W = 512;
constexpr int NPART = 32;
constexpr int NEXP = 16384;
constexpr float NORM_EPS = 1e-6f, GN_EPS = 64e-5f;
constexpr int NTHREADS = 512;
constexpr int LDS_BYTES = 159 * 1024;

constexpr size_t al256(size_t x) { return (x + 255) & ~(size_t)255; }
constexpr size_t SLOT_BYTES = (size_t)MR * D * 2;
constexpr size_t WS_BAR    = 0;
constexpr size_t WS_PTRS   = 14336;
constexpr size_t WS_MOD    = 16384;
constexpr size_t WS_MODP   = WS_MOD    + al256((size_t)2 * 3 * 6 * D * 4);
constexpr size_t WS_TW     = WS_MODP   + al256((size_t)NPART * 2 * 3 * 6 * D * 4);
constexpr size_t WS_CONVW  = WS_TW     + al256((size_t)32768 * 8);
constexpr size_t WS_LBIAS  = WS_CONVW  + al256((size_t)3 * NTOT * 4);
constexpr size_t WS_CTXRES = WS_LBIAS  + al256((size_t)4 * D * 4);
constexpr size_t WS_H      = WS_CTXRES + al256((size_t)TC * D * 4);
constexpr size_t WS_WTIN   = WS_H      + SLOT_BYTES;
constexpr size_t WS_WTLORA = WS_WTIN   + al256((size_t)NTOT * D * 2);
constexpr size_t WS_WTOUT  = WS_WTLORA + al256((size_t)4 * D * LORA_W * 2);
constexpr size_t WS_WTSC   = WS_WTOUT  + al256((size_t)D * D * 2);
constexpr size_t WS_W3T    = WS_WTSC   + al256((size_t)D * D * 2);
constexpr size_t WS_HDN    = WS_W3T    + al256((size_t)8192 * 256 * 2);
constexpr size_t WS_HDNC   = WS_HDN    + al256((size_t)SEQ * 256 * 2);
constexpr size_t WS_PCTX   = WS_HDNC   + al256((size_t)CL * 256 * 2);
constexpr size_t WS_LORAIN = WS_PCTX   + al256((size_t)TC * NR * 2);
constexpr size_t WS_SLOT0  = WS_LORAIN + al256((size_t)MR * LORA_W * 2);
constexpr size_t WS_PEER8  = WS_SLOT0  + 7 * SLOT_BYTES;
constexpr size_t WS_END    = WS_PEER8  + al256((size_t)2 * NEXP * D);
constexpr size_t CH_ARR = (size_t)NB * D * CL * 4;
constexpr size_t WS_CV   = WS_LORAIN;
constexpr size_t WS_YHC  = WS_CV + 3 * CH_ARR;
constexpr size_t WS_HCF  = WS_YHC + CH_ARR;
static_assert(WS_HCF + (size_t)8192 * 256 * 4 <= WS_SLOT0, "ctx hyena arrays must fit the lora_in region");

#define GAS __attribute__((address_space(1)))
struct KArgs {
    const float* in[33];
    float* out;
    unsigned char* ws;
};
struct Params {
    float* out;
    unsigned char* ws;
    int tid, bid, nblk;
};

enum { I_X = 0, I_C, I_CTX, I_CCTX, I_ADAW, I_ADAB, I_N1G, I_N2G, I_WIN, I_CONVW, I_W0, I_W2, I_A0, I_A2, I_G2, I_KK, I_KA, I_RK, I_LNW, I_LNB,
       I_HW1, I_HB1, I_HW2, I_HB2, I_HW3, I_HFREQ, I_HSKIP, I_WOUT, I_WQ, I_KEYS, I_PU, I_PV, I_FING };

__device__ __forceinline__ float bf2f(bf16_t v) { return __uint_as_float((unsigned)v << 16); }
__device__ __forceinline__ bf16_t f2bf(float f) { unsigned u = __float_as_uint(f); u += 0x7FFFu + ((u >> 16) & 1u); return (bf16_t)(u >> 16); }
__device__ __forceinline__ unsigned pack2(float lo, float hi) { return (unsigned)f2bf(lo) | ((unsigned)f2bf(hi) << 16); }
__device__ __forceinline__ float bflo(unsigned w) { return __uint_as_float(w << 16); }
__device__ __forceinline__ float bfhi(unsigned w) { return __uint_as_float(w & 0xFFFF0000u); }
__device__ __forceinline__ float sigmoidf_(float x) { return __builtin_amdgcn_rcpf(1.0f + __expf(-x)); }
__device__ __forceinline__ float tanhf_(float x) { return 1.0f - 2.0f * __builtin_amdgcn_rcpf(1.0f + __expf(2.0f * x)); }
template <int CTRL> __device__ __forceinline__ float dppf(float x) { return __builtin_bit_cast(float, __builtin_amdgcn_mov_dpp(__builtin_bit_cast(int, x), CTRL, 0xf, 0xf, true)); }
__device__ __forceinline__ float red16(float x) { x += dppf<0xB1>(x); x += dppf<0x4E>(x); x += dppf<0x141>(x); x += dppf<0x128>(x); return x; }
__device__ __forceinline__ float rdlane(float x, int l) { return __builtin_bit_cast(float, __builtin_amdgcn_readlane(__builtin_bit_cast(int, x), l)); }
__device__ __forceinline__ float wave_sum(float x) { x = red16(x); return (rdlane(x, 0) + rdlane(x, 16)) + (rdlane(x, 32) + rdlane(x, 48)); }

__device__ __forceinline__ const float* inp(const Params& p, int k) {
    const unsigned long long v = ((const unsigned long long*)(p.ws + WS_PTRS))[k];
    const unsigned lo = __builtin_amdgcn_readfirstlane((unsigned)v), hi = __builtin_amdgcn_readfirstlane((unsigned)(v >> 32));
    GAS const float* g_ = (GAS const float*)(((unsigned long long)hi << 32) | lo); asm volatile("" : "+s"(g_)); return (const float*)g_;
}
__device__ __forceinline__ const float* xrow_c(const Params& p, int r) { return r < TL ? p.out + (size_t)r * D : (const float*)(p.ws + WS_CTXRES) + (size_t)(r - TL) * D; }
__device__ __forceinline__ float* xrow(const Params& p, int r) { return r < TL ? p.out + (size_t)r * D : (float*)(p.ws + WS_CTXRES) + (size_t)(r - TL) * D; }
__device__ __forceinline__ int mrow_of(int r) { return r < TL ? (r >> 14) : 2; }
__device__ __forceinline__ const float* modp(const Params& p, int l, int mrow, int chunk) { return (const float*)(p.ws + WS_MOD) + ((size_t)(l * 3 + mrow) * 6 + chunk) * D; }
__device__ __forceinline__ bf16_t* slot(const Params& p, int s) { return (bf16_t*)(p.ws + WS_SLOT0 + (size_t)s * SLOT_BYTES); }

__device__ __forceinline__ int src_col(int n) {
    if (n < 4096) return n;
    if (n < 6144) return 4480 + (n - 4096);
    if (n < NR) { const int cc = n - 6144, blk = cc >> 7, o = cc & 127;
        if (o < 96) return (blk == 0 ? 4096 : blk == 1 ? 4288 : blk == 2 ? 4192 : 4384) + o;
        return blk == 0 ? 6528 + (o - 96) : blk == 1 ? 6528 + 32 + (o - 96) : -1; }
    if (n < NR + NHY) return 6592 + (n - NR);
    { const int g = n - NR - NHY, tile = g >> 8, o = g & 255;
      return o < 128 ? CONV_COLS + tile * 128 + o : CONV_COLS + D + tile * 128 + (o - 128); }
}

__device__ __forceinline__ float siluf_(float x) { return x * sigmoidf_(x); }
__device__ __forceinline__ void ph_init(const Params& p, const float* in_x, const float* in_ctx, const float* cv, const float* cc, const float* ada_w) {
    const size_t gt = (size_t)p.bid * NTHREADS + p.tid, GT = (size_t)p.nblk * NTHREADS;
    float* mp = (float*)(p.ws + WS_MODP);
    for (int u = p.bid; u < 2 * 12 * NPART; u += p.nblk) {
        const int kc = u % NPART, cch = (u / NPART) % 12, l = u / (NPART * 12);
        const int col = cch * 1024 + p.tid * 2;
        float a0 = 0.f, a1 = 0.f, b0 = 0.f, b1 = 0.f, c0 = 0.f, c1 = 0.f;
        const float* w = ada_w + ((size_t)l * D + (size_t)kc * 64) * (6 * D) + col;
#pragma unroll 8
        for (int k = 0; k < 64; ++k) {
            const int kk = kc * 64 + k;
            const float s0 = siluf_(cv[kk]), s1 = siluf_(cv[D + kk]), s2 = siluf_(cc[kk]);
            const f32x2 wv = *(const f32x2*)(w + (size_t)k * (6 * D));
            a0 += s0 * wv.x; a1 += s0 * wv.y; b0 += s1 * wv.x; b1 += s1 * wv.y; c0 += s2 * wv.x; c1 += s2 * wv.y;
        }
        float* o = mp + ((size_t)(kc * 2 + l) * 3) * (6 * D) + col;
        *(f32x2*)(o) = (f32x2){a0, a1}; *(f32x2*)(o + 6 * D) = (f32x2){b0, b1}; *(f32x2*)(o + 12 * D) = (f32x2){c0, c1};
    }
}
__device__ __forceinline__ void ph_modred(const Params& p) {
    const int gt = p.bid * NTHREADS + p.tid, GT = p.nblk * NTHREADS;
    const float* mp = (const float*)(p.ws + WS_MODP); float* md = (float*)(p.ws + WS_MOD);
    for (int i = gt; i < 2 * 3 * 6 * D; i += GT) {
        const int col = i % (6 * D), r = (i / (6 * D)) % 3, l = i / (18 * D);
        float s = inp(p, I_ADAB)[l * 6 * D + col];
        for (int kc = 0; kc < NPART; ++kc) s += mp[((size_t)(kc * 2 + l) * 3 + r) * (6 * D) + col];
        md[i] = s;
    }
}

__device__ __forceinline__ void norm_rows(const Params& p, const float* g, int l, int ch_shift, int ch_scale, int M, const float* xin = nullptr, const float* cin = nullptr) {
    const int lane = p.tid & 63, wv = p.bid * 8 + (p.tid >> 6), NW = p.nblk * 8;
    bf16_t* h = (bf16_t*)(p.ws + WS_H);
    f32x4 gg[8];
#pragma unroll
    for (int c = 0; c < 8; ++c) gg[c] = *(const f32x4*)(g + c * 256 + lane * 4);
    auto rowp = [&](int r) { return xin ? (r < TL ? xin + (size_t)r * D : cin + (size_t)(r - TL) * D) : xrow_c(p, r); };
    f32x4 v[8];
    if (wv < M) { const float* xr = rowp(wv);
#pragma unroll
        for (int c = 0; c < 8; ++c) v[c] = *(const f32x4*)(xr + c * 256 + lane * 4); }
    for (int r = wv; r < M; r += NW) {
        const int mr = mrow_of(r);
        const float* sh = modp(p, l, mr, ch_shift); const float* sc = modp(p, l, mr, ch_scale);
        f32x4 vn[8];
        { const int rn = r + NW < M ? r + NW : r; const float* xn = rowp(rn);
#pragma unroll
          for (int c = 0; c < 8; ++c) vn[c] = *(const f32x4*)(xn + c * 256 + lane * 4); }
        float ss = 0.f;
#pragma unroll
        for (int c = 0; c < 8; ++c) ss += v[c][0] * v[c][0] + v[c][1] * v[c][1] + v[c][2] * v[c][2] + v[c][3] * v[c][3];
        ss = wave_sum(ss);
        const float rs = rsqrtf(ss * (1.0f / D) + NORM_EPS);
#pragma unroll
        for (int c = 0; c < 8; ++c) { const int col = c * 256 + lane * 4;
            const f32x4 s1 = *(const f32x4*)(sc + col), s0 = *(const f32x4*)(sh + col);
            const f32x4 y = (v[c] * rs) * gg[c] * (s1 + 1.0f) + s0;
            u32x2 w; w.x = pack2(y[0], y[1]); w.y = pack2(y[2], y[3]);
            *(u32x2*)(h + (size_t)r * D + col) = w; }
#pragma unroll
        for (int c = 0; c < 8; ++c) v[c] = vn[c];
    }
}

template <class F> __device__ __forceinline__ void cvt_T(const Params& p, bf16_t* dst, int N, int Kd, F f) {
    const int lane = p.tid & 63, wv = p.bid * 8 + (p.tid >> 6), NW = p.nblk * 8;
    const int nblk = N / 64, units = nblk * (Kd / 32);
    for (int u = wv; u < units; u += NW) {
        const int n = (u % nblk) * 64 + lane, k0 = (u / nblk) * 32;
        float v[32];
#pragma unroll
        for (int i = 0; i < 32; ++i) v[i] = f(k0 + i, n);
        unsigned w[16];
#pragma unroll
        for (int i = 0; i < 16; ++i) w[i] = pack2(v[2 * i], v[2 * i + 1]);
        u32x4* d = (u32x4*)(dst + (size_t)n * Kd + k0);
#pragma unroll
        for (int i = 0; i < 4; ++i) d[i] = (u32x4){w[4 * i], w[4 * i + 1], w[4 * i + 2], w[4 * i + 3]};
    }
}

__device__ __forceinline__ void filter_mlp(const Params& p, int l, int Lf, bf16_t* dst) {
    const int lane = p.tid & 63, wv = p.bid * 8 + (p.tid >> 6), NW = p.nblk * 8;
    const float* w1 = inp(p, I_HW1) + (size_t)l * 33 * 64; const float* b1 = inp(p, I_HB1) + l * 64;
    const float* w2 = inp(p, I_HW2) + (size_t)l * 64 * 64; const float* b2 = inp(p, I_HB2) + l * 64;
    const float fr = inp(p, I_HFREQ)[l * 64 + lane];
    float w1c[33], w2c[64];
#pragma unroll
    for (int i = 0; i < 33; ++i) w1c[i] = w1[i * 64 + lane];
#pragma unroll
    for (int i = 0; i < 64; ++i) w2c[i] = w2[i * 64 + lane];
    const float b1l = b1[lane], b2l = b2[lane];
    for (int n = wv; n < Lf; n += NW) {
        float zf = 0.f;
        if (lane == 0) zf = (float)n / (float)(Lf - 1);
        else if (lane <= 32) { const int bi = (lane - 1) & 15; const float band = 1e-4f + (float)bi * ((15.0f - 1e-4f) / 15.0f);
            float s, c; sincospif(2.0f * (float)n * band / (float)Lf, &s, &c); zf = lane <= 16 ? c : -s; }
        float a = b1l;
#pragma unroll
        for (int i = 0; i < 33; ++i) a += rdlane(zf, i) * w1c[i];
        const float h1 = sinf(fr * a);
        float b = b2l;
#pragma unroll
        for (int i = 0; i < 64; ++i) b += rdlane(h1, i) * w2c[i];
        const float h2 = sinf(fr * b);
        bf16_t* d = dst + (size_t)n * 256;
        d[lane] = f2bf(h2); d[64 + lane] = 0; d[128 + lane] = 0; d[192 + lane] = 0;
    }
}

__device__ __forceinline__ void prep_win(const Params& p, int l, int n0, int n1) {
    const float* w = inp(p, I_WIN) + (size_t)l * D * IN_COLS;
    cvt_T(p, (bf16_t*)(p.ws + WS_WTIN) + (size_t)n0 * D, n1 - n0, D, [=](int k, int n) { const int s = src_col(n + n0); return s >= 0 ? w[(size_t)k * IN_COLS + s] : 0.f; });
    float* cw = (float*)(p.ws + WS_CONVW); const float* cs = inp(p, I_CONVW) + (size_t)l * 3 * CONV_COLS; const int nn = n1 - n0;
    for (int i = p.bid * NTHREADS + p.tid; i < 3 * nn; i += p.nblk * NTHREADS) { const int j = i / nn, n = n0 + i % nn; const int s = src_col(n);
        cw[j * NTOT + n] = (n < NR + NHY && s >= 0) ? cs[j * CONV_COLS + s] : 0.f; }
}
__device__ __forceinline__ void ph_prepA(const Params& p, int l) {
    prep_win(p, l, 0, NR);
    { const float* w2 = inp(p, I_W2) + (size_t)l * 2 * 96 * D; const float* a2 = inp(p, I_A2) + (size_t)l * 2 * 96 * D;
      cvt_T(p, (bf16_t*)(p.ws + WS_WTLORA), 4 * D, LORA_W, [=](int k, int n) { const int t = n >> 11, j = n & (D - 1), kb = k >> 7, o = k & 127;
          if (kb != t || o >= 96) return 0.f; const float* s = (t & 1) ? a2 : w2; return s[((size_t)(t >> 1) * 96 + o) * D + j]; }); }
    { float* lb = (float*)(p.ws + WS_LBIAS); for (int i = p.bid * NTHREADS + p.tid; i < 4 * D; i += p.nblk * NTHREADS) { const int t = i >> 11, j = i & (D - 1);
          lb[i] = ((t & 1) ? inp(p, I_A0) : inp(p, I_W0))[(size_t)l * 2 * D + (t >> 1) * D + j]; } }
}
__device__ __forceinline__ void ph_prepB(const Params& p, int l) { prep_win(p, l, NR, NTOT); }

__device__ __forceinline__ void ph_prep_bg(const Params& p, int l) {
    { const float* w = inp(p, I_WOUT) + (size_t)l * D * D; cvt_T(p, (bf16_t*)(p.ws + WS_WTOUT), D, D, [=](int k, int n) { return w[(size_t)k * D + n]; }); }
    { const float* w = inp(p, I_HW3) + (size_t)l * 64 * 8192; cvt_T(p, (bf16_t*)(p.ws + WS_W3T), 8192, 256, [=](int k, int n) { return k < 64 ? w[(size_t)k * 8192 + n] : 0.f; }); }
    { const float* wq = inp(p, I_WQ) + (size_t)l * D * D; const float* keys = inp(p, I_KEYS) + (size_t)l * 16 * 128 * 128; unsigned* dst = (unsigned*)(p.ws + WS_WTSC);
      for (size_t i = (size_t)p.bid * NTHREADS + p.tid; i < (size_t)D * D / 2; i += (size_t)p.nblk * NTHREADS) {
          const int row = (int)(i / (D / 2)), kk = (int)(i % (D / 2)) * 2, hp = row >> 7;
          const f32x4* kr = (const f32x4*)(keys + (size_t)row * 128); const f32x4* q0 = (const f32x4*)(wq + (size_t)kk * D + hp * 128); const f32x4* q1 = (const f32x4*)(wq + (size_t)(kk + 1) * D + hp * 128);
          float s0 = 0.f, s1 = 0.f;
#pragma unroll 4
          for (int d4 = 0; d4 < 32; ++d4) { const f32x4 a = kr[d4], b = q0[d4], c = q1[d4];
              s0 += a[0] * b[0] + a[1] * b[1] + a[2] * b[2] + a[3] * b[3]; s1 += a[0] * c[0] + a[1] * c[1] + a[2] * c[2] + a[3] * c[3]; }
          dst[i] = pack2(s0, s1); } }
    filter_mlp(p, l, SEQ, (bf16_t*)(p.ws + WS_HDN));
    if (l == 0) filter_mlp(p, l, CL, (bf16_t*)(p.ws + WS_HDNC));
    { const f32x4* su = (const f32x4*)(inp(p, I_PU) + (size_t)l * NEXP * D); const f32x4* sv = (const f32x4*)(inp(p, I_PV) + (size_t)l * NEXP * D);
      unsigned* du = (unsigned*)(p.ws + WS_PEER8); unsigned* dv = du + (size_t)NEXP * D / 4;
      for (size_t i = (size_t)p.bid * NTHREADS + p.tid; i < (size_t)NEXP * D / 4; i += (size_t)p.nblk * NTHREADS) {
          const f32x4 a = su[i] * 128.0f, b = sv[i] * 8.0f;
          int wa = __builtin_amdgcn_cvt_pk_fp8_f32(a[0], a[1], 0, false); wa = __builtin_amdgcn_cvt_pk_fp8_f32(a[2], a[3], wa, true);
          int wb = __builtin_amdgcn_cvt_pk_fp8_f32(b[0], b[1], 0, false); wb = __builtin_amdgcn_cvt_pk_fp8_f32(b[2], b[3], wb, true);
          du[i] = (unsigned)wa; dv[i] = (unsigned)wb; } }
}

using pg8::Unit; using pg8::cvt_pk_bf16;
typedef f32x4 Acc[2][2][4][2];

__device__ __forceinline__ void st8bf(bf16_t* p, const f32x4 a, const f32x4 b) { *(u32x4*)p = (u32x4){cvt_pk_bf16(a[0], a[1]), cvt_pk_bf16(a[2], a[3]), cvt_pk_bf16(b[0], b[1]), cvt_pk_bf16(b[2], b[3])}; }
__device__ __forceinline__ void st4bf(bf16_t* p, const f32x4 v) { u32x2 w; w.x = cvt_pk_bf16(v[0], v[1]); w.y = cvt_pk_bf16(v[2], v[3]); *(u32x2*)p = w; }

template <int GROUP> struct EpiConv {
    static constexpr bool PERM = false, AFTER_DRAIN = false;
    const float* cw;
    bf16_t* pctx;
    bf16_t* d0; bf16_t* lora;
    __device__ __forceinline__ void operator()(const Acc& acc, const Unit& u, int wr, int wc, int fr, int fq) const {
        if (u.pm >= TL / 256) {
#pragma unroll
            for (int ai = 0; ai < 2; ++ai)
#pragma unroll
                for (int m = 0; m < 4; ++m) { const int row = (u.pm - TL / 256) * 256 + ai * 128 + wr * 64 + m * 16 + fr;
#pragma unroll
                    for (int bj = 0; bj < 2; ++bj)
#pragma unroll
                        for (int n = 0; n < 2; ++n) st4bf(pctx + (size_t)row * NR + u.pn * 256 + bj * 128 + wc * 32 + n * 16 + 4 * fq, acc[ai][bj][m][n]); }
            return;
        }
        f32x4 tap[2][2][3];
#pragma unroll
        for (int bj = 0; bj < 2; ++bj)
#pragma unroll
            for (int n = 0; n < 2; ++n)
#pragma unroll
                for (int j = 0; j < 3; ++j) tap[bj][n][j] = *(const f32x4*)(cw + j * NTOT + u.pn * 256 + bj * 128 + wc * 32 + n * 16 + 4 * fq);
#pragma unroll
        for (int bj = 0; bj < 2; ++bj)
#pragma unroll
            for (int n = 0; n < 2; ++n) {
                const int colg = u.pn * 256 + bj * 128 + wc * 32 + n * 16 + 4 * fq;
                const f32x4 w0 = tap[bj][n][0], w1 = tap[bj][n][1], w2 = tap[bj][n][2];
#pragma unroll
                for (int ai = 0; ai < 2; ++ai) {
                    f32x4 rp[4], rn[4];
#pragma unroll
                    for (int m = 0; m < 4; ++m)
#pragma unroll
                        for (int e = 0; e < 4; ++e) { rp[m][e] = dppf<0x121>(acc[ai][bj][m][n][e]); rn[m][e] = dppf<0x12F>(acc[ai][bj][m][n][e]); }
#pragma unroll
                    for (int m = 0; m < 4; ++m) {
                        const f32x4 z = (f32x4){0.f, 0.f, 0.f, 0.f};
                        const f32x4 pv = (fr == 0) ? (m > 0 ? rp[m > 0 ? m - 1 : 0] : z) : rp[m];
                        const f32x4 nx = (fr == 15) ? (m < 3 ? rn[m < 3 ? m + 1 : 3] : z) : rn[m];
                        const f32x4 o = w0 * pv + w1 * acc[ai][bj][m][n] + w2 * nx;
                        const int row = u.pm * 256 + ai * 128 + wr * 64 + m * 16 + fr;
                        if (GROUP == 0) {
                            if (colg < 3 * D) { bf16_t* d = d0 + (size_t)(colg >> 11) * (SLOT_BYTES / 2); st4bf(d + (size_t)row * D + (colg & (D - 1)), o); }
                            else { const int cc = colg - 3 * D, blk = cc >> 7, oo = cc & 127; f32x4 a;
                                if (oo < 96) { if (blk & 1) a = o; else { a[0] = tanhf_(o[0]); a[1] = tanhf_(o[1]); a[2] = tanhf_(o[2]); a[3] = tanhf_(o[3]); } }
                                else if (blk < 2) { a[0] = sigmoidf_(o[0]); a[1] = sigmoidf_(o[1]); a[2] = sigmoidf_(o[2]); a[3] = sigmoidf_(o[3]); }
                                else a = z;
                                st4bf(lora + (size_t)row * LORA_W + cc, a); }
                        } else {
                            bf16_t* d = d0 + (size_t)(colg >> 11) * (SLOT_BYTES / 2); const int c = colg & (D - 1), b = row >> 14, t = row & (SEQ - 1);
                            const bool odd = fr & 1;
                            const float r0 = dppf<0xB1>(odd ? o[0] : o[2]), r1 = dppf<0xB1>(odd ? o[1] : o[3]);
                            const unsigned w0 = cvt_pk_bf16(odd ? r0 : o[0], odd ? o[2] : r0), w1 = cvt_pk_bf16(odd ? r1 : o[1], odd ? o[3] : r1);
                            bf16_t* q = d + ((size_t)(b * D + c + (odd ? 2 : 0))) * SEQ + (t - (odd ? 1 : 0));
                            *(unsigned*)q = w0; *(unsigned*)(q + SEQ) = w1;
                        }
                    }
                }
            }
    }
};

struct EpiLora {
    static constexpr bool PERM = true, AFTER_DRAIN = false;
    const float* bias4;
    int t0;
    bf16_t* dst0;
    __device__ __forceinline__ void operator()(const Acc& acc, const Unit& u, int wr, int wc, int fr, int fq) const {
        const int t = t0 + (u.pn >> 3); const bool isa = t & 1; const float mul = isa ? 1.0f : -0.60653065971f; const float* bias = bias4 + t * D; bf16_t* d = dst0 + (size_t)t * (SLOT_BYTES / 2);
#pragma unroll
        for (int bj = 0; bj < 2; ++bj) { const int col = (u.pn & 7) * 256 + bj * 128 + wc * 32 + 8 * fq; const f32x4 b0 = *(const f32x4*)(bias + col), b1 = *(const f32x4*)(bias + col + 4);
#pragma unroll
            for (int ai = 0; ai < 2; ++ai)
#pragma unroll
                for (int m = 0; m < 4; ++m) { const int row = u.pm * 256 + ai * 128 + wr * 64 + m * 16 + fr; const f32x4 x0 = acc[ai][bj][m][0] + b0, x1 = acc[ai][bj][m][1] + b1; f32x4 o0, o1;
#pragma unroll
                    for (int e = 0; e < 4; ++e) { o0[e] = sigmoidf_(x0[e]) * mul; o1[e] = sigmoidf_(x1[e]) * mul; }
                    st8bf(d + (size_t)row * D + col, o0, o1); } }
    }
};

struct EpiBf {
    static constexpr bool PERM = true, AFTER_DRAIN = false;
    bf16_t* O; int ldc;
    __device__ __forceinline__ void operator()(const Acc& acc, const Unit& u, int wr, int wc, int fr, int fq) const {
#pragma unroll
        for (int ai = 0; ai < 2; ++ai)
#pragma unroll
            for (int m = 0; m < 4; ++m) { const int row = u.pm * 256 + ai * 128 + wr * 64 + m * 16 + fr;
#pragma unroll
                for (int bj = 0; bj < 2; ++bj) st8bf(O + (size_t)row * ldc + u.pn * 256 + bj * 128 + wc * 32 + 8 * fq, acc[ai][bj][m][0], acc[ai][bj][m][1]); }
    }
};
struct EpiF32 {
    static constexpr bool PERM = false, AFTER_DRAIN = false;
    float* O; int ldc;
    __device__ __forceinline__ void operator()(const Acc& acc, const Unit& u, int wr, int wc, int fr, int fq) const {
#pragma unroll
        for (int ai = 0; ai < 2; ++ai)
#pragma unroll
            for (int m = 0; m < 4; ++m) { const int row = u.pm * 256 + ai * 128 + wr * 64 + m * 16 + fr;
#pragma unroll
                for (int bj = 0; bj < 2; ++bj)
#pragma unroll
                    for (int n = 0; n < 2; ++n) *(f32x4*)(O + (size_t)row * ldc + u.pn * 256 + bj * 128 + wc * 32 + n * 16 + 4 * fq) = acc[ai][bj][m][n]; }
    }
};
struct EpiGate {
    static constexpr bool PERM = false, AFTER_DRAIN = false;
    const bf16_t* yrw;
    const bf16_t* yhy;
    const float* yhc;
    bf16_t* y;
    __device__ __forceinline__ void operator()(const Acc& acc, const Unit& u, int wr, int wc, int fr, int fq) const {
        const bool lat = u.pm < TL / 256;
#pragma unroll
        for (int ai = 0; ai < 2; ++ai) {
            u32x2 rw[4][2]; float hy[4][2][4];
#pragma unroll
            for (int m = 0; m < 4; ++m) { const int row = u.pm * 256 + ai * 128 + wr * 64 + m * 16 + fr;
#pragma unroll
                for (int n = 0; n < 2; ++n) { const int ch = u.pn * 128 + wc * 32 + n * 16 + 4 * fq;
                    rw[m][n] = *(const u32x2*)(yrw + (size_t)row * D + ch);
                    if (lat) { const bf16_t* q = yhy + ((size_t)((row >> 14) * D + ch)) * SEQ + (row & (SEQ - 1));
#pragma unroll
                        for (int e = 0; e < 4; ++e) hy[m][n][e] = bf2f(q[(size_t)e * SEQ]); }
                    else { const int rc = row - TL; const float* q = yhc + ((size_t)((rc >> 8) * D + ch)) * CL + (rc & (CL - 1));
#pragma unroll
                        for (int e = 0; e < 4; ++e) hy[m][n][e] = q[(size_t)e * CL]; } } }
#pragma unroll
            for (int m = 0; m < 4; ++m) { const int row = u.pm * 256 + ai * 128 + wr * 64 + m * 16 + fr;
#pragma unroll
                for (int n = 0; n < 2; ++n) { const int ch = u.pn * 128 + wc * 32 + n * 16 + 4 * fq;
                    const float r4[4] = {bflo(rw[m][n].x), bfhi(rw[m][n].x), bflo(rw[m][n].y), bfhi(rw[m][n].y)};
                    f32x4 o;
#pragma unroll
                    for (int e = 0; e < 4; ++e) o[e] = sigmoidf_(acc[ai][0][m][n][e]) * r4[e] + sigmoidf_(acc[ai][1][m][n][e]) * hy[m][n][e];
                    st4bf(y + (size_t)row * D + ch, o); } }
        }
    }
};
struct EpiResid {
    static constexpr bool PERM = false, AFTER_DRAIN = false;
    float* xl; float* xc; const float* ga;
    const float* rl; const float* rc;
    __device__ __forceinline__ void operator()(const Acc& acc, const Unit& u, int wr, int wc, int fr, int fq) const {
        const int row00 = u.pm * 256 + wr * 64 + fr; const int mr = mrow_of(row00);
        const float* g = ga + (size_t)mr * 6 * D + u.pn * 256 + wc * 32 + 4 * fq;
        f32x4 gv[2][2];
#pragma unroll
        for (int bj = 0; bj < 2; ++bj)
#pragma unroll
            for (int n = 0; n < 2; ++n) gv[bj][n] = *(const f32x4*)(g + bj * 128 + n * 16);
#pragma unroll
        for (int ai = 0; ai < 2; ++ai)
#pragma unroll
            for (int mh = 0; mh < 2; ++mh) {
                f32x4 xv[2][2][2]; f32x4* qp[2];
#pragma unroll
                for (int mm = 0; mm < 2; ++mm) { const int row = row00 + ai * 128 + (2 * mh + mm) * 16;
                    const size_t ro = (row < TL ? (size_t)row * D : (size_t)(row - TL) * D) + u.pn * 256 + wc * 32 + 4 * fq;
                    float* xr = (row < TL ? xl : xc) + ro; qp[mm] = (f32x4*)xr; const float* xs = (row < TL ? rl : rc) + ro;
#pragma unroll
                    for (int bj = 0; bj < 2; ++bj)
#pragma unroll
                        for (int n = 0; n < 2; ++n) xv[mm][bj][n] = *(const f32x4*)(xs + bj * 128 + n * 16); }
#pragma unroll
                for (int mm = 0; mm < 2; ++mm)
#pragma unroll
                    for (int bj = 0; bj < 2; ++bj)
#pragma unroll
                        for (int n = 0; n < 2; ++n) *(f32x4*)((float*)qp[mm] + bj * 128 + n * 16) = xv[mm][bj][n] + gv[bj][n] * acc[ai][bj][2 * mh + mm][n]; }
    }
};

template <class Epi> __device__ __forceinline__ void run_gemm(const Params& p, unsigned char* lds, const bf16_t* A, int lda, const bf16_t* Bt, int ldb, int M, int N, int K, const Epi& E) {
    asm volatile("" : "+s"(M), "+s"(N), "+s"(K), "+s"(lda), "+s"(ldb));
    pg8::Gemm g{A, Bt, M, N, K, lda, ldb}; pg8::StaticOrder S; S.init(M, N, (int)p.nblk, (int)p.bid);
    pg8::gemm_phase<Epi, pg8::StaticOrder>((PG8_LAS unsigned char*)lds, g, S, E, p.tid);
}

template <int GROUP> __device__ __forceinline__ void ph_ctxconv(const Params& p) {
    constexpr int NC = GROUP == 0 ? NR : NHY;
    const float* cw = (const float*)(p.ws + WS_CONVW) + (GROUP == 0 ? 0 : NR);
    const bf16_t* pc = (const bf16_t*)(p.ws + WS_PCTX);
    const int items = TC * (NC / 4);
    for (int i = p.bid * NTHREADS + p.tid; i < items; i += p.nblk * NTHREADS) {
        const int rc = i / (NC / 4), colg = (i % (NC / 4)) * 4, t = rc & (CL - 1);
        const f32x4 w0 = *(const f32x4*)(cw + colg), w1 = *(const f32x4*)(cw + NTOT + colg), w2 = *(const f32x4*)(cw + 2 * NTOT + colg);
        const u32x2 c = *(const u32x2*)(pc + (size_t)rc * NR + colg);
        u32x2 a = (u32x2){0u, 0u}, b = (u32x2){0u, 0u};
        if (t > 0) a = *(const u32x2*)(pc + (size_t)(rc - 1) * NR + colg);
        if (t < CL - 1) b = *(const u32x2*)(pc + (size_t)(rc + 1) * NR + colg);
        const f32x4 pv = (f32x4){bflo(a.x), bfhi(a.x), bflo(a.y), bfhi(a.y)}, cu = (f32x4){bflo(c.x), bfhi(c.x), bflo(c.y), bfhi(c.y)}, nx = (f32x4){bflo(b.x), bfhi(b.x), bflo(b.y), bfhi(b.y)};
        const f32x4 o = w0 * pv + w1 * cu + w2 * nx;
        const int row = TL + rc;
        if (GROUP == 0) {
            if (colg < 3 * D) { bf16_t* d = slot(p, colg < D ? 0 : colg < 2 * D ? 1 : 2); st4bf(d + (size_t)row * D + (colg & (D - 1)), o); }
            else { const int cc = colg - 3 * D, blk = cc >> 7, oo = cc & 127; f32x4 v;
                if (oo < 96) { if (blk & 1) v = o; else { v[0] = tanhf_(o[0]); v[1] = tanhf_(o[1]); v[2] = tanhf_(o[2]); v[3] = tanhf_(o[3]); } }
                else if (blk < 2) { v[0] = sigmoidf_(o[0]); v[1] = sigmoidf_(o[1]); v[2] = sigmoidf_(o[2]); v[3] = sigmoidf_(o[3]); }
                else v = (f32x4){0.f, 0.f, 0.f, 0.f};
                st4bf((bf16_t*)(p.ws + WS_LORAIN) + (size_t)row * LORA_W + cc, v); }
        } else {
            float* d = (float*)(p.ws + WS_CV) + (size_t)(colg >> 11) * (NB * D * CL); const int c0 = colg & (D - 1), b_ = rc >> 8;
#pragma unroll
            for (int e = 0; e < 4; ++e) d[((size_t)(b_ * D + c0 + e)) * CL + t] = o[e];
        }
    }
}

constexpr int SC_CH = 32;
constexpr int SC_NCH = (CL + SEQ) / SC_CH;
constexpr int SC_BUF_F = 6 * SC_CH * 64;
__device__ __forceinline__ int scan_row(int b, int dir, int s) {
    if (s < CL) return TL + b * CL + (dir ? CL - 1 - s : s);
    const int t = s - CL; return b * SEQ + (dir ? SEQ - 1 - t : t);
}
__device__ __forceinline__ void ph_scan(const Params& p, int l, unsigned char* lds_raw) {
    float* lds = (float*)lds_raw;
    float* ybuf = lds + 2 * SC_BUF_F;
    const int tid = p.tid, tl = tid >> 4, jq = tid & 15, ip = tid >> 4;
    for (int unit = p.bid; unit < NB * NHEAD * 2; unit += p.nblk) {
        const int dir = unit & 1, h = (unit >> 1) & (NHEAD - 1), b = unit >> 6;
        const bf16_t* kb = slot(p, 0); const bf16_t* vb = slot(p, 1); const bf16_t* rb = slot(p, 2);
        bf16_t* lw = slot(p, 3 + 2 * dir); const bf16_t* ab = slot(p, 4 + 2 * dir);
        const int col0 = h * HN + 4 * jq;
        const f32x4 kkw = *(const f32x4*)(inp(p, I_KK) + l * D + col0), kaw = *(const f32x4*)(inp(p, I_KA) + l * D + col0);
        float S0[4] = {0.f, 0.f, 0.f, 0.f}, S1[4] = {0.f, 0.f, 0.f, 0.f};
        u32x2 gk, gv, gr, gw, ga;
        auto gload = [&](int c) { const size_t off = (size_t)scan_row(b, dir, c * SC_CH + tl) * D + col0;
            gk = *(const u32x2*)(kb + off); gv = *(const u32x2*)(vb + off); gr = *(const u32x2*)(rb + off); gw = *(const u32x2*)(lw + off); ga = *(const u32x2*)(ab + off); };
        auto gstage = [&](int buf) { float* B = lds + buf * SC_BUF_F + tl * 64 + 4 * jq;
            const f32x4 k4 = (f32x4){bflo(gk.x), bfhi(gk.x), bflo(gk.y), bfhi(gk.y)}, a4 = (f32x4){bflo(ga.x), bfhi(ga.x), bflo(ga.y), bfhi(ga.y)};
            const f32x4 w4 = (f32x4){__expf(bflo(gw.x)), __expf(bfhi(gw.x)), __expf(bflo(gw.y)), __expf(bfhi(gw.y))};
            const f32x4 kx = k4 * kkw; float ss = kx[0] * kx[0] + kx[1] * kx[1] + kx[2] * kx[2] + kx[3] * kx[3]; ss = red16(ss);
            const f32x4 kk = kx * rsqrtf(fmaxf(ss, 1e-24f));
            *(f32x4*)(B) = kk; *(f32x4*)(B + SC_CH * 64) = w4; *(f32x4*)(B + 2 * SC_CH * 64) = kk * a4; *(f32x4*)(B + 3 * SC_CH * 64) = k4 * ((a4 - 1.0f) * kaw + 1.0f);
            *(f32x4*)(B + 4 * SC_CH * 64) = (f32x4){bflo(gr.x), bfhi(gr.x), bflo(gr.y), bfhi(gr.y)}; *(f32x4*)(B + 5 * SC_CH * 64) = (f32x4){bflo(gv.x), bfhi(gv.x), bflo(gv.y), bfhi(gv.y)}; };
        __syncthreads();
        gload(0); gstage(0);
        __syncthreads();
        for (int c = 0; c < SC_NCH; ++c) {
            const int buf = c & 1;
            if (c + 1 < SC_NCH) gload(c + 1);
            if (c > 0) {
                const float* Y = ybuf + (buf ^ 1) * (SC_CH * 64) + tl * 64 + 4 * jq; const f32x4 yv = *(const f32x4*)Y;
                st4bf(lw + (size_t)scan_row(b, dir, (c - 1) * SC_CH + tl) * D + col0, yv); }
            const float* B = lds + buf * SC_BUF_F + 4 * jq; float* Yw = ybuf + buf * (SC_CH * 64);
#pragma unroll 4
            for (int s = 0; s < SC_CH; ++s) {
                const f32x4 kk = *(const f32x4*)(B + s * 64), w = *(const f32x4*)(B + SC_CH * 64 + s * 64), ka = *(const f32x4*)(B + 2 * SC_CH * 64 + s * 64),
                            kt = *(const f32x4*)(B + 3 * SC_CH * 64 + s * 64), rr = *(const f32x4*)(B + 4 * SC_CH * 64 + s * 64);
                const f32x2 vv = *(const f32x2*)(lds + buf * SC_BUF_F + 5 * SC_CH * 64 + s * 64 + 2 * ip);
                float d0 = S0[0] * kk[0] + S0[1] * kk[1] + S0[2] * kk[2] + S0[3] * kk[3];
                float d1 = S1[0] * kk[0] + S1[1] * kk[1] + S1[2] * kk[2] + S1[3] * kk[3];
                d0 = red16(d0); d1 = red16(d1);
#pragma unroll
                for (int e = 0; e < 4; ++e) { S0[e] = S0[e] * w[e] + vv.x * kt[e] - d0 * ka[e]; S1[e] = S1[e] * w[e] + vv.y * kt[e] - d1 * ka[e]; }
                float y0 = S0[0] * rr[0] + S0[1] * rr[1] + S0[2] * rr[2] + S0[3] * rr[3];
                float y1 = S1[0] * rr[0] + S1[1] * rr[1] + S1[2] * rr[2] + S1[3] * rr[3];
                y0 = red16(y0); y1 = red16(y1);
                if (jq == 0) *(f32x2*)(Yw + s * 64 + 2 * ip) = (f32x2){y0, y1};
            }
            if (c + 1 < SC_NCH) gstage(buf ^ 1);
            __syncthreads();
        }
        { const float* Y = ybuf + ((SC_NCH - 1) & 1) * (SC_CH * 64) + tl * 64 + 4 * jq; const f32x4 yv = *(const f32x4*)Y;
          st4bf(lw + (size_t)scan_row(b, dir, (SC_NCH - 1) * SC_CH + tl) * D + col0, yv); }
    }
}

__device__ __forceinline__ void ph_rwkv_out(const Params& p, int l, int M, unsigned char* lds_raw) {
    constexpr int RB = 8;
    float* sb = (float*)lds_raw;
    const int tid = p.tid, col = 4 * tid;
    const f32x4 lnw = *(const f32x4*)(inp(p, I_LNW) + l * D + col), lnb = *(const f32x4*)(inp(p, I_LNB) + l * D + col), rk = *(const f32x4*)(inp(p, I_RK) + l * D + col);
    const float* g2 = inp(p, I_G2) + (size_t)l * 64 * D;
    const bf16_t* kb = slot(p, 0); const bf16_t* vb = slot(p, 1); const bf16_t* rb = slot(p, 2); const bf16_t* yf = slot(p, 3); const bf16_t* yb = slot(p, 5);
    const bf16_t* lora = (const bf16_t*)(p.ws + WS_LORAIN); bf16_t* out = slot(p, 6);
    for (int row0 = p.bid * RB; row0 < M; row0 += p.nblk * RB) {
        __syncthreads();
        { const int r = tid >> 6, i = tid & 63; sb[i * RB + r] = bf2f(lora[(size_t)(row0 + r) * LORA_W + (i < 32 ? 96 + i : 224 + (i - 32))]); }
        __syncthreads();
        f32x4 g[RB];
#pragma unroll
        for (int r = 0; r < RB; ++r) g[r] = (f32x4){0.f, 0.f, 0.f, 0.f};
#pragma unroll 1
        for (int ib = 0; ib < 64; ib += 16) {
            f32x4 w[16];
#pragma unroll
            for (int i = 0; i < 16; ++i) w[i] = *(const f32x4*)(g2 + (size_t)(ib + i) * D + col);
#pragma unroll
            for (int i = 0; i < 16; ++i) { const f32x4 s0 = *(const f32x4*)(sb + (ib + i) * RB), s1 = *(const f32x4*)(sb + (ib + i) * RB + 4);
#pragma unroll
                for (int r = 0; r < 4; ++r) { g[r] += w[i] * s0[r]; g[4 + r] += w[i] * s1[r]; } } }
        u32x2 ya[RB], yb2[RB], kk2[RB], vv2[RB], rr2[RB];
#pragma unroll
        for (int r = 0; r < RB; ++r) { const size_t off = (size_t)(row0 + r) * D + col;
            ya[r] = *(const u32x2*)(yf + off); yb2[r] = *(const u32x2*)(yb + off); kk2[r] = *(const u32x2*)(kb + off); vv2[r] = *(const u32x2*)(vb + off); rr2[r] = *(const u32x2*)(rb + off); }
#pragma unroll
        for (int r = 0; r < RB; ++r) {
            const size_t off = (size_t)(row0 + r) * D + col;
            const u32x2 a = ya[r], b = yb2[r], k2 = kk2[r], v2 = vv2[r], r2 = rr2[r];
            const f32x4 y = (f32x4){bflo(a.x) + bflo(b.x), bfhi(a.x) + bfhi(b.x), bflo(a.y) + bflo(b.y), bfhi(a.y) + bfhi(b.y)};
            const f32x4 k4 = (f32x4){bflo(k2.x), bfhi(k2.x), bflo(k2.y), bfhi(k2.y)}, v4 = (f32x4){bflo(v2.x), bfhi(v2.x), bflo(v2.y), bfhi(v2.y)}, r4 = (f32x4){bflo(r2.x), bfhi(r2.x), bflo(r2.y), bfhi(r2.y)};
            const float mu = red16(y[0] + y[1] + y[2] + y[3]) * (1.0f / HN);
            const f32x4 dy = y - mu;
            const float var = red16(dy[0] * dy[0] + dy[1] * dy[1] + dy[2] * dy[2] + dy[3] * dy[3]) * (1.0f / HN);
            const f32x4 yn = dy * rsqrtf(var + GN_EPS) * lnw + lnb;
            const f32x4 rkk = r4 * k4 * rk;
            const float bon = red16(rkk[0] + rkk[1] + rkk[2] + rkk[3]);
            st4bf(out + off, (yn + v4 * bon) * g[r]);
        }
    }
}

constexpr int S3_NS = 5, S3_NCH = (CL + SEQ) / 16;
constexpr int S3_SLOT = 18432;
constexpr int S3_OXQ1 = 0, S3_OXY = 3328, S3_OKAP = 6656, S3_OVU = 11776, S3_OTX = 16896, S3_OG = 18176;
constexpr int S3_PSCR = 8192;
constexpr int S3_OAL = 0, S3_OKH = 2304, S3_OAF = 4608, S3_ORN = 5632;
constexpr int S3_CSCR = 3584;
constexpr int S3_RING = 0, S3_PBASE = S3_RING + S3_NS * S3_SLOT, S3_CBASE = S3_PBASE + 4 * S3_PSCR, S3_FLAGS = S3_CBASE + 4 * S3_CSCR, S3_END = S3_FLAGS + 64;
static_assert(S3_END <= LDS_BYTES - 64, "scan LDS layout");
constexpr unsigned S3_SPIN_CAP = 1u << 22;
typedef short bf16x8_t __attribute__((ext_vector_type(8)));
__device__ __forceinline__ bf16x8_t ldfrag(const bf16_t* p) { return *(const bf16x8_t*)p; }
__device__ __forceinline__ f32x4 mma(const bf16x8_t a, const bf16x8_t b, const f32x4 c) { return __builtin_amdgcn_mfma_f32_16x16x32_bf16(a, b, c, 0, 0, 0); }
__device__ __forceinline__ bf16_t cvbf(float x) { return (bf16_t)(pg8::cvt_pk_bf16(x, 0.f) & 0xFFFFu); }
#define S3_LGKM() asm volatile("s_waitcnt lgkmcnt(0)" ::: "memory")
__device__ __forceinline__ void ph_scan3(const Params& p, int l, unsigned char* lds) {
    const int tid = p.tid, lane = tid & 63, wid = __builtin_amdgcn_readfirstlane(tid >> 6), fr = lane & 15, fq = lane >> 4;
    LAS unsigned* flags = (LAS unsigned*)(lds + S3_FLAGS);
#define S3_FLD(i) __hip_atomic_load(flags + (i), __ATOMIC_RELAXED, __HIP_MEMORY_SCOPE_WORKGROUP)
#define S3_FST(i, v) __hip_atomic_store(flags + (i), (v), __ATOMIC_RELAXED, __HIP_MEMORY_SCOPE_WORKGROUP)
    const bf16_t* kb = slot(p, 0); const bf16_t* vb = slot(p, 1); const bf16_t* rb = slot(p, 2);
    const f32x4 zero4 = (f32x4){0.f, 0.f, 0.f, 0.f};
    for (int unit = p.bid; unit < NB * NHEAD * 2; unit += p.nblk) {
        const int dir = unit & 1, h = (unit >> 1) & (NHEAD - 1), b = unit >> 6;
        bf16_t* lwy = slot(p, 3 + 2 * dir); const bf16_t* ab = slot(p, 4 + 2 * dir);
        const long rstride = dir ? -(long)D : (long)D;
        __syncthreads();
        for (int i = tid; i < S3_END / 4; i += NTHREADS) ((unsigned*)lds)[i] = 0u;
        __syncthreads();
        if (wid >= 4) {
            const int pw = wid - 4;
            unsigned char* scr = lds + S3_PBASE + pw * S3_PSCR;
            bf16_t* AL = (bf16_t*)(scr + S3_OAL); bf16_t* KH = (bf16_t*)(scr + S3_OKH); float* AF = (float*)(scr + S3_OAF); float* RN = (float*)(scr + S3_ORN);
            const float kkj = inp(p, I_KK)[l * D + h * HN + lane], kaj = inp(p, I_KA)[l * D + h * HN + lane];
            const int rt = lane >> 2, rp = lane & 3;
            const float* kkp = inp(p, I_KK) + l * D + h * HN + 16 * rp;
            const f32x4 kc0 = *(const f32x4*)kkp, kc1 = *(const f32x4*)(kkp + 4), kc2 = *(const f32x4*)(kkp + 8), kc3 = *(const f32x4*)(kkp + 12);
            typedef unsigned short u16x2 __attribute__((ext_vector_type(2)));
            u16x2 kq[8], rq[8], lq[8], aq[8], vq[8]; u32x4 kn0, kn1;
#define S3_FETCH(cc, K_, R_, L_, A_, V_, N0_, N1_) do { const size_t o_ = (size_t)scan_row(b, dir, 16 * (cc)) * D + h * HN; \
                const bf16_t* kp_ = kb + o_ + lane; const bf16_t* rp_ = rb + o_ + lane; const bf16_t* lp_ = lwy + o_ + lane; const bf16_t* ap_ = ab + o_ + lane; const bf16_t* vp_ = vb + o_ + lane; \
                _Pragma("unroll") for (int t = 0; t < 16; ++t) { K_[t >> 1][t & 1] = *kp_; R_[t >> 1][t & 1] = *rp_; L_[t >> 1][t & 1] = *lp_; A_[t >> 1][t & 1] = *ap_; V_[t >> 1][t & 1] = *vp_; kp_ += rstride; rp_ += rstride; lp_ += rstride; ap_ += rstride; vp_ += rstride; } \
                const bf16_t* kr_ = kb + o_ + (long)rt * rstride + 16 * rp; N0_ = *(const u32x4*)kr_; N1_ = *(const u32x4*)(kr_ + 8); } while (0)
            S3_FETCH(pw, kq, rq, lq, aq, vq, kn0, kn1);
#pragma unroll 1
            for (int c = pw; c < S3_NCH; c += 4) {
                const int sl = c % S3_NS; unsigned char* sb = lds + S3_RING + sl * S3_SLOT;
                bf16_t* XQ1 = (bf16_t*)(sb + S3_OXQ1); bf16_t* XY = (bf16_t*)(sb + S3_OXY); bf16_t* KAP = (bf16_t*)(sb + S3_OKAP); bf16_t* VU = (bf16_t*)(sb + S3_OVU); bf16_t* TX = (bf16_t*)(sb + S3_OTX); float* G = (float*)(sb + S3_OG);
                u16x2 kq2[8], rq2[8], lq2[8], aq2[8], vq2[8]; u32x4 kn2, kn3;
                { const int cn = c + 4 < S3_NCH ? c + 4 : c; S3_FETCH(cn, kq2, rq2, lq2, aq2, vq2, kn2, kn3); }
                { const u32x4 w0 = kn0, w1 = kn1;
                  const float x0 = bflo(w0[0]) * kc0[0], x1 = bfhi(w0[0]) * kc0[1], x2 = bflo(w0[1]) * kc0[2], x3 = bfhi(w0[1]) * kc0[3], x4 = bflo(w0[2]) * kc1[0], x5 = bfhi(w0[2]) * kc1[1], x6 = bflo(w0[3]) * kc1[2], x7 = bfhi(w0[3]) * kc1[3];
                  const float y0 = bflo(w1[0]) * kc2[0], y1 = bfhi(w1[0]) * kc2[1], y2 = bflo(w1[1]) * kc2[2], y3 = bfhi(w1[1]) * kc2[3], y4 = bflo(w1[2]) * kc3[0], y5 = bfhi(w1[2]) * kc3[1], y6 = bflo(w1[3]) * kc3[2], y7 = bfhi(w1[3]) * kc3[3];
                  float ss = x0 * x0 + x1 * x1 + x2 * x2 + x3 * x3 + x4 * x4 + x5 * x5 + x6 * x6 + x7 * x7 + y0 * y0 + y1 * y1 + y2 * y2 + y3 * y3 + y4 * y4 + y5 * y5 + y6 * y6 + y7 * y7;
                  ss += dppf<0xB1>(ss); ss += dppf<0x4E>(ss);
                  if (rp == 0) RN[rt] = rsqrtf(fmaxf(ss, 1e-24f)); }
                if (c >= S3_NS) { const unsigned need = (unsigned)(c - S3_NS + 1); unsigned sp = 0;
                    for (;;) { const unsigned m0 = S3_FLD(8), m1 = S3_FLD(9), m2 = S3_FLD(10), m3 = S3_FLD(11); const unsigned mn = min(min(m0, m1), min(m2, m3));
                        if (mn >= need || ++sp > S3_SPIN_CAP) break; __builtin_amdgcn_s_sleep(1); } }
                asm volatile("" ::: "memory");
                S3_LGKM();
                { float cl[16]; float run = 0.f;
#pragma unroll
                  for (int t = 0; t < 16; ++t) { run += bf2f(lq[t >> 1][t & 1]); cl[t] = run; }
                  const float cend = cl[15], gend = __expf(cend); G[lane] = gend;
                  unsigned kp[8], ap[8], vv[8]; float epm1 = 1.0f;
#pragma unroll
                  for (int t = 0; t < 16; ++t) {
                      const float em = __expf(-cl[t]), ep = __builtin_amdgcn_rcpf(em), ee = gend * em;
                      const float kv = bf2f(kq[t >> 1][t & 1]), a = bf2f(aq[t >> 1][t & 1]), kap = kv * kkj * RN[t], al = a * kap, kt = kv * (1.0f + (a - 1.0f) * kaj);
                      XQ1[t * 104 + lane] = cvbf(epm1 * kap); AL[t * 72 + lane] = cvbf(al * em); KH[t * 72 + lane] = cvbf(kt * em); XY[t * 104 + lane] = cvbf(bf2f(rq[t >> 1][t & 1]) * ep);
                      const unsigned kpb = cvbf(kt * ee), apb = cvbf(al * ee);
                      if (t & 1) { kp[t >> 1] |= kpb << 16; ap[t >> 1] |= apb << 16; } else { kp[t >> 1] = kpb; ap[t >> 1] = apb; vv[t >> 1] = __builtin_bit_cast(unsigned, vq[t >> 1]); }
                      epm1 = ep; }
                  u32x4* d = (u32x4*)(KAP + lane * 40);
                  d[0] = (u32x4){kp[0], kp[1], kp[2], kp[3]}; d[1] = (u32x4){kp[4], kp[5], kp[6], kp[7]}; d[2] = (u32x4){ap[0], ap[1], ap[2], ap[3]}; d[3] = (u32x4){ap[4], ap[5], ap[6], ap[7]};
                  u32x4* dv = (u32x4*)(VU + lane * 40); dv[0] = (u32x4){vv[0], vv[1], vv[2], vv[3]}; dv[1] = (u32x4){vv[4], vv[5], vv[6], vv[7]}; }
                S3_LGKM();
                { const bf16_t* Xk = XQ1 + fr * 104 + 8 * fq; const bf16_t* Xr = XY + fr * 104 + 8 * fq; const bf16_t* Ya = AL + fr * 72 + 8 * fq; const bf16_t* Yk = KH + fr * 72 + 8 * fq;
                  f32x4 dA = zero4, dB = zero4, dE = zero4, dF = zero4;
#pragma unroll
                  for (int ks = 0; ks < 2; ++ks) { const bf16x8_t xk = ldfrag(Xk + 32 * ks), xr = ldfrag(Xr + 32 * ks), ya = ldfrag(Ya + 32 * ks), yk = ldfrag(Yk + 32 * ks);
                      dA = mma(xk, ya, dA); dB = mma(xk, yk, dB); dE = mma(xr, yk, dE); dF = mma(xr, ya, dF); }
#pragma unroll
                  for (int e = 0; e < 4; ++e) { const int t = 4 * fq + e; const bool lo = fr < t, le = fr <= t;
                      dA[e] = lo ? dA[e] : 0.f; XQ1[t * 104 + 64 + fr] = cvbf(lo ? dB[e] : 0.f); XY[t * 104 + 64 + fr] = cvbf(le ? dE[e] : 0.f); XY[t * 104 + 80 + fr] = cvbf(le ? dF[e] : 0.f); }
                  float tc[16];
#pragma unroll
                  for (int t = 0; t < 16; ++t) { float v0 = (t == fr) ? 1.0f : 0.0f, v1 = 0.f;
#pragma unroll
                      for (int s = 0; s < t; ++s) { const float a = rdlane(dA[t & 3], 16 * (t >> 2) + s); if (s & 1) v1 -= a * tc[s]; else v0 -= a * tc[s]; }
                      tc[t] = v0 + v1; }
                  if (fq == 0) {
#pragma unroll
                      for (int t = 0; t < 16; ++t) TX[t * 40 + fr] = cvbf(tc[t]); } }
                S3_LGKM();
                if (lane == 0) S3_FST(sl, (unsigned)(c + 1));
#pragma unroll
                for (int t = 0; t < 8; ++t) { kq[t] = kq2[t]; rq[t] = rq2[t]; lq[t] = lq2[t]; aq[t] = aq2[t]; vq[t] = vq2[t]; }
                kn0 = kn2; kn1 = kn3;
            }
#undef S3_FETCH
        } else {
            const int it = wid;
            unsigned char* scr = lds + S3_CBASE + it * S3_CSCR;
            bf16_t* SB = (bf16_t*)scr; bf16_t* RT = (bf16_t*)(scr + 2304);
            f32x4 Sacc[4] = {zero4, zero4, zero4, zero4};
#pragma unroll 1
            for (int c = 0; c < S3_NCH; ++c) {
                const int sl = c % S3_NS; unsigned char* sb = lds + S3_RING + sl * S3_SLOT;
                const bf16_t* XQ1 = (const bf16_t*)(sb + S3_OXQ1); const bf16_t* XY = (const bf16_t*)(sb + S3_OXY); const bf16_t* KAP = (const bf16_t*)(sb + S3_OKAP); bf16_t* VU = (bf16_t*)(sb + S3_OVU); const bf16_t* TX = (const bf16_t*)(sb + S3_OTX); const float* G = (const float*)(sb + S3_OG);
                { unsigned sp = 0; while (S3_FLD(sl) != (unsigned)(c + 1)) { if (++sp > S3_SPIN_CAP) break; __builtin_amdgcn_s_sleep(1); } }
                asm volatile("" ::: "memory");
                const bf16_t* Ys = SB + fr * 72 + 8 * fq; bf16_t* VUr = VU + (16 * it + fr) * 40;
                { const bf16_t* X = XQ1 + fr * 104 + 8 * fq;
                  f32x4 d = mma(ldfrag(X), ldfrag(Ys), zero4); d = mma(ldfrag(X + 32), ldfrag(Ys + 32), d); d = mma(ldfrag(X + 64), ldfrag(VUr + 8 * fq), d);
                  *(u32x2*)(RT + fr * 40 + 4 * fq) = (u32x2){pg8::cvt_pk_bf16(d[0], d[1]), pg8::cvt_pk_bf16(d[2], d[3])}; }
                S3_LGKM();
                { const f32x4 d = mma(ldfrag(TX + fr * 40 + 8 * fq), ldfrag(RT + fr * 40 + 8 * fq), zero4);
                  *(u32x2*)(VUr + 16 + 4 * fq) = (u32x2){pg8::cvt_pk_bf16(-d[0], -d[1]), pg8::cvt_pk_bf16(-d[2], -d[3])}; }
                S3_LGKM();
                const bf16x8_t vu = ldfrag(VUr + 8 * fq);
                { const bf16_t* X = XY + fr * 104 + 8 * fq;
                  f32x4 d = mma(ldfrag(X), ldfrag(Ys), zero4); d = mma(ldfrag(X + 32), ldfrag(Ys + 32), d); d = mma(ldfrag(X + 64), vu, d);
                  bf16_t* yo = lwy + (size_t)scan_row(b, dir, 16 * c + 4 * fq) * D + h * HN + 16 * it + fr;
#pragma unroll
                  for (int e = 0; e < 4; ++e) { *yo = cvbf(d[e]); yo += rstride; } }
#pragma unroll
                for (int jt = 0; jt < 4; ++jt) Sacc[jt] = mma(vu, ldfrag(KAP + (16 * jt + fr) * 40 + 8 * fq), Sacc[jt] * G[16 * jt + fr]);
#pragma unroll
                for (int jt = 0; jt < 4; ++jt)
#pragma unroll
                    for (int e = 0; e < 4; ++e) SB[(4 * fq + e) * 72 + 16 * jt + fr] = cvbf(Sacc[jt][e]);
                S3_LGKM();
                if (lane == 0) S3_FST(8 + it, (unsigned)(c + 1));
            }
        }
    }
    __syncthreads();
}

__device__ __forceinline__ float hy_delta(int c) { return 3.0701134573f + (float)c * ((15.3505672866f - 3.0701134573f) / 2047.0f); }
__device__ __forceinline__ void ph_ctxfilter(const Params& p, int l) {
    const bf16_t* hd = (const bf16_t*)(p.ws + WS_HDNC); const float* w3 = inp(p, I_HW3) + (size_t)l * 64 * 8192; float* hcf = (float*)(p.ws + WS_HCF);
    const int gt = p.bid * NTHREADS + p.tid, GT = p.nblk * NTHREADS;
    if (GT % 8192 == 0) {
        const int col = gt % 8192; float wc[64];
#pragma unroll
        for (int k = 0; k < 64; ++k) wc[k] = w3[(size_t)k * 8192 + col];
        const float dl = hy_delta(col & (D - 1));
        for (int n = gt / 8192; n < CL; n += GT / 8192) { u32x4 hv[8];
#pragma unroll
            for (int k8 = 0; k8 < 8; ++k8) hv[k8] = *(const u32x4*)(hd + n * 256 + 8 * k8);
            float s = 0.f;
#pragma unroll
            for (int k8 = 0; k8 < 8; ++k8)
#pragma unroll
                for (int e = 0; e < 4; ++e) s += bflo(hv[k8][e]) * wc[8 * k8 + 2 * e] + bfhi(hv[k8][e]) * wc[8 * k8 + 2 * e + 1];
            hcf[(size_t)col * CL + n] = s * __expf(-((float)n / (float)(CL - 1)) * dl); }
    } else {
        for (int i = gt; i < 8192 * CL; i += GT) {
            const int col = i % 8192, n = i / 8192; float s = 0.f;
            for (int k = 0; k < 64; ++k) s += bf2f(hd[n * 256 + k]) * w3[(size_t)k * 8192 + col];
            hcf[(size_t)col * CL + n] = s * __expf(-((float)n / (float)(CL - 1)) * hy_delta(col & (D - 1))); }
    }
}
__device__ __forceinline__ void ph_ctxhyena(const Params& p, int l, unsigned char* lds_raw) {
    const int lane = p.tid & 63, wid = p.tid >> 6, wv = p.bid * 8 + wid, NW = p.nblk * 8;
    float* L = (float*)lds_raw + wid * 768;
    const float* hcf = (const float*)(p.ws + WS_HCF); const float* cv = (const float*)(p.ws + WS_CV); float* yhc = (float*)(p.ws + WS_YHC);
    for (int u = wv; u < NB * D; u += NW) {
        const int c = u & (D - 1), b = u >> 11;
        f32x4 z = *(const f32x4*)(cv + ((size_t)(b * D + c)) * CL + 4 * lane);
#pragma unroll
        for (int o = 0; o < 2; ++o) {
            const f32x4 f = *(const f32x4*)(hcf + ((size_t)((o * 2 + 0) * D + c)) * CL + 4 * lane), g = *(const f32x4*)(hcf + ((size_t)((o * 2 + 1) * D + c)) * CL + 4 * lane);
            float ss = 0.f;
#pragma unroll
            for (int i = 0; i < 4; ++i) { const int n = 4 * lane + i; if (n == 0) L[256 + 255] = f[i] + g[i]; else { L[256 + 255 - n] = f[i]; L[256 + 255 + n] = g[i]; } ss += f[i] * f[i] + g[i] * g[i]; }
            *(f32x4*)(L + 4 * lane) = z;
            ss = wave_sum(ss); const float rn = rsqrtf(ss);
            const float sk = inp(p, I_HSKIP)[(l * 2 + o) * D + c];
            const float* gate = cv + (size_t)(o + 1) * (NB * D * CL) + ((size_t)(b * D + c)) * CL;
            f32x4 acc = (f32x4){0.f, 0.f, 0.f, 0.f};
            const float* hb = L + 256 + 252 - 4 * lane;
#pragma unroll 4
            for (int s0 = 0; s0 < CL; s0 += 4) { const f32x4 us = *(const f32x4*)(L + s0), wa = *(const f32x4*)(hb + s0), wb = *(const f32x4*)(hb + s0 + 4);
                const float W[8] = {wa[0], wa[1], wa[2], wa[3], wb[0], wb[1], wb[2], wb[3]};
#pragma unroll
                for (int i = 0; i < 4; ++i)
#pragma unroll
                    for (int q = 0; q < 4; ++q) acc[i] += W[3 - i + q] * us[q]; }
            const f32x4 gt = *(const f32x4*)(gate + 4 * lane);
            z = gt * (acc * rn + z * sk);
        }
        *(f32x4*)(yhc + ((size_t)(b * D + c)) * CL + 4 * lane) = z;
    }
}

__device__ __forceinline__ f32x2 cmul(const f32x2 a, const f32x2 b) {
    const f32x2 t = a * __builtin_shufflevector(b, b, 0, 0);
    return __builtin_elementwise_fma(__builtin_shufflevector(a, a, 1, 0), (f32x2){-b.y, b.y}, t); }
__device__ __forceinline__ f32x2 cconj(const f32x2 a) { return (f32x2){a.x, -a.y}; }
template <bool INV> __device__ __forceinline__ void dft4(f32x2& a, f32x2& b, f32x2& c, f32x2& d) {
    const f32x2 s0 = a + c, s1 = a - c, s2 = b + d, s3 = b - d;
    const f32x2 r = __builtin_shufflevector(s3, s3, 1, 0); const f32x2 sg = INV ? (f32x2){-1.f, 1.f} : (f32x2){1.f, -1.f};
    a = s0 + s2; c = s0 - s2; b = __builtin_elementwise_fma(r, sg, s1); d = __builtin_elementwise_fma(r, -sg, s1);
}
template <bool INV> __device__ __forceinline__ void dft16(f32x2 (&x)[16]) {
    constexpr float C[10] = {1.f, 0.92387953251f, 0.70710678119f, 0.38268343237f, 0.f, 0.f, -0.70710678119f, 0.f, 0.f, -0.92387953251f};
    constexpr float S[10] = {0.f, 0.38268343237f, 0.70710678119f, 0.92387953251f, 1.f, 0.f, 0.70710678119f, 0.f, 0.f, -0.38268343237f};
#pragma unroll
    for (int n1 = 0; n1 < 4; ++n1) dft4<INV>(x[n1], x[n1 + 4], x[n1 + 8], x[n1 + 12]);
#pragma unroll
    for (int n1 = 1; n1 < 4; ++n1)
#pragma unroll
        for (int k2 = 1; k2 < 4; ++k2) { const int m = n1 * k2; x[n1 + 4 * k2] = cmul(x[n1 + 4 * k2], (f32x2){C[m], INV ? S[m] : -S[m]}); }
#pragma unroll
    for (int k2 = 0; k2 < 4; ++k2) dft4<INV>(x[4 * k2], x[4 * k2 + 1], x[4 * k2 + 2], x[4 * k2 + 3]);
    f32x2 y[16];
#pragma unroll
    for (int k1 = 0; k1 < 4; ++k1)
#pragma unroll
        for (int k2 = 0; k2 < 4; ++k2) y[4 * k1 + k2] = x[4 * k2 + k1];
#pragma unroll
    for (int k = 0; k < 16; ++k) x[k] = y[k];
}
__device__ __forceinline__ int zpad(int pidx) { return pidx + 2 * (pidx >> 4); }
constexpr int ZN = 18432;

__device__ __forceinline__ f32x2 twf(int j) { float x = (float)j * (1.0f / 32768.0f); asm volatile("" : "+v"(x));
    return (f32x2){__builtin_amdgcn_cosf(x), -__builtin_amdgcn_sinf(x)}; }
struct HyRaw { f32x2 a, b, c; unsigned w; unsigned short s0, s1, s2, s3; };
template <bool INV> __device__ __forceinline__ void dft32(f32x2 (&x)[32]) {
    constexpr float C[16] = {1.f, 0.98078528040f, 0.92387953251f, 0.83146961230f, 0.70710678119f, 0.55557023302f, 0.38268343237f, 0.19509032202f,
                             0.f, -0.19509032202f, -0.38268343237f, -0.55557023302f, -0.70710678119f, -0.83146961230f, -0.92387953251f, -0.98078528040f};
    constexpr float S[16] = {0.f, 0.19509032202f, 0.38268343237f, 0.55557023302f, 0.70710678119f, 0.83146961230f, 0.92387953251f, 0.98078528040f,
                             1.f, 0.98078528040f, 0.92387953251f, 0.83146961230f, 0.70710678119f, 0.55557023302f, 0.38268343237f, 0.19509032202f};
    f32x2 e[16], o[16];
#pragma unroll
    for (int k = 0; k < 16; ++k) { e[k] = x[2 * k]; o[k] = x[2 * k + 1]; }
    __builtin_amdgcn_sched_barrier(0); dft16<INV>(e); __builtin_amdgcn_sched_barrier(0); dft16<INV>(o); __builtin_amdgcn_sched_barrier(0);
#pragma unroll
    for (int k = 0; k < 16; ++k) { const f32x2 t = cmul(o[k], (f32x2){C[k], INV ? S[k] : -S[k]}); x[k] = e[k] + t; x[k + 16] = e[k] - t; }
}
template <class Ld, class Mk> __device__ __forceinline__ void fft_fwdA(f32x2* Z, int tid, Ld ld, Mk mk) {
    __syncthreads();
    asm volatile("" : "+v"(tid));
    f32x2 x[32];
#pragma unroll
    for (int h = 0; h < 2; ++h) { HyRaw raw[16];
#pragma unroll
      for (int i = 0; i < 16; ++i) raw[i] = ld((16 * h + i) * 512 + tid);
#pragma unroll
      for (int i = 0; i < 16; ++i) x[16 * h + i] = mk((16 * h + i) * 512 + tid, raw[i]);
      __builtin_amdgcn_sched_barrier(0); }
    dft32<false>(x);
    const f32x2 w1 = twf(2 * tid); f32x2 wk = w1;
    Z[zpad(tid)] = x[0];
#pragma unroll
    for (int k = 1; k < 32; ++k) { Z[zpad(k * 512 + tid)] = cmul(x[k], wk); wk = cmul(wk, w1); }
    __syncthreads();
}
__device__ __forceinline__ void fft_fwdB(f32x2* Z, int tid) {
    asm volatile("" : "+v"(tid));
    const int blk = tid >> 4, n2 = tid & 15, base = blk * 512 + n2;
    const f32x2 w1 = twf(64 * n2);
    f32x2 x[32];
#pragma unroll
    for (int n1 = 0; n1 < 32; ++n1) x[n1] = Z[zpad(base + n1 * 16)];
    dft32<false>(x);
    f32x2 wk = w1;
    Z[zpad(base)] = x[0];
#pragma unroll
    for (int k = 1; k < 32; ++k) { Z[zpad(base + k * 16)] = cmul(x[k], wk); wk = cmul(wk, w1); }
    __syncthreads();
}
__device__ __forceinline__ void fft_invB(f32x2* Z, int tid) {
    asm volatile("" : "+v"(tid));
    const int blk = tid >> 4, n2 = tid & 15, base = blk * 512 + n2;
    const f32x2 w1 = cconj(twf(64 * n2)); f32x2 wk = w1;
    f32x2 x[32];
    x[0] = Z[zpad(base)];
#pragma unroll
    for (int k = 1; k < 32; ++k) { x[k] = cmul(Z[zpad(base + k * 16)], wk); wk = cmul(wk, w1); }
    dft32<true>(x);
#pragma unroll
    for (int n1 = 0; n1 < 32; ++n1) Z[zpad(base + n1 * 16)] = x[n1];
    __syncthreads();
}
__device__ __forceinline__ unsigned cpk(const f32x2 v) { return pg8::cvt_pk_bf16(v.x, v.y); }
__device__ __forceinline__ f32x2 cunpk(unsigned w) { return (f32x2){bflo(w), bfhi(w)}; }
__device__ __forceinline__ void fft_fwd_rest_to_stash(f32x2* Z, int tid, unsigned (&g)[32]) {
    fft_fwdB(Z, tid);
    asm volatile("" : "+v"(tid));
#pragma unroll
    for (int j = 0; j < 2; ++j) { const int q = tid + 512 * j; f32x2 x[16];
#pragma unroll
        for (int n1 = 0; n1 < 16; ++n1) x[n1] = Z[18 * q + n1];
        dft16<false>(x);
#pragma unroll
        for (int k = 0; k < 16; ++k) g[j * 16 + k] = cpk(x[k]);
        __builtin_amdgcn_sched_barrier(0); }
}
template <class Ld, class Out> __device__ __forceinline__ void fft_conv_rest(f32x2* Z, int tid, const unsigned (&g)[32], Ld ld, Out out) {
    fft_fwdB(Z, tid);
    asm volatile("" : "+v"(tid));
#pragma unroll
    for (int j = 0; j < 2; ++j) { const int q = tid + 512 * j; f32x2 x[16];
#pragma unroll
        for (int n1 = 0; n1 < 16; ++n1) x[n1] = Z[18 * q + n1];
        dft16<false>(x);
#pragma unroll
        for (int k = 0; k < 16; ++k) x[k] = cmul(x[k], cunpk(g[j * 16 + k]));
        dft16<true>(x);
#pragma unroll
        for (int n1 = 0; n1 < 16; ++n1) Z[18 * q + n1] = x[n1];
        __builtin_amdgcn_sched_barrier(0); }
    __syncthreads();
    fft_invB(Z, tid);
    asm volatile("" : "+v"(tid));
    { const f32x2 w1 = cconj(twf(2 * tid)); f32x2 wk = w1; f32x2 x[32];
      x[0] = Z[zpad(tid)];
#pragma unroll
      for (int k = 1; k < 32; ++k) { x[k] = cmul(Z[zpad(k * 512 + tid)], wk); wk = cmul(wk, w1); }
      dft32<true>(x);
#pragma unroll
      for (int h = 0; h < 4; ++h) { HyRaw raw[8];
#pragma unroll
          for (int i = 0; i < 8; ++i) raw[i] = ld((8 * h + i) * 512 + tid);
#pragma unroll
          for (int i = 0; i < 8; ++i) out(8 * h + i, (8 * h + i) * 512 + tid, x[8 * h + i], raw[i]);
          __builtin_amdgcn_sched_barrier(0); } }
}

template <int O> __device__ __forceinline__ void hy_order(const Params& p, int l, int c, f32x2* Z, float* red, const f32x2* tw, int tid, const bf16_t* Ht, bf16_t* hv, const bf16_t* gate, unsigned* zs) {
    unsigned gs[32];
    const float delta = hy_delta(c);
    const size_t cb0 = ((size_t)(0 * D + c)) * SEQ, cb1 = ((size_t)(1 * D + c)) * SEQ;
    const bf16_t* fw = Ht + ((size_t)((O * 2 + 0) * D + c)) * SEQ; const bf16_t* bw = Ht + ((size_t)((O * 2 + 1) * D + c)) * SEQ;
    float ssq = 0.f;
    auto ld_filt = [=](int n) { HyRaw r{}; const int nb = n == 0 ? 0 : SEQ - n; r.s0 = fw[n]; r.s1 = bw[nb]; return r; };

    auto ld_z = [=](int n) { HyRaw r{}; if (O == 0) { r.s0 = hv[cb0 + n]; r.s1 = hv[cb1 + n]; } else r.w = zs[n]; return r; };

    auto zval = [=](const HyRaw& r) { return O == 0 ? (f32x2){bf2f(r.s0), bf2f(r.s1)} : cunpk(r.w); };
    fft_fwdA(Z, tid, ld_filt, [&](int n, const HyRaw& r) { const int nb = n == 0 ? 0 : SEQ - n;
        const float f = bf2f(r.s0) * __expf(-((float)n * (1.0f / (SEQ - 1))) * delta), g = bf2f(r.s1) * __expf(-((float)nb * (1.0f / (SEQ - 1))) * delta);
        ssq += f * f + g * g; return (f32x2){f + g, 0.f}; });
    fft_fwd_rest_to_stash(Z, tid, gs);
    ssq = wave_sum(ssq); if ((tid & 63) == 0) red[tid >> 6] = ssq;
    fft_fwdA(Z, tid, ld_z, [=](int, const HyRaw& r) { return zval(r); });
    float tot = 0.f;
#pragma unroll
    for (int w = 0; w < 8; ++w) tot += red[w];
    const float scale = 0.5f * (1.0f / SEQ) * rsqrtf(tot);
    unsigned rsv[32];
    fft_conv_rest(Z, tid, gs, [=](int) { return HyRaw{}; }, [&](int i, int, f32x2 val, const HyRaw&) { rsv[i] = cpk(val * scale); });
    fft_fwdA(Z, tid, ld_filt, [=](int n, const HyRaw& r) { const int nb = n == 0 ? 0 : SEQ - n;
        const float f = bf2f(r.s0) * __expf(-((float)n * (1.0f / (SEQ - 1))) * delta), g = bf2f(r.s1) * __expf(-((float)nb * (1.0f / (SEQ - 1))) * delta);
        const float gd = n == 0 ? f + g : f - g; const f32x2 w = twf(n); return (f32x2){gd * w.x, gd * w.y}; });
    fft_fwd_rest_to_stash(Z, tid, gs);
    fft_fwdA(Z, tid, ld_z, [=](int n, const HyRaw& r) { return cmul(zval(r), twf(n)); });
    const float sk = inp(p, I_HSKIP)[(l * 2 + O) * D + c];
    fft_conv_rest(Z, tid, gs,
        [=](int n) { HyRaw r{}; if (O == 0) { r.s0 = hv[cb0 + n]; r.s1 = hv[cb1 + n]; } else r.w = zs[n]; r.s2 = gate[cb0 + n]; r.s3 = gate[cb1 + n]; return r; },
        [&](int i, int n, f32x2 val, const HyRaw& r) {
            const f32x2 cv = cunpk(rsv[i]) + cmul(val, cconj(twf(n))) * scale;
            const f32x2 zz = zval(r);
            const f32x2 res = (f32x2){bf2f(r.s2) * (cv.x + zz.x * sk), bf2f(r.s3) * (cv.y + zz.y * sk)};
            if (O == 0) zs[n] = cpk(res); else { hv[cb0 + n] = f2bf(res.x); hv[cb1 + n] = f2bf(res.y); } });
}

__device__ __forceinline__ void ph_hyena(const Params& p, int l, unsigned char* lds_raw) {
    f32x2* Z = (f32x2*)lds_raw; float* red = (float*)(lds_raw + (size_t)ZN * 8);
    const f32x2* tw = (const f32x2*)(p.ws + WS_TW);
    const int tid = p.tid;
    const bf16_t* Ht = (const bf16_t*)slot(p, 3);
    bf16_t* hv = slot(p, 0); const bf16_t* hx1 = slot(p, 1); const bf16_t* hx2 = slot(p, 2);
    unsigned* zs = (unsigned*)slot(p, 5) + (size_t)p.bid * SEQ;
#pragma unroll 1
    for (int c = p.bid; c < D; c += p.nblk) {
        hy_order<0>(p, l, c, Z, red, tw, tid, Ht, hv, hx1, zs);
        hy_order<1>(p, l, c, Z, red, tw, tid, Ht, hv, hx2, zs);
    }
}

constexpr float PEER_USCALE = 128.0f, PEER_VSCALE = 8.0f;
__device__ __forceinline__ void ph_prep2(const Params& p, int l, int M) {
    norm_rows(p, inp(p, I_N2G) + l * D, l, 3, 4, M);
}

__constant__ unsigned char c_cand[50] = {
    0x00,0x01,0x02,0x03,0x04,0x05,0x06,0x07,0x08,0x09,0x0A,0x0B,0x0C,0x0D,0x0E,0x0F, 0x10,0x11,0x12,0x13,0x14,0x15,0x16,0x17, 0x20,0x21,0x22,0x23,0x24, 0x30,0x31,0x32,0x33,
    0x40,0x41,0x42, 0x50,0x51, 0x60,0x61, 0x70,0x71, 0x80,0x90,0xA0,0xB0,0xC0,0xD0,0xE0,0xF0};
__device__ __forceinline__ unsigned fkey(float x) { const unsigned u = __float_as_uint(x); return (u & 0x80000000u) ? ~u : (u | 0x80000000u); }
__device__ __forceinline__ int mbcnt64(unsigned long long m) { return (int)__builtin_amdgcn_mbcnt_hi((unsigned)(m >> 32), __builtin_amdgcn_mbcnt_lo((unsigned)m, 0u)); }
__device__ __forceinline__ void ph_topk(const Params& p, int M, unsigned char* lds_raw) {
    constexpr int U = 2;
    const int lane = p.tid & 63, wid = p.tid >> 6, wv = p.bid * 8 + wid, NW = p.nblk * 8, total = M * 8;
    const float* sc = (const float*)slot(p, 3); int* idx = (int*)slot(p, 2); float* gate = (float*)slot(p, 2) + (size_t)MR * 128;
    const int cand_ab = lane < 50 ? (int)c_cand[lane] : 0;
    float fn[U][4];
#pragma unroll
    for (int u = 0; u < U; ++u) { int it0 = wv + u * NW; it0 = it0 < total ? it0 : wv; if (wv < total) { const float* s = sc + (size_t)(it0 >> 3) * D + (it0 & 7) * 256;
#pragma unroll
        for (int j = 0; j < 4; ++j) fn[u][j] = s[lane + 64 * j]; } }
    for (int it = wv; it < total; it += U * NW) {
        int itu[U]; float f[U][4]; unsigned k[U][4];
#pragma unroll
        for (int u = 0; u < U; ++u) { itu[u] = it + u * NW < total ? it + u * NW : it;
#pragma unroll
            for (int j = 0; j < 4; ++j) { f[u][j] = fn[u][j]; k[u][j] = fkey(f[u][j]); } }
#pragma unroll
        for (int u = 0; u < U; ++u) { int itn = itu[u] + U * NW; itn = itn < total ? itn : itu[u]; const float* s = sc + (size_t)(itn >> 3) * D + (itn & 7) * 256;
#pragma unroll
            for (int j = 0; j < 4; ++j) fn[u][j] = s[lane + 64 * j]; }
        unsigned th[U][2];
#pragma unroll
        for (int u = 0; u < U; ++u) { th[u][0] = 0u; th[u][1] = 0u; }
#pragma unroll
        for (int bit = 31; bit >= 16; --bit)
#pragma unroll
            for (int u = 0; u < U; ++u)
#pragma unroll
                for (int pp = 0; pp < 2; ++pp) { const unsigned c = th[u][pp] | (1u << bit);
                    const int n = __popcll(__ballot(k[u][2 * pp] >= c)) + __popcll(__ballot(k[u][2 * pp + 1] >= c)); th[u][pp] = n >= 16 ? c : th[u][pp]; }
#pragma unroll
        for (int u = 0; u < U; ++u)
#pragma unroll
            for (int pp = 0; pp < 2; ++pp) {
                const bool more = __popcll(__ballot(k[u][2 * pp] >= th[u][pp])) + __popcll(__ballot(k[u][2 * pp + 1] >= th[u][pp])) != 16;
                if (more) { unsigned t = th[u][pp];
#pragma unroll
                    for (int bit = 15; bit >= 0; --bit) { const unsigned c = t | (1u << bit);
                        const int n = __popcll(__ballot(k[u][2 * pp] >= c)) + __popcll(__ballot(k[u][2 * pp + 1] >= c)); t = n >= 16 ? c : t; }
                    th[u][pp] = t; } }
        float cv[U]; unsigned key[U]; int ca[U], cb[U];
#pragma unroll
        for (int u = 0; u < U; ++u) {
            unsigned* L = (unsigned*)lds_raw + (wid * U + u) * 192;
            unsigned* ck = L; unsigned* cvl = L + 32; unsigned* ci = L + 64; float* topv = (float*)(L + 96); int* topi = (int*)(L + 128);
#pragma unroll
            for (int pp = 0; pp < 2; ++pp) { const unsigned t = th[u][pp], ka = k[u][2 * pp], kb = k[u][2 * pp + 1];
                const unsigned long long ga = __ballot(ka > t), gb = __ballot(kb > t), ea = __ballot(ka == t), eb = __ballot(kb == t);
                const int need = 16 - __popcll(ga) - __popcll(gb);
                const bool sa = (ka > t) || (ka == t && mbcnt64(ea) < need), sb = (kb > t) || (kb == t && __popcll(ea) + mbcnt64(eb) < need);
                const unsigned long long ma = __ballot(sa), mb = __ballot(sb);
                const int pa = mbcnt64(ma), pb = __popcll(ma) + mbcnt64(mb);
                if (sa) { ck[pp * 16 + pa] = ka; cvl[pp * 16 + pa] = __float_as_uint(f[u][2 * pp]); ci[pp * 16 + pa] = (unsigned)lane; }
                if (sb) { ck[pp * 16 + pb] = kb; cvl[pp * 16 + pb] = __float_as_uint(f[u][2 * pp + 1]); ci[pp * 16 + pb] = (unsigned)(lane + 64); } }
            if (lane < 32) { const int pp = lane >> 4, me = lane & 15; const unsigned my = ck[lane]; int rk = 0;
#pragma unroll
                for (int j = 0; j < 16; ++j) { const unsigned o = ck[pp * 16 + j]; rk += (o > my || (o == my && j < me)) ? 1 : 0; }
                topv[pp * 16 + rk] = __uint_as_float(cvl[lane]); topi[pp * 16 + rk] = (int)ci[lane]; }
            cv[u] = 0.f; key[u] = 0u; ca[u] = 0; cb[u] = 0;
            if (lane < 50) { const int ab = cand_ab; ca[u] = ab >> 4; cb[u] = ab & 15; cv[u] = topv[ca[u]] + topv[16 + cb[u]]; key[u] = fkey(cv[u]); }
        }
        unsigned tc[U];
#pragma unroll
        for (int u = 0; u < U; ++u) tc[u] = 0u;
#pragma unroll
        for (int bit = 31; bit >= 14; --bit)
#pragma unroll
            for (int u = 0; u < U; ++u) { const unsigned c = tc[u] | (1u << bit); tc[u] = __popcll(__ballot(key[u] >= c)) >= 16 ? c : tc[u]; }
#pragma unroll
        for (int u = 0; u < U; ++u) {
            const bool more2 = __popcll(__ballot(key[u] >= tc[u])) != 16;
            if (more2) { unsigned t = tc[u];
#pragma unroll
                for (int bit = 13; bit >= 0; --bit) { const unsigned c = t | (1u << bit); t = __popcll(__ballot(key[u] >= c)) >= 16 ? c : t; }
                tc[u] = t; } }
#pragma unroll
        for (int u = 0; u < U; ++u) {
            const int* topi = (const int*)((unsigned*)lds_raw + (wid * U + u) * 192 + 128);
            const int row = itu[u] >> 3, h = itu[u] & 7; const unsigned t = tc[u];
            const unsigned long long g = __ballot(key[u] > t), e_ = __ballot(key[u] == t);
            const int need = 16 - __popcll(g);
            const bool win = (key[u] > t) || (key[u] == t && mbcnt64(e_) < need);
            const unsigned long long wm = __ballot(win);
            const float v16 = rdlane(cv[u], __builtin_amdgcn_readfirstlane(__ffsll(e_) - 1));
            const float ex = win ? __expf(cv[u] - v16) : 0.f;
            const float den = wave_sum(ex);
            if (win) { const int sl = mbcnt64(wm); idx[(size_t)row * 128 + h * 16 + sl] = topi[ca[u]] * 128 + topi[16 + cb[u]]; gate[(size_t)row * 128 + h * 16 + sl] = ex / den; }
        }
    }
}

__device__ __forceinline__ float gelu_exact(float v) {
    const float av = fabsf(v), t = __builtin_amdgcn_rcpf(av * 0.2316418882f + 1.0f);
    float q = t * 0.5307027145f + (-0.7265760135f); q = q * t + 0.7107068705f; q = q * t + (-0.142248368f); q = q * t + 0.127414796f; q = q * t;
    const float e = __builtin_amdgcn_exp2f((v * v) * (-0.72134752044f));
    const float m = v * (q * e);
    return v < 0.f ? m : v - m;
}
__device__ __forceinline__ void ph_expert(const Params& p, int l, int M) {
    const int lane = p.tid & 63, wv = p.bid * 8 + (p.tid >> 6), NW = p.nblk * 8;
    const unsigned char* U = (const unsigned char*)(p.ws + WS_PEER8); const unsigned char* V = U + (size_t)NEXP * D; const bf16_t* hb = (const bf16_t*)(p.ws + WS_H);
    const int* idx = (const int*)slot(p, 2); const float* gate = (const float*)slot(p, 2) + (size_t)MR * 128;
    u32x4 hw[4]; int idn0 = 0, idn1 = 0; float gn0 = 0.f, gn1 = 0.f;
    if (wv < M) {
#pragma unroll
        for (int c = 0; c < 2; ++c)
#pragma unroll
            for (int q = 0; q < 2; ++q) hw[c * 2 + q] = *(const u32x4*)(hb + (size_t)wv * D + c * 1024 + lane * 16 + q * 8);
        idn0 = idx[(size_t)wv * 128 + lane]; idn1 = idx[(size_t)wv * 128 + 64 + lane]; gn0 = gate[(size_t)wv * 128 + lane]; gn1 = gate[(size_t)wv * 128 + 64 + lane]; }
    for (int row = wv; row < M; row += NW) {
        float x[32], acc[32];
#pragma unroll
        for (int c = 0; c < 2; ++c)
#pragma unroll
            for (int q = 0; q < 2; ++q) { const u32x4 w = hw[c * 2 + q];
#pragma unroll
                for (int e = 0; e < 4; ++e) { x[c * 16 + q * 8 + 2 * e] = bflo(w[e]); x[c * 16 + q * 8 + 2 * e + 1] = bfhi(w[e]); } }
#pragma unroll
        for (int i = 0; i < 32; ++i) acc[i] = 0.f;
        const int id0 = idn0, id1 = idn1; const float g0 = gn0, g1 = gn1;
        { const int rn = row + NW < M ? row + NW : row;
#pragma unroll
          for (int c = 0; c < 2; ++c)
#pragma unroll
              for (int q = 0; q < 2; ++q) hw[c * 2 + q] = *(const u32x4*)(hb + (size_t)rn * D + c * 1024 + lane * 16 + q * 8);
          idn0 = idx[(size_t)rn * 128 + lane]; idn1 = idx[(size_t)rn * 128 + 64 + lane]; gn0 = gate[(size_t)rn * 128 + lane]; gn1 = gate[(size_t)rn * 128 + 64 + lane]; }
        float* xr = xrow(p, row); const int mr = mrow_of(row); const float* ga = modp(p, l, mr, 5);
        f32x4 xv[8], gv[8];
#pragma unroll
        for (int c = 0; c < 2; ++c)
#pragma unroll
            for (int q = 0; q < 4; ++q) { const int col = c * 1024 + lane * 16 + 4 * q; xv[c * 4 + q] = *(const f32x4*)(xr + col); gv[c * 4 + q] = *(const f32x4*)(ga + col); }
#pragma unroll 4
        for (int e = 0; e < 128; ++e) {
            const int id = __builtin_amdgcn_readlane(e < 64 ? id0 : id1, e & 63);
            const float g = __builtin_bit_cast(float, __builtin_amdgcn_readlane(__builtin_bit_cast(int, e < 64 ? g0 : g1), e & 63));
            const unsigned char* ur = U + (size_t)id * D + lane * 16; const unsigned char* vr = V + (size_t)id * D + lane * 16;
            u32x4 uw[2], vw[2];
#pragma unroll
            for (int c = 0; c < 2; ++c) { uw[c] = *(const u32x4*)(ur + c * 1024); vw[c] = *(const u32x4*)(vr + c * 1024); }
            float d = 0.f;
#pragma unroll
            for (int c = 0; c < 2; ++c)
#pragma unroll
                for (int q = 0; q < 4; ++q) { const f32x2 lo = __builtin_amdgcn_cvt_pk_f32_fp8((int)uw[c][q], false), hi = __builtin_amdgcn_cvt_pk_f32_fp8((int)uw[c][q], true);
                    d += lo.x * x[c * 16 + 4 * q] + lo.y * x[c * 16 + 4 * q + 1] + hi.x * x[c * 16 + 4 * q + 2] + hi.y * x[c * 16 + 4 * q + 3]; }
            d = wave_sum(d) * (1.0f / PEER_USCALE);
            const float a = g * gelu_exact(d) * (1.0f / PEER_VSCALE);
#pragma unroll
            for (int c = 0; c < 2; ++c)
#pragma unroll
                for (int q = 0; q < 4; ++q) { const f32x2 lo = __builtin_amdgcn_cvt_pk_f32_fp8((int)vw[c][q], false), hi = __builtin_amdgcn_cvt_pk_f32_fp8((int)vw[c][q], true);
                    acc[c * 16 + 4 * q] += a * lo.x; acc[c * 16 + 4 * q + 1] += a * lo.y; acc[c * 16 + 4 * q + 2] += a * hi.x; acc[c * 16 + 4 * q + 3] += a * hi.y; }
        }
        float ss = 0.f;
#pragma unroll
        for (int i = 0; i < 8; ++i) { xv[i] = xv[i] + gv[i] * (f32x4){acc[4 * i], acc[4 * i + 1], acc[4 * i + 2], acc[4 * i + 3]}; ss += xv[i][0] * xv[i][0] + xv[i][1] * xv[i][1] + xv[i][2] * xv[i][2] + xv[i][3] * xv[i][3]; }
        ss = wave_sum(ss);
        const float rs = rsqrtf(ss * (1.0f / D) + NORM_EPS);
        if (l == 1) {
            const float* fg = inp(p, I_FING);
#pragma unroll
            for (int c = 0; c < 2; ++c)
#pragma unroll
                for (int q = 0; q < 4; ++q) { const int col = c * 1024 + lane * 16 + 4 * q; *(f32x4*)(xr + col) = (xv[c * 4 + q] * rs) * *(const f32x4*)(fg + col); }
        } else {
            const float* g1 = inp(p, I_N1G) + (l + 1) * D; const float* sh = modp(p, l + 1, mr, 0); const float* sc = modp(p, l + 1, mr, 1);
            bf16_t* hrow = (bf16_t*)(p.ws + WS_H) + (size_t)row * D;
#pragma unroll
            for (int c = 0; c < 2; ++c) { unsigned w[8];
#pragma unroll
                for (int q = 0; q < 4; ++q) { const int col = c * 1024 + lane * 16 + 4 * q; *(f32x4*)(xr + col) = xv[c * 4 + q];
                    const f32x4 y = (xv[c * 4 + q] * rs) * *(const f32x4*)(g1 + col) * (*(const f32x4*)(sc + col) + 1.0f) + *(const f32x4*)(sh + col);
                    w[2 * q] = pack2(y[0], y[1]); w[2 * q + 1] = pack2(y[2], y[3]); }
                u32x4* d = (u32x4*)(hrow + c * 1024 + lane * 16); d[0] = (u32x4){w[0], w[1], w[2], w[3]}; d[1] = (u32x4){w[4], w[5], w[6], w[7]}; }
        }
    }
}

__device__ __forceinline__ void ph_final(const Params& p) {
    const int lane = p.tid & 63, wv = p.bid * 8 + (p.tid >> 6), NW = p.nblk * 8;
    const float* g = inp(p, I_FING);
    for (int r = wv; r < TL; r += NW) {
        float* xr = p.out + (size_t)r * D; f32x4 v[8]; float ss = 0.f;
#pragma unroll
        for (int c = 0; c < 8; ++c) { v[c] = *(const f32x4*)(xr + c * 256 + lane * 4); ss += v[c][0] * v[c][0] + v[c][1] * v[c][1] + v[c][2] * v[c][2] + v[c][3] * v[c][3]; }
        ss = wave_sum(ss); const float rs = rsqrtf(ss * (1.0f / D) + NORM_EPS);
#pragma unroll
        for (int c = 0; c < 8; ++c) { const int col = c * 256 + lane * 4; *(f32x4*)(xr + col) = (v[c] * rs) * *(const f32x4*)(g + col); }
    }
}

__global__ void __launch_bounds__(NTHREADS, 2) mega(KArgs a) {
    extern __shared__ __attribute__((aligned(16))) unsigned char shm[];
    volatile LAS unsigned* st = (volatile LAS unsigned*)(shm + LDS_BYTES - 16);
    if (threadIdx.x == 0) { st[0] = 0u; st[1] = 0u; st[2] = 0u; st[3] = 0u; }
    __syncthreads();
    unsigned char* const k_ws = a.ws; float* const k_out = a.out; const int k_wid = __builtin_amdgcn_readfirstlane(threadIdx.x >> 6), k_bid = blockIdx.x, k_nblk = gridDim.x;
#define CTX(q) Params q; { GAS unsigned char* w_ = (GAS unsigned char*)k_ws; GAS float* o_ = (GAS float*)k_out;     int b_ = k_bid, n_ = k_nblk, wv_ = k_wid; unsigned m_ = 0xFFFFFFFFu; asm volatile("; PHP_MARK" : "+s"(w_), "+s"(o_), "+s"(wv_), "+s"(b_), "+s"(n_), "+s"(m_)); int t_ = wv_ * 64 + (int)__builtin_amdgcn_mbcnt_hi(m_, __builtin_amdgcn_mbcnt_lo(m_, 0u)); q.ws = (unsigned char*)w_; q.out = (float*)o_; q.tid = t_; q.bid = b_; q.nblk = n_; }
#define GBAR() do { unsigned char* w_ = k_ws; asm volatile("" : "+s"(w_)); XcdBarrier b_; b_.bar = (unsigned*)(w_ + WS_BAR); b_.x = xb_xcc_id(); b_.st = st; xcd_barrier(b_); } while (0)
    (void)xcd_barrier_post((unsigned*)(k_ws + WS_BAR), st);
    { unsigned char* ws = k_ws;
    if (blockIdx.x == 0 && threadIdx.x == 0) { const float** tab = (const float**)(ws + WS_PTRS);
#pragma unroll
        for (int i = 0; i < 33; ++i) tab[i] = a.in[i]; } }
    { CTX(q); ph_init(q, a.in[I_X], a.in[I_CTX], a.in[I_C], a.in[I_CCTX], a.in[I_ADAW]); }
    GBAR();
    { CTX(q); ph_modred(q); }
    GBAR();
    { CTX(q); ph_prepA(q, 0); norm_rows(q, inp(q, I_N1G), 0, 0, 1, MR, inp(q, I_X), inp(q, I_CTX)); } GBAR();
#pragma unroll 1
    for (int l = 0; l < 2; ++l) {
        const bool last = (l == 1);
        const int ML = last ? TL : MR;
        { CTX(q); unsigned char* ws = q.ws; EpiConv<0> E{(const float*)(ws + WS_CONVW), (bf16_t*)(ws + WS_PCTX), slot(q, 0), (bf16_t*)(ws + WS_LORAIN)};
          run_gemm(q, shm, (const bf16_t*)(ws + WS_H), D, (const bf16_t*)(ws + WS_WTIN), D, MR, NR, D, E); } GBAR();
        { CTX(q); ph_ctxconv<0>(q); } GBAR();
        { CTX(q); unsigned char* ws = q.ws;
          { EpiLora E{(const float*)(ws + WS_LBIAS), 0, slot(q, 3)};
            run_gemm(q, shm, (const bf16_t*)(ws + WS_LORAIN), LORA_W, (const bf16_t*)(ws + WS_WTLORA), LORA_W, MR, 2 * D, 256, E); }
          { EpiLora E{(const float*)(ws + WS_LBIAS), 2, slot(q, 3)}; Params q2 = q; q2.bid = (q.bid + 32) % q.nblk;
            run_gemm(q2, shm, (const bf16_t*)(ws + WS_LORAIN) + 256, LORA_W, (const bf16_t*)(ws + WS_WTLORA) + (size_t)2 * D * LORA_W + 256, LORA_W, MR, 2 * D, 256, E); } } GBAR();
        { CTX(q); constexpr int NU = NB * NHEAD * 2;
          if (q.bid < NU) ph_scan3(q, l, shm); else { Params g = q; g.bid = q.bid - NU; g.nblk = q.nblk - NU; ph_prepB(g, l); ph_prep_bg(g, l); if (!last) ph_prepA(g, l + 1); } } GBAR();
        { CTX(q); ph_rwkv_out(q, l, ML, shm); } GBAR();
        { CTX(q); unsigned char* ws = q.ws; EpiConv<1> E{(const float*)(ws + WS_CONVW) + NR, (bf16_t*)(ws + WS_PCTX), slot(q, 0), nullptr};
          run_gemm(q, shm, (const bf16_t*)(ws + WS_H), D, (const bf16_t*)(ws + WS_WTIN) + (size_t)NR * D, D, ML, NHY, D, E); }
        { CTX(q); unsigned char* ws = q.ws; EpiBf E{slot(q, 3), SEQ};
          run_gemm(q, shm, (const bf16_t*)(ws + WS_W3T), 256, (const bf16_t*)(ws + WS_HDN), 256, 8192, SEQ, 256, E); } GBAR();
        if (!last) { { CTX(q); ph_ctxconv<1>(q); } { CTX(q); ph_ctxfilter(q, l); } GBAR(); { CTX(q); ph_ctxhyena(q, l, shm); } }
        { CTX(q); ph_hyena(q, l, shm); } GBAR();
        { CTX(q); unsigned char* ws = q.ws; EpiGate E{slot(q, 6), slot(q, 0), (const float*)(ws + WS_YHC), slot(q, 5)};
          run_gemm(q, shm, (const bf16_t*)(ws + WS_H), D, (const bf16_t*)(ws + WS_WTIN) + (size_t)(NR + NHY) * D, D, ML, NG, D, E); } GBAR();
        { CTX(q); unsigned char* ws = q.ws; EpiResid E{q.out, (float*)(ws + WS_CTXRES), (const float*)(ws + WS_MOD) + (size_t)(l * 18 + 2) * D, l == 0 ? inp(q, I_X) : (const float*)q.out, l == 0 ? inp(q, I_CTX) : (const float*)(ws + WS_CTXRES)};
          run_gemm(q, shm, slot(q, 5), D, (const bf16_t*)(ws + WS_WTOUT), D, ML, D, D, E); } GBAR();
        { CTX(q); ph_prep2(q, l, ML); } GBAR();
        { CTX(q); unsigned char* ws = q.ws; EpiF32 E{(float*)slot(q, 3), D};
          run_gemm(q, shm, (const bf16_t*)(ws + WS_H), D, (const bf16_t*)(ws + WS_WTSC), D, ML, D, D, E); } GBAR();
        { CTX(q); ph_topk(q, ML, shm); } GBAR();
        { CTX(q); ph_expert(q, l, ML); } GBAR();
    }
}

extern "C" void kernel_launch(void* const* d_in, const int* in_sizes, int n_in, void* d_out, int out_size, void* d_ws, size_t ws_size, hipStream_t stream) {
    static int grid = 0;
    if (grid == 0) {
        if (n_in != 33 || out_size != TL * D || ws_size < WS_END) { fprintf(stderr, "kernel_launch: unexpected shapes / workspace (%d inputs, out %d, ws %zu < %zu)\n", n_in, out_size, ws_size, (size_t)WS_END); grid = -1; return; }
        int dev = 0, cus = 0;
        if (hipGetDevice(&dev) != hipSuccess || hipDeviceGetAttribute(&cus, hipDeviceAttributeMultiprocessorCount, dev) != hipSuccess) { grid = -1; return; }
        if (hipFuncSetAttribute((const void*)mega, hipFuncAttributeMaxDynamicSharedMemorySize, LDS_BYTES) != hipSuccess) { fprintf(stderr, "kernel_launch: hipFuncSetAttribute failed\n"); grid = -1; return; }
        int per_cu = 0;
        if (hipOccupancyMaxActiveBlocksPerMultiprocessor(&per_cu, (const void*)mega, NTHREADS, LDS_BYTES) != hipSuccess || per_cu < 1) { fprintf(stderr, "kernel_launch: occupancy query says %d\n", per_cu); (void)hipGetLastError(); }
        grid = cus;
        if (grid <= NB * NHEAD * 2) { fprintf(stderr, "kernel_launch: needs more than %d compute units\n", NB * NHEAD * 2); grid = -1; return; }
    }
    if (grid < 0) return;
    (void)hipMemsetAsync((char*)d_ws + WS_BAR, 0, XCD_BAR_WORDS * sizeof(unsigned), stream);
    KArgs a{};
    for (int i = 0; i < 33; ++i) a.in[i] = (const float*)d_in[i];
    a.out = (float*)d_out; a.ws = (unsigned char*)d_ws;
    hipLaunchKernelGGL(mega, dim3(grid), dim3(NTHREADS), LDS_BYTES, stream, a);
}
```

```cpp
#include <hip/hip_runtime.h>
#include <cstdio>
#include <cstdint>

typedef unsigned short bf16_t;
typedef float f32x4 __attribute__((ext_vector_type(4)));
typedef float f32x2 __attribute__((ext_vector_type(2)));
typedef unsigned u32x4 __attribute__((ext_vector_type(4)));
typedef unsigned u32x2 __attribute__((ext_vector_type(2)));
#define LAS __attribute__((address_space(3)))

#define XB_TMO      128
#define XB_XCNT(j)  (256  + 64 * (j))
#define XB_XSUB(j)  (1280 + 64 * (j))
#define XB_XGEN(j)  (2304 + 64 * (j))
#define XB_TOP      3328
#define XB_TOPGEN   3392
#define XCD_BAR_WORDS 3456
#define XB_SPIN_CAP (1u << 22)

__device__ __forceinline__ unsigned xb_ld(unsigned* p)              { return __hip_atomic_load(p, __ATOMIC_RELAXED, __HIP_MEMORY_SCOPE_AGENT); }
__device__ __forceinline__ unsigned xb_add(unsigned* p, unsigned v) { return __hip_atomic_fetch_add(p, v, __ATOMIC_RELAXED, __HIP_MEMORY_SCOPE_AGENT); }
__device__ __forceinline__ unsigned xb_xcc_id() { return (unsigned)__builtin_amdgcn_s_getreg((3 << 11) | 20) & 0xFu; }
#define XB_SPIN(cond, bar) do { unsigned _sp = 0; while (cond) { __builtin_amdgcn_s_sleep(1); \
    if ((++_sp & 255u) == 0u) { if (xb_ld(&(bar)[XB_TMO])) break; if (_sp > XB_SPIN_CAP) { atomicAdd(&(bar)[XB_TMO], 1u); break; } } } } while (0)

struct XcdBarrier { unsigned* bar; unsigned x; volatile LAS unsigned* st; };

__device__ __forceinline__ XcdBarrier xcd_barrier_post(unsigned* bar, volatile LAS unsigned* st) {
    XcdBarrier b; b.bar = bar; b.x = xb_xcc_id(); b.st = st;
    if (threadIdx.x == 0) (void)xb_add(&bar[XB_XCNT(b.x)], 1u);
    return b;
}
__device__ __forceinline__ void xcd_barrier_complete(unsigned* bar, unsigned x, unsigned& nloc, unsigned& nx) {
    const unsigned G = gridDim.x * gridDim.y * gridDim.z;
    unsigned sum, cnt, mine, sp = 0u;
    for (;;) {
        sum = 0u; cnt = 0u; mine = 0u;
#pragma unroll
        for (unsigned j = 0; j < 16; ++j) { const unsigned c = xb_ld(&bar[XB_XCNT(j)]); sum += c; cnt += (c > 0u) ? 1u : 0u; mine = (j == x) ? c : mine; }
        if (sum == G) break;
        __builtin_amdgcn_s_sleep(1);
        if ((++sp & 255u) == 0u) { if (xb_ld(&bar[XB_TMO])) break; if (sp > XB_SPIN_CAP) { atomicAdd(&bar[XB_TMO], 1u); break; } }
    }
    nloc = mine > 0u ? mine : 1u; nx = cnt > 0u ? cnt : 1u;
}
__device__ __forceinline__ void xcd_barrier(const XcdBarrier& b) {
    asm volatile("s_waitcnt vmcnt(0)" ::: "memory");
    __syncthreads();
    if (threadIdx.x == 0) {
        unsigned* bar = b.bar;
        __builtin_amdgcn_s_waitcnt(0);
        unsigned nloc = b.st[0], nx = b.st[1];
        if (nloc == 0u) { xcd_barrier_complete(bar, b.x, nloc, nx); b.st[0] = nloc; b.st[1] = nx; }
        const unsigned old = xb_add(&bar[XB_XSUB(b.x)], 1u);
        const unsigned gen = old / nloc;
        if (old + 1u == (gen + 1u) * nloc) {
            __builtin_amdgcn_fence(__ATOMIC_RELEASE, "agent");
            asm volatile("s_waitcnt vmcnt(0)" ::: "memory");
            const unsigned og = xb_add(&bar[XB_TOP], 1u);
            const unsigned tg = og / nx;
            if (og + 1u == (tg + 1u) * nx) xb_add(&bar[XB_TOPGEN], 1u);
            else XB_SPIN(xb_ld(&bar[XB_TOPGEN]) == tg, bar);
            __builtin_amdgcn_fence(__ATOMIC_ACQUIRE, "agent");
            xb_add(&bar[XB_XGEN(b.x)], 1u);
            asm volatile("s_waitcnt vmcnt(0)" ::: "memory");
        } else {
            XB_SPIN(xb_ld(&bar[XB_XGEN(b.x)]) == gen, bar);
            __builtin_amdgcn_fence(__ATOMIC_ACQUIRE, "agent");
            asm volatile("s_waitcnt vmcnt(0)" ::: "memory");
        }
    }
    __syncthreads();
}

namespace pg8 {
#define PG8_LAS __attribute__((address_space(3)))
typedef unsigned short bf16_t;
typedef short bf16x8 __attribute__((ext_vector_type(8)));
typedef float f32x4 __attribute__((ext_vector_type(4)));
typedef unsigned u32x4 __attribute__((ext_vector_type(4)));
constexpr int BM = 256, BK = 64, HALF = 128, HTB = HALF * BK * 2  , STAGE_BYTES = 8 * HTB, NXCD = 8, WGM = 8;

__host__ __device__ __forceinline__ int lds_byte(int r, int c) { const int st = (r >> 4) * 2 + (c >> 5), rr = r & 15, cc = c & 31, ob = rr * 64 + cc * 2; return st * 1024 + (ob ^ (((ob >> 9) & 1) << 5)); }
__host__ __device__ __forceinline__ void stage_rc(int b, int& R, int& C) { const int st = b / 1024, sb = b % 1024, swz = sb ^ (((sb >> 9) & 1) << 5); R = (st >> 1) * 16 + swz / 64; C = (st & 1) * 32 + (swz % 64) / 2; }
__host__ __device__ __forceinline__ int perm32(int rho) { const int n = rho >> 4, i = rho & 15; return 8 * (i >> 2) + 4 * n + (i & 3); }

struct Unit { int pm, pn; };
struct Gemm { const bf16_t* A; const bf16_t* Bt; int M, N, K, lda, ldb; };

struct StaticOrder {
    int nM, nN, nwg, G, c;
    __host__ __device__ void init(int M, int N, int G_, int c_) { nM = M / BM; nN = N / BM; nwg = nM * nN; G = G_; c = c_; }
    __host__ __device__ bool next(int i, Unit& u) const {
        const long L = (long)i * G + c; if (L >= nwg) return false;
        int wgid = (int)L; { const int q = nwg / NXCD, r = nwg % NXCD, xcd = wgid % NXCD, off = wgid / NXCD; wgid = (xcd < r ? xcd * (q + 1) : r * (q + 1) + (xcd - r) * q) + off; }
        const int nig = WGM * nN, gid = wgid / nig, fm = gid * WGM, gsz = (nM - fm) < WGM ? (nM - fm) : WGM;
        u.pm = fm + ((wgid % nig) % gsz); u.pn = (wgid % nig) / gsz; return true;
    }
    __device__ __forceinline__ void a_ready(const Unit&) const {}
    __device__ __forceinline__ void done(const Unit&) const {}
};
typedef float f32x2c __attribute__((ext_vector_type(2))); typedef __bf16 bf16x2c __attribute__((ext_vector_type(2)));
__device__ __forceinline__ unsigned cvt_pk_bf16(float lo, float hi) { const f32x2c v = {lo, hi}; return __builtin_bit_cast(unsigned, __builtin_convertvector(v, bf16x2c)); }
typedef float f32x2 __attribute__((ext_vector_type(2)));
template <class Epi, class Sched>
__device__ __forceinline__ void gemm_phase(PG8_LAS unsigned char* lds, const Gemm g, const Sched& S, const Epi& E, const int tid) {
    const int wid = __builtin_amdgcn_readfirstlane(tid >> 6), lane = tid & 63, wr = wid >> 2, wc = wid & 3, fr = lane & 15, fq = lane >> 4;
    const int K = g.K, nt = K / BK;
    unsigned voffA[2], voffB[2];
#pragma unroll
    for (int i = 0; i < 2; ++i) { int R, C; stage_rc(tid * 16 + i * 8192, R, C); const int Rb = Epi::PERM ? ((R & ~31) + perm32(R & 31)) : R;
        voffA[i] = (unsigned)(R * g.lda + C) * 2u; voffB[i] = (unsigned)(Rb * g.ldb + C) * 2u; }
    const size_t kstep = (size_t)(BK * 2);
    const size_t hstepA = (size_t)HALF * g.lda * 2, hstepB = (size_t)HALF * g.ldb * 2;
    const size_t tstepA = 2 * hstepA, tstepB = 2 * hstepB;
    const unsigned ldsw = (unsigned)wid * 1024u;
    const int aoff = lds_byte(wr * 64 + fr, fq * 8), boff = lds_byte(wc * 32 + fr, fq * 8);
#define PG8_SA(b, h) (((b) * 2 + (h)) * HTB)
#define PG8_SB(b, h) ((4 + (b) * 2 + (h)) * HTB)
#define PG8_STAGE(bufoff, gbase, voff) do { _Pragma("unroll") for (int _i = 0; _i < 2; ++_i) \
        __builtin_amdgcn_global_load_lds((const unsigned*)((const char*)(gbase) + (voff)[_i]), (PG8_LAS unsigned*)(lds + (bufoff) + ldsw + _i * 8192), 16, 0, 0); } while (0)
#define PG8_LDA(dst, b, h) do { _Pragma("unroll") for (int m = 0; m < 4; ++m) _Pragma("unroll") for (int k = 0; k < 2; ++k) dst[m][k] = *(const PG8_LAS bf16x8*)(lds + PG8_SA(b, h) + aoff + m * 2048 + k * 1024); } while (0)
#define PG8_LDB(dst, b, h) do { _Pragma("unroll") for (int n = 0; n < 2; ++n) _Pragma("unroll") for (int k = 0; k < 2; ++k) dst[n][k] = *(const PG8_LAS bf16x8*)(lds + PG8_SB(b, h) + boff + n * 2048 + k * 1024); } while (0)
#define PG8_MMA(ai, bj, At, Bt) do { __builtin_amdgcn_s_setprio(1); _Pragma("unroll") for (int m = 0; m < 4; ++m) _Pragma("unroll") for (int n = 0; n < 2; ++n) _Pragma("unroll") for (int k = 0; k < 2; ++k) \
        acc[ai][bj][m][n] = __builtin_amdgcn_mfma_f32_16x16x32_bf16(Bt[n][k], At[m][k], acc[ai][bj][m][n], 0, 0, 0); __builtin_amdgcn_s_setprio(0); } while (0)
#define PG8_WAIT_V(n) asm volatile("s_waitcnt vmcnt(" #n ")" ::: "memory")
#define PG8_WAIT_L(n) asm volatile("s_waitcnt lgkmcnt(" #n ")" ::: "memory")
#define PG8_BAR __builtin_amdgcn_s_barrier()
#define PG8_SCHED __builtin_amdgcn_sched_barrier(0)
    Unit cur, nxt; int ui = 0;
    if (!S.next(0, cur)) return;
    f32x4 acc[2][2][4][2];
#pragma unroll
    for (int a = 0; a < 2; ++a)
#pragma unroll
        for (int b = 0; b < 2; ++b)
#pragma unroll
            for (int m = 0; m < 4; ++m)
#pragma unroll
                for (int n = 0; n < 2; ++n) acc[a][b][m][n] = (f32x4){0.f, 0.f, 0.f, 0.f};
    bf16x8 At[4][2], B0[2][2], B1[2][2];
    const char* cA = (const char*)g.A + (size_t)cur.pm * tstepA; const char* cB = (const char*)g.Bt + (size_t)cur.pn * tstepB;
    S.a_ready(cur);
    PG8_STAGE(PG8_SB(0, 0), cB, voffB); PG8_STAGE(PG8_SA(0, 0), cA, voffA); PG8_STAGE(PG8_SB(0, 1), cB + hstepB, voffB); PG8_STAGE(PG8_SA(0, 1), cA + hstepA, voffA);
    if (wr == 1) PG8_BAR;
    PG8_WAIT_V(4); PG8_BAR;
    PG8_STAGE(PG8_SB(1, 0), cB + kstep, voffB); PG8_STAGE(PG8_SA(1, 0), cA + kstep, voffA); PG8_STAGE(PG8_SB(1, 1), cB + hstepB + kstep, voffB);
    PG8_WAIT_V(6); PG8_BAR;
    for (;;) {
        const bool has_next = S.next(ui + 1, nxt);
        const char* nA = has_next ? (const char*)g.A + (size_t)nxt.pm * tstepA : cA; const char* nB = has_next ? (const char*)g.Bt + (size_t)nxt.pn * tstepB : cB;
        for (int t = 0; t < nt; t += 2) {
            const bool last = (t == nt - 2);
            const char* a1 = cA + (size_t)(t + 1) * kstep;
            const char* a2 = last ? nA : cA + (size_t)(t + 2) * kstep; const char* b2 = last ? nB : cB + (size_t)(t + 2) * kstep;
            const char* a3 = a2 + kstep; const char* b3 = b2 + kstep;
            if (last && has_next) S.a_ready(nxt);
            PG8_LDB(B0, 0, 0); PG8_SCHED; PG8_LDA(At, 0, 0); PG8_STAGE(PG8_SA(1, 1), a1 + hstepA, voffA);
            PG8_WAIT_L(8); PG8_BAR; PG8_WAIT_L(0); PG8_MMA(0, 0, At, B0); PG8_BAR; PG8_SCHED;
            PG8_LDB(B1, 0, 1); PG8_STAGE(PG8_SB(0, 0), b2, voffB);
            PG8_BAR; PG8_WAIT_L(0); PG8_MMA(0, 1, At, B1); PG8_BAR;
            PG8_LDA(At, 0, 1); PG8_STAGE(PG8_SA(0, 0), a2, voffA);
            PG8_BAR; PG8_WAIT_L(0); PG8_MMA(1, 0, At, B0); PG8_BAR; PG8_SCHED;
            PG8_STAGE(PG8_SB(0, 1), b2 + hstepB, voffB);
            PG8_WAIT_V(6); PG8_BAR; PG8_MMA(1, 1, At, B1); PG8_BAR;
            PG8_LDB(B0, 1, 0); PG8_SCHED; PG8_LDA(At, 1, 0); PG8_STAGE(PG8_SA(0, 1), a2 + hstepA, voffA);
            PG8_WAIT_L(8); PG8_BAR; PG8_WAIT_L(0); PG8_MMA(0, 0, At, B0); PG8_BAR; PG8_SCHED;
            PG8_LDB(B1, 1, 1); PG8_STAGE(PG8_SB(1, 0), b3, voffB);
            PG8_BAR; PG8_WAIT_L(0); PG8_MMA(0, 1, At, B1); PG8_BAR;
            PG8_LDA(At, 1, 1); PG8_STAGE(PG8_SA(1, 0), a3, voffA);
            PG8_BAR; PG8_WAIT_L(0); PG8_MMA(1, 0, At, B0); PG8_BAR; PG8_SCHED;
            PG8_STAGE(PG8_SB(1, 1), b3 + hstepB, voffB);
            PG8_WAIT_V(6); PG8_BAR; PG8_MMA(1, 1, At, B1); PG8_BAR;
        }
            if constexpr (!Epi::AFTER_DRAIN) { E(acc, cur, wr, wc, fr, fq); S.done(cur); }
            if (!has_next) break;
#pragma unroll
        for (int a = 0; a < 2; ++a)
#pragma unroll
            for (int b = 0; b < 2; ++b)
#pragma unroll
                for (int m = 0; m < 4; ++m)
#pragma unroll
                    for (int n = 0; n < 2; ++n) acc[a][b][m][n] = (f32x4){0.f, 0.f, 0.f, 0.f};
        cur = nxt; cA = nA; cB = nB; ++ui;
    }
    PG8_WAIT_V(0);
    if (wr == 0) PG8_BAR;
    PG8_BAR;
    if constexpr (Epi::AFTER_DRAIN) { E.fused(acc, cur, wr, wc, fr, fq, lds, wid, lane); S.done(cur); }
#undef PG8_SA
#undef PG8_SB
#undef PG8_STAGE
#undef PG8_LDA
#undef PG8_LDB
#undef PG8_MMA
#undef PG8_WAIT_V
#undef PG8_WAIT_L
#undef PG8_BAR
#undef PG8_SCHED
}
}

constexpr int D = 2048, NB = 2, SEQ = 16384, CL = 256, TL = NB * SEQ, TC = NB * CL, MR = TL + TC;
constexpr int NHEAD = 32, HN = 64;
constexpr int IN_COLS = 16832, CONV_COLS = 12736;
constexpr int NR = 6656, NHY = 6144, NG = 4096, NTOT = NR + NHY + NG;
constexpr int LORA_W = 512;
constexpr int NPART = 32;
constexpr int NEXP = 16384;
constexpr float NORM_EPS = 1e-6f, GN_EPS = 64e-5f;
constexpr int NTHREADS = 512;
constexpr int LDS_BYTES = 159 * 1024;

constexpr size_t al256(size_t x) { return (x + 255) & ~(size_t)255; }
constexpr size_t SLOT_BYTES = (size_t)MR * D * 2;
constexpr size_t WS_BAR    = 0;
constexpr size_t WS_PTRS   = 14336;
constexpr size_t WS_MOD    = 16384;
constexpr size_t WS_MODP   = WS_MOD    + al256((size_t)2 * 3 * 6 * D * 4);
constexpr size_t WS_TW     = WS_MODP   + al256((size_t)NPART * 2 * 3 * 6 * D * 4);
constexpr size_t WS_CONVW  = WS_TW     + al256((size_t)32768 * 8);
constexpr size_t WS_LBIAS  = WS_CONVW  + al256((size_t)3 * NTOT * 4);
constexpr size_t WS_CTXRES = WS_LBIAS  + al256((size_t)4 * D * 4);
constexpr size_t WS_H      = WS_CTXRES + al256((size_t)TC * D * 4);
constexpr size_t WS_WTIN   = WS_H      + SLOT_BYTES;
constexpr size_t WS_WTLORA = WS_WTIN   + al256((size_t)NTOT * D * 2);
constexpr size_t WS_WTOUT  = WS_WTLORA + al256((size_t)4 * D * LORA_W * 2);
constexpr size_t WS_WTSC   = WS_WTOUT  + al256((size_t)D * D * 2);
constexpr size_t WS_W3T    = WS_WTSC   + al256((size_t)D * D * 2);
constexpr size_t WS_HDN    = WS_W3T    + al256((size_t)8192 * 256 * 2);
constexpr size_t WS_HDNC   = WS_HDN    + al256((size_t)SEQ * 256 * 2);
constexpr size_t WS_PCTX   = WS_HDNC   + al256((size_t)CL * 256 * 2);
constexpr size_t WS_LORAIN = WS_PCTX   + al256((size_t)TC * NR * 2);
constexpr size_t WS_SLOT0  = WS_LORAIN + al256((size_t)MR * LORA_W * 2);
constexpr size_t WS_PEER8  = WS_SLOT0  + 7 * SLOT_BYTES;
constexpr size_t WS_END    = WS_PEER8  + al256((size_t)2 * NEXP * D);
constexpr size_t CH_ARR = (size_t)NB * D * CL * 4;
constexpr size_t WS_CV   = WS_LORAIN;
constexpr size_t WS_YHC  = WS_CV + 3 * CH_ARR;
constexpr size_t WS_HCF  = WS_YHC + CH_ARR;
static_assert(WS_HCF + (size_t)8192 * 256 * 4 <= WS_SLOT0, "ctx hyena arrays must fit the lora_in region");

#define GAS __attribute__((address_space(1)))
struct KArgs {
    const float* in[33];
    float* out;
    unsigned char* ws;
};
struct Params {
    float* out;
    unsigned char* ws;
    int tid, bid, nblk;
};

enum { I_X = 0, I_C, I_CTX, I_CCTX, I_ADAW, I_ADAB, I_N1G, I_N2G, I_WIN, I_CONVW, I_W0, I_W2, I_A0, I_A2, I_G2, I_KK, I_KA, I_RK, I_LNW, I_LNB,
       I_HW1, I_HB1, I_HW2, I_HB2, I_HW3, I_HFREQ, I_HSKIP, I_WOUT, I_WQ, I_KEYS, I_PU, I_PV, I_FING };

__device__ __forceinline__ float bf2f(bf16_t v) { return __uint_as_float((unsigned)v << 16); }
__device__ __forceinline__ bf16_t f2bf(float f) { unsigned u = __float_as_uint(f); u += 0x7FFFu + ((u >> 16) & 1u); return (bf16_t)(u >> 16); }
__device__ __forceinline__ unsigned pack2(float lo, float hi) { return (unsigned)f2bf(lo) | ((unsigned)f2bf(hi) << 16); }
__device__ __forceinline__ float bflo(unsigned w) { return __uint_as_float(w << 16); }
__device__ __forceinline__ float bfhi(unsigned w) { return __uint_as_float(w & 0xFFFF0000u); }
__device__ __forceinline__ float sigmoidf_(float x) { return __builtin_amdgcn_rcpf(1.0f + __expf(-x)); }
__device__ __forceinline__ float tanhf_(float x) { return 1.0f - 2.0f * __builtin_amdgcn_rcpf(1.0f + __expf(2.0f * x)); }
template <int CTRL> __device__ __forceinline__ float dppf(float x) { return __builtin_bit_cast(float, __builtin_amdgcn_mov_dpp(__builtin_bit_cast(int, x), CTRL, 0xf, 0xf, true)); }
__device__ __forceinline__ float red16(float x) { x += dppf<0xB1>(x); x += dppf<0x4E>(x); x += dppf<0x141>(x); x += dppf<0x128>(x); return x; }
__device__ __forceinline__ float rdlane(float x, int l) { return __builtin_bit_cast(float, __builtin_amdgcn_readlane(__builtin_bit_cast(int, x), l)); }
__device__ __forceinline__ float wave_sum(float x) { x = red16(x); return (rdlane(x, 0) + rdlane(x, 16)) + (rdlane(x, 32) + rdlane(x, 48)); }

__device__ __forceinline__ const float* inp(const Params& p, int k) {
    const unsigned long long v = ((const unsigned long long*)(p.ws + WS_PTRS))[k];
    const unsigned lo = __builtin_amdgcn_readfirstlane((unsigned)v), hi = __builtin_amdgcn_readfirstlane((unsigned)(v >> 32));
    GAS const float* g_ = (GAS const float*)(((unsigned long long)hi << 32) | lo); asm volatile("" : "+s"(g_)); return (const float*)g_;
}
__device__ __forceinline__ const float* xrow_c(const Params& p, int r) { return r < TL ? p.out + (size_t)r * D : (const float*)(p.ws + WS_CTXRES) + (size_t)(r - TL) * D; }
__device__ __forceinline__ float* xrow(const Params& p, int r) { return r < TL ? p.out + (size_t)r * D : (float*)(p.ws + WS_CTXRES) + (size_t)(r - TL) * D; }
__device__ __forceinline__ int mrow_of(int r) { return r < TL ? (r >> 14) : 2; }
__device__ __forceinline__ const float* modp(const Params& p, int l, int mrow, int chunk) { return (const float*)(p.ws + WS_MOD) + ((size_t)(l * 3 + mrow) * 6 + chunk) * D; }
__device__ __forceinline__ bf16_t* slot(const Params& p, int s) { return (bf16_t*)(p.ws + WS_SLOT0 + (size_t)s * SLOT_BYTES); }

__device__ __forceinline__ int src_col(int n) {
    if (n < 4096) return n;
    if (n < 6144) return 4480 + (n - 4096);
    if (n < NR) { const int cc = n - 6144, blk = cc >> 7, o = cc & 127;
        if (o < 96) return (blk == 0 ? 4096 : blk == 1 ? 4288 : blk == 2 ? 4192 : 4384) + o;
        return blk == 0 ? 6528 + (o - 96) : blk == 1 ? 6528 + 32 + (o - 96) : -1; }
    if (n < NR + NHY) return 6592 + (n - NR);
    { const int g = n - NR - NHY, tile = g >> 8, o = g & 255;
      return o < 128 ? CONV_COLS + tile * 128 + o : CONV_COLS + D + tile * 128 + (o - 128); }
}

__device__ __forceinline__ float siluf_(float x) { return x * sigmoidf_(x); }
__device__ __forceinline__ void ph_init(const Params& p, const float* in_x, const float* in_ctx, const float* cv, const float* cc, const float* ada_w) {
    const size_t gt = (size_t)p.bid * NTHREADS + p.tid, GT = (size_t)p.nblk * NTHREADS;
    float* mp = (float*)(p.ws + WS_MODP);
    for (int u = p.bid; u < 2 * 12 * NPART; u += p.nblk) {
        const int kc = u % NPART, cch = (u / NPART) % 12, l = u / (NPART * 12);
        const int col = cch * 1024 + p.tid * 2;
        float a0 = 0.f, a1 = 0.f, b0 = 0.f, b1 = 0.f, c0 = 0.f, c1 = 0.f;
        const float* w = ada_w + ((size_t)l * D + (size_t)kc * 64) * (6 * D) + col;
#pragma unroll 8
        for (int k = 0; k < 64; ++k) {
            const int kk = kc * 64 + k;
            const float s0 = siluf_(cv[kk]), s1 = siluf_(cv[D + kk]), s2 = siluf_(cc[kk]);
            const f32x2 wv = *(const f32x2*)(w + (size_t)k * (6 * D));
            a0 += s0 * wv.x; a1 += s0 * wv.y; b0 += s1 * wv.x; b1 += s1 * wv.y; c0 += s2 * wv.x; c1 += s2 * wv.y;
        }
        float* o = mp + ((size_t)(kc * 2 + l) * 3) * (6 * D) + col;
        *(f32x2*)(o) = (f32x2){a0, a1}; *(f32x2*)(o + 6 * D) = (f32x2){b0, b1}; *(f32x2*)(o + 12 * D) = (f32x2){c0, c1};
    }
}
__device__ __forceinline__ void ph_modred(const Params& p) {
    const int gt = p.bid * NTHREADS + p.tid, GT = p.nblk * NTHREADS;
    const float* mp = (const float*)(p.ws + WS_MODP); float* md = (float*)(p.ws + WS_MOD);
    for (int i = gt; i < 2 * 3 * 6 * D; i += GT) {
        const int col = i % (6 * D), r = (i / (6 * D)) % 3, l = i / (18 * D);
        float s = inp(p, I_ADAB)[l * 6 * D + col];
        for (int kc = 0; kc < NPART; ++kc) s += mp[((size_t)(kc * 2 + l) * 3 + r) * (6 * D) + col];
        md[i] = s;
    }
}

__device__ __forceinline__ void norm_rows(const Params& p, const float* g, int l, int ch_shift, int ch_scale, int M, const float* xin = nullptr, const float* cin = nullptr) {
    const int lane = p.tid & 63, wv = p.bid * 8 + (p.tid >> 6), NW = p.nblk * 8;
    bf16_t* h = (bf16_t*)(p.ws + WS_H);
    f32x4 gg[8];
#pragma unroll
    for (int c = 0; c < 8; ++c) gg[c] = *(const f32x4*)(g + c * 256 + lane * 4);
    auto rowp = [&](int r) { return xin ? (r < TL ? xin + (size_t)r * D : cin + (size_t)(r - TL) * D) : xrow_c(p, r); };
    f32x4 v[8];
    if (wv < M) { const float* xr = rowp(wv);
#pragma unroll
        for (int c = 0; c < 8; ++c) v[c] = *(const f32x4*)(xr + c * 256 + lane * 4); }
    for (int r = wv; r < M; r += NW) {
        const int mr = mrow_of(r);
        const float* sh = modp(p, l, mr, ch_shift); const float* sc = modp(p, l, mr, ch_scale);
        f32x4 vn[8];
        { const int rn = r + NW < M ? r + NW : r; const float* xn = rowp(rn);
#pragma unroll
          for (int c = 0; c < 8; ++c) vn[c] = *(const f32x4*)(xn + c * 256 + lane * 4); }
        f32x4 s1[8], s0[8];
#pragma unroll
        for (int c = 0; c < 8; ++c) { const int col = c * 256 + lane * 4; s1[c] = *(const f32x4*)(sc + col); s0[c] = *(const f32x4*)(sh + col); }
        float ss = 0.f;
#pragma unroll
        for (int c = 0; c < 8; ++c) ss += v[c][0] * v[c][0] + v[c][1] * v[c][1] + v[c][2] * v[c][2] + v[c][3] * v[c][3];
        ss = wave_sum(ss);
        const float rs = rsqrtf(ss * (1.0f / D) + NORM_EPS);
#pragma unroll
        for (int c = 0; c < 8; ++c) { const int col = c * 256 + lane * 4;
            const f32x4 y = (v[c] * rs) * gg[c] * (s1[c] + 1.0f) + s0[c];
            u32x2 w; w.x = pack2(y[0], y[1]); w.y = pack2(y[2], y[3]);
            *(u32x2*)(h + (size_t)r * D + col) = w; }
#pragma unroll
        for (int c = 0; c < 8; ++c) v[c] = vn[c];
    }
}

template <class F> __device__ __forceinline__ void cvt_T(const Params& p, bf16_t* dst, int N, int Kd, F f) {
    const int lane = p.tid & 63, wv = p.bid * 8 + (p.tid >> 6), NW = p.nblk * 8;
    const int nblk = N / 64, units = nblk * (Kd / 32);
    for (int u = wv; u < units; u += NW) {
        const int n = (u % nblk) * 64 + lane, k0 = (u / nblk) * 32;
        float v[32];
#pragma unroll
        for (int i = 0; i < 32; ++i) v[i] = f(k0 + i, n);
        unsigned w[16];
#pragma unroll
        for (int i = 0; i < 16; ++i) w[i] = pack2(v[2 * i], v[2 * i + 1]);
        u32x4* d = (u32x4*)(dst + (size_t)n * Kd + k0);
#pragma unroll
        for (int i = 0; i < 4; ++i) d[i] = (u32x4){w[4 * i], w[4 * i + 1], w[4 * i + 2], w[4 * i + 3]};
    }
}

__device__ __forceinline__ void filter_mlp(const Params& p, int l, int Lf, bf16_t* dst) {
    const int lane = p.tid & 63, wv = p.bid * 8 + (p.tid >> 6), NW = p.nblk * 8;
    const float* w1 = inp(p, I_HW1) + (size_t)l * 33 * 64; const float* b1 = inp(p, I_HB1) + l * 64;
    const float* w2 = inp(p, I_HW2) + (size_t)l * 64 * 64; const float* b2 = inp(p, I_HB2) + l * 64;
    const float fr = inp(p, I_HFREQ)[l * 64 + lane];
    float w1c[33], w2c[64];
#pragma unroll
    for (int i = 0; i < 33; ++i) w1c[i] = w1[i * 64 + lane];
#pragma unroll
    for (int i = 0; i < 64; ++i) w2c[i] = w2[i * 64 + lane];
    const float b1l = b1[lane], b2l = b2[lane];
    for (int n = wv; n < Lf; n += NW) {
        float zf = 0.f;
        if (lane == 0) zf = (float)n / (float)(Lf - 1);
        else if (lane <= 32) { const int bi = (lane - 1) & 15; const float band = 1e-4f + (float)bi * ((15.0f - 1e-4f) / 15.0f);
            float s, c; sincospif(2.0f * (float)n * band / (float)Lf, &s, &c); zf = lane <= 16 ? c : -s; }
        float a = b1l;
#pragma unroll
        for (int i = 0; i < 33; ++i) a += rdlane(zf, i) * w1c[i];
        const float h1 = sinf(fr * a);
        float b = b2l;
#pragma unroll
        for (int i = 0; i < 64; ++i) b += rdlane(h1, i) * w2c[i];
        const float h2 = sinf(fr * b);
        bf16_t* d = dst + (size_t)n * 256;
        d[lane] = f2bf(h2); d[64 + lane] = 0; d[128 + lane] = 0; d[192 + lane] = 0;
    }
}

__device__ __forceinline__ void prep_win(const Params& p, int l, int n0, int n1) {
    const float* w = inp(p, I_WIN) + (size_t)l * D * IN_COLS;
    cvt_T(p, (bf16_t*)(p.ws + WS_WTIN) + (size_t)n0 * D, n1 - n0, D, [=](int k, int n) { const int s = src_col(n + n0); return s >= 0 ? w[(size_t)k * IN_COLS + s] : 0.f; });
    float* cw = (float*)(p.ws + WS_CONVW); const float* cs = inp(p, I_CONVW) + (size_t)l * 3 * CONV_COLS; const int nn = n1 - n0;
    for (int i = p.bid * NTHREADS + p.tid; i < 3 * nn; i += p.nblk * NTHREADS) { const int j = i / nn, n = n0 + i % nn; const int s = src_col(n);
        cw[j * NTOT + n] = (n < NR + NHY && s >= 0) ? cs[j * CONV_COLS + s] : 0.f; }
}
__device__ __forceinline__ void ph_prepA(const Params& p, int l) {
    prep_win(p, l, 0, NR);
    { const float* w2 = inp(p, I_W2) + (size_t)l * 2 * 96 * D; const float* a2 = inp(p, I_A2) + (size_t)l * 2 * 96 * D;
      cvt_T(p, (bf16_t*)(p.ws + WS_WTLORA), 4 * D, LORA_W, [=](int k, int n) { const int t = n >> 11, j = n & (D - 1), kb = k >> 7, o = k & 127;
          if (kb != t || o >= 96) return 0.f; const float* s = (t & 1) ? a2 : w2; return s[((size_t)(t >> 1) * 96 + o) * D + j]; }); }
    { float* lb = (float*)(p.ws + WS_LBIAS); for (int i = p.bid * NTHREADS + p.tid; i < 4 * D; i += p.nblk * NTHREADS) { const int t = i >> 11, j = i & (D - 1);
          lb[i] = ((t & 1) ? inp(p, I_A0) : inp(p, I_W0))[(size_t)l * 2 * D + (t >> 1) * D + j]; } }
}
__device__ __forceinline__ void ph_prepB(const Params& p, int l) { prep_win(p, l, NR, NTOT); }

__device__ __forceinline__ void ph_prep_bg(const Params& p, int l) {
    { const float* w = inp(p, I_WOUT) + (size_t)l * D * D; cvt_T(p, (bf16_t*)(p.ws + WS_WTOUT), D, D, [=](int k, int n) { return w[(size_t)k * D + n]; }); }
    { const float* w = inp(p, I_HW3) + (size_t)l * 64 * 8192; cvt_T(p, (bf16_t*)(p.ws + WS_W3T), 8192, 256, [=](int k, int n) { return k < 64 ? w[(size_t)k * 8192 + n] : 0.f; }); }
    { const float* wq = inp(p, I_WQ) + (size_t)l * D * D; const float* keys = inp(p, I_KEYS) + (size_t)l * 16 * 128 * 128; unsigned* dst = (unsigned*)(p.ws + WS_WTSC);
      for (size_t i = (size_t)p.bid * NTHREADS + p.tid; i < (size_t)D * D / 2; i += (size_t)p.nblk * NTHREADS) {
          const int row = (int)(i / (D / 2)), kk = (int)(i % (D / 2)) * 2, hp = row >> 7;
          const f32x4* kr = (const f32x4*)(keys + (size_t)row * 128); const f32x4* q0 = (const f32x4*)(wq + (size_t)kk * D + hp * 128); const f32x4* q1 = (const f32x4*)(wq + (size_t)(kk + 1) * D + hp * 128);
          float s0 = 0.f, s1 = 0.f;
#pragma unroll 4
          for (int d4 = 0; d4 < 32; ++d4) { const f32x4 a = kr[d4], b = q0[d4], c = q1[d4];
              s0 += a[0] * b[0] + a[1] * b[1] + a[2] * b[2] + a[3] * b[3]; s1 += a[0] * c[0] + a[1] * c[1] + a[2] * c[2] + a[3] * c[3]; }
          dst[i] = pack2(s0, s1); } }
    filter_mlp(p, l, SEQ, (bf16_t*)(p.ws + WS_HDN));
    if (l == 0) filter_mlp(p, l, CL, (bf16_t*)(p.ws + WS_HDNC));
    { const f32x4* su = (const f32x4*)(inp(p, I_PU) + (size_t)l * NEXP * D); const f32x4* sv = (const f32x4*)(inp(p, I_PV) + (size_t)l * NEXP * D);
      unsigned* du = (unsigned*)(p.ws + WS_PEER8); unsigned* dv = du + (size_t)NEXP * D / 4;
      for (size_t i = (size_t)p.bid * NTHREADS + p.tid; i < (size_t)NEXP * D / 4; i += (size_t)p.nblk * NTHREADS) {
          const f32x4 a = su[i] * 128.0f, b = sv[i] * 8.0f;
          int wa = __builtin_amdgcn_cvt_pk_fp8_f32(a[0], a[1], 0, false); wa = __builtin_amdgcn_cvt_pk_fp8_f32(a[2], a[3], wa, true);
          int wb = __builtin_amdgcn_cvt_pk_fp8_f32(b[0], b[1], 0, false); wb = __builtin_amdgcn_cvt_pk_fp8_f32(b[2], b[3], wb, true);
          du[i] = (unsigned)wa; dv[i] = (unsigned)wb; } }
}

using pg8::Unit; using pg8::cvt_pk_bf16;
typedef f32x4 Acc[2][2][4][2];

__device__ __forceinline__ void st8bf(bf16_t* p, const f32x4 a, const f32x4 b) { *(u32x4*)p = (u32x4){cvt_pk_bf16(a[0], a[1]), cvt_pk_bf16(a[2], a[3]), cvt_pk_bf16(b[0], b[1]), cvt_pk_bf16(b[2], b[3])}; }
__device__ __forceinline__ void st4bf(bf16_t* p, const f32x4 v) { u32x2 w; w.x = cvt_pk_bf16(v[0], v[1]); w.y = cvt_pk_bf16(v[2], v[3]); *(u32x2*)p = w; }

template <int GROUP> struct EpiConv {
    static constexpr bool PERM = false, AFTER_DRAIN = false;
    const float* cw;
    bf16_t* pctx;
    bf16_t* d0; bf16_t* lora;
    __device__ __forceinline__ void operator()(const Acc& acc, const Unit& u, int wr, int wc, int fr, int fq) const {
        if (u.pm >= TL / 256) {
#pragma unroll
            for (int ai = 0; ai < 2; ++ai)
#pragma unroll
                for (int m = 0; m < 4; ++m) { const int row = (u.pm - TL / 256) * 256 + ai * 128 + wr * 64 + m * 16 + fr;
#pragma unroll
                    for (int bj = 0; bj < 2; ++bj)
#pragma unroll
                        for (int n = 0; n < 2; ++n) st4bf(pctx + (size_t)row * NR + u.pn * 256 + bj * 128 + wc * 32 + n * 16 + 4 * fq, acc[ai][bj][m][n]); }
            return;
        }
        f32x4 tap[2][2][3];
#pragma unroll
        for (int bj = 0; bj < 2; ++bj)
#pragma unroll
            for (int n = 0; n < 2; ++n)
#pragma unroll
                for (int j = 0; j < 3; ++j) tap[bj][n][j] = *(const f32x4*)(cw + j * NTOT + u.pn * 256 + bj * 128 + wc * 32 + n * 16 + 4 * fq);
#pragma unroll
        for (int bj = 0; bj < 2; ++bj)
#pragma unroll
            for (int n = 0; n < 2; ++n) {
                const int colg = u.pn * 256 + bj * 128 + wc * 32 + n * 16 + 4 * fq;
                const f32x4 w0 = tap[bj][n][0], w1 = tap[bj][n][1], w2 = tap[bj][n][2];
#pragma unroll
                for (int ai = 0; ai < 2; ++ai) {
                    f32x4 rp[4], rn[4];
#pragma unroll
                    for (int m = 0; m < 4; ++m)
#pragma unroll
                        for (int e = 0; e < 4; ++e) { rp[m][e] = dppf<0x121>(acc[ai][bj][m][n][e]); rn[m][e] = dppf<0x12F>(acc[ai][bj][m][n][e]); }
#pragma unroll
                    for (int m = 0; m < 4; ++m) {
                        const f32x4 z = (f32x4){0.f, 0.f, 0.f, 0.f};
                        const f32x4 pv = (fr == 0) ? (m > 0 ? rp[m > 0 ? m - 1 : 0] : z) : rp[m];
                        const f32x4 nx = (fr == 15) ? (m < 3 ? rn[m < 3 ? m + 1 : 3] : z) : rn[m];
                        const f32x4 o = w0 * pv + w1 * acc[ai][bj][m][n] + w2 * nx;
                        const int row = u.pm * 256 + ai * 128 + wr * 64 + m * 16 + fr;
                        if (GROUP == 0) {
                            if (colg < 3 * D) { bf16_t* d = d0 + (size_t)(colg >> 11) * (SLOT_BYTES / 2); st4bf(d + (size_t)row * D + (colg & (D - 1)), o); }
                            else { const int cc = colg - 3 * D, blk = cc >> 7, oo = cc & 127; f32x4 a;
                                if (oo < 96) { if (blk & 1) a = o; else { a[0] = tanhf_(o[0]); a[1] = tanhf_(o[1]); a[2] = tanhf_(o[2]); a[3] = tanhf_(o[3]); } }
                                else if (blk < 2) { a[0] = sigmoidf_(o[0]); a[1] = sigmoidf_(o[1]); a[2] = sigmoidf_(o[2]); a[3] = sigmoidf_(o[3]); }
                                else a = z;
                                st4bf(lora + (size_t)row * LORA_W + cc, a); }
                        } else {
                            bf16_t* d = d0 + (size_t)(colg >> 11) * (SLOT_BYTES / 2); const int c = colg & (D - 1), b = row >> 14, t = row & (SEQ - 1);
                            const bool odd = fr & 1;
                            const float r0 = dppf<0xB1>(odd ? o[0] : o[2]), r1 = dppf<0xB1>(odd ? o[1] : o[3]);
                            const unsigned w0 = cvt_pk_bf16(odd ? r0 : o[0], odd ? o[2] : r0), w1 = cvt_pk_bf16(odd ? r1 : o[1], odd ? o[3] : r1);
                            bf16_t* q = d + ((size_t)(b * D + c + (odd ? 2 : 0))) * SEQ + (t - (odd ? 1 : 0));
                            *(unsigned*)q = w0; *(unsigned*)(q + SEQ) = w1;
                        }
                    }
                }
            }
    }
};

struct EpiLora {
    static constexpr bool PERM = true, AFTER_DRAIN = false;
    const float* bias4;
    int t0;
    bf16_t* dst0;
    __device__ __forceinline__ void operator()(const Acc& acc, const Unit& u, int wr, int wc, int fr, int fq) const {
        const int t = t0 + (u.pn >> 3); const bool isa = t & 1; const float mul = isa ? 1.0f : -0.60653065971f; const float* bias = bias4 + t * D; bf16_t* d = dst0 + (size_t)t * (SLOT_BYTES / 2);
#pragma unroll
        for (int bj = 0; bj < 2; ++bj) { const int col = (u.pn & 7) * 256 + bj * 128 + wc * 32 + 8 * fq; const f32x4 b0 = *(const f32x4*)(bias + col), b1 = *(const f32x4*)(bias + col + 4);
#pragma unroll
            for (int ai = 0; ai < 2; ++ai)
#pragma unroll
                for (int m = 0; m < 4; ++m) { const int row = u.pm * 256 + ai * 128 + wr * 64 + m * 16 + fr; const f32x4 x0 = acc[ai][bj][m][0] + b0, x1 = acc[ai][bj][m][1] + b1; f32x4 o0, o1;
#pragma unroll
                    for (int e = 0; e < 4; ++e) { o0[e] = sigmoidf_(x0[e]) * mul; o1[e] = sigmoidf_(x1[e]) * mul; }
                    st8bf(d + (size_t)row * D + col, o0, o1); } }
    }
};

struct EpiBf {
    static constexpr bool PERM = true, AFTER_DRAIN = false;
    bf16_t* O; int ldc;
    __device__ __forceinline__ void operator()(const Acc& acc, const Unit& u, int wr, int wc, int fr, int fq) const {
#pragma unroll
        for (int ai = 0; ai < 2; ++ai)
#pragma unroll
            for (int m = 0; m < 4; ++m) { const int row = u.pm * 256 + ai * 128 + wr * 64 + m * 16 + fr;
#pragma unroll
                for (int bj = 0; bj < 2; ++bj) st8bf(O + (size_t)row * ldc + u.pn * 256 + bj * 128 + wc * 32 + 8 * fq, acc[ai][bj][m][0], acc[ai][bj][m][1]); }
    }
};
struct EpiF32 {
    static constexpr bool PERM = false, AFTER_DRAIN = false;
    float* O; int ldc;
    __device__ __forceinline__ void operator()(const Acc& acc, const Unit& u, int wr, int wc, int fr, int fq) const {
#pragma unroll
        for (int ai = 0; ai < 2; ++ai)
#pragma unroll
            for (int m = 0; m < 4; ++m) { const int row = u.pm * 256 + ai * 128 + wr * 64 + m * 16 + fr;
#pragma unroll
                for (int bj = 0; bj < 2; ++bj)
#pragma unroll
                    for (int n = 0; n < 2; ++n) *(f32x4*)(O + (size_t)row * ldc + u.pn * 256 + bj * 128 + wc * 32 + n * 16 + 4 * fq) = acc[ai][bj][m][n]; }
    }
};
struct EpiGate {
    static constexpr bool PERM = false, AFTER_DRAIN = false;
    const bf16_t* yrw;
    const bf16_t* yhy;
    const float* yhc;
    bf16_t* y;
    __device__ __forceinline__ void operator()(const Acc& acc, const Unit& u, int wr, int wc, int fr, int fq) const {
        const bool lat = u.pm < TL / 256;
#pragma unroll
        for (int ai = 0; ai < 2; ++ai) {
            u32x2 rw[4][2]; float hy[4][2][4];
#pragma unroll
            for (int m = 0; m < 4; ++m) { const int row = u.pm * 256 + ai * 128 + wr * 64 + m * 16 + fr;
#pragma unroll
                for (int n = 0; n < 2; ++n) { const int ch = u.pn * 128 + wc * 32 + n * 16 + 4 * fq;
                    rw[m][n] = *(const u32x2*)(yrw + (size_t)row * D + ch);
                    if (lat) { const bf16_t* q = yhy + ((size_t)((row >> 14) * D + ch)) * SEQ + (row & (SEQ - 1));
#pragma unroll
                        for (int e = 0; e < 4; ++e) hy[m][n][e] = bf2f(q[(size_t)e * SEQ]); }
                    else { const int rc = row - TL; const float* q = yhc + ((size_t)((rc >> 8) * D + ch)) * CL + (rc & (CL - 1));
#pragma unroll
                        for (int e = 0; e < 4; ++e) hy[m][n][e] = q[(size_t)e * CL]; } } }
#pragma unroll
            for (int m = 0; m < 4; ++m) { const int row = u.pm * 256 + ai * 128 + wr * 64 + m * 16 + fr;
#pragma unroll
                for (int n = 0; n < 2; ++n) { const int ch = u.pn * 128 + wc * 32 + n * 16 + 4 * fq;
                    const float r4[4] = {bflo(rw[m][n].x), bfhi(rw[m][n].x), bflo(rw[m][n].y), bfhi(rw[m][n].y)};
                    f32x4 o;
#pragma unroll
                    for (int e = 0; e < 4; ++e) o[e] = sigmoidf_(acc[ai][0][m][n][e]) * r4[e] + sigmoidf_(acc[ai][1][m][n][e]) * hy[m][n][e];
                    st4bf(y + (size_t)row * D + ch, o); } }
        }
    }
};
struct EpiResid {
    static constexpr bool PERM = false, AFTER_DRAIN = false;
    float* xl; float* xc; const float* ga;
    const float* rl; const float* rc;
    __device__ __forceinline__ void operator()(const Acc& acc, const Unit& u, int wr, int wc, int fr, int fq) const {
        const int row00 = u.pm * 256 + wr * 64 + fr; const int mr = mrow_of(row00);
        const float* g = ga + (size_t)mr * 6 * D + u.pn * 256 + wc * 32 + 4 * fq;
        f32x4 gv[2][2];
#pragma unroll
        for (int bj = 0; bj < 2; ++bj)
#pragma unroll
            for (int n = 0; n < 2; ++n) gv[bj][n] = *(const f32x4*)(g + bj * 128 + n * 16);
#pragma unroll
        for (int ai = 0; ai < 2; ++ai)
#pragma unroll
            for (int mh = 0; mh < 2; ++mh) {
                f32x4 xv[2][2][2]; f32x4* qp[2];
#pragma unroll
                for (int mm = 0; mm < 2; ++mm) { const int row = row00 + ai * 128 + (2 * mh + mm) * 16;
                    const size_t ro = (row < TL ? (size_t)row * D : (size_t)(row - TL) * D) + u.pn * 256 + wc * 32 + 4 * fq;
                    float* xr = (row < TL ? xl : xc) + ro; qp[mm] = (f32x4*)xr; const float* xs = (row < TL ? rl : rc) + ro;
#pragma unroll
                    for (int bj = 0; bj < 2; ++bj)
#pragma unroll
                        for (int n = 0; n < 2; ++n) xv[mm][bj][n] = *(const f32x4*)(xs + bj * 128 + n * 16); }
#pragma unroll
                for (int mm = 0; mm < 2; ++mm)
#pragma unroll
                    for (int bj = 0; bj < 2; ++bj)
#pragma unroll
                        for (int n = 0; n < 2; ++n) *(f32x4*)((float*)qp[mm] + bj * 128 + n * 16) = xv[mm][bj][n] + gv[bj][n] * acc[ai][bj][2 * mh + mm][n]; }
    }
};

template <class Epi> __device__ __forceinline__ void run_gemm(const Params& p, unsigned char* lds, const bf16_t* A, int lda, const bf16_t* Bt, int ldb, int M, int N, int K, const Epi& E) {
    asm volatile("" : "+s"(M), "+s"(N), "+s"(K), "+s"(lda), "+s"(ldb));
    pg8::Gemm g{A, Bt, M, N, K, lda, ldb}; pg8::StaticOrder S; S.init(M, N, (int)p.nblk, (int)p.bid);
    pg8::gemm_phase<Epi, pg8::StaticOrder>((PG8_LAS unsigned char*)lds, g, S, E, p.tid);
}

template <int GROUP> __device__ __forceinline__ void ph_ctxconv(const Params& p) {
    constexpr int NC = GROUP == 0 ? NR : NHY;
    const float* cw = (const float*)(p.ws + WS_CONVW) + (GROUP == 0 ? 0 : NR);
    const bf16_t* pc = (const bf16_t*)(p.ws + WS_PCTX);
    const int items = TC * (NC / 4);
    for (int i = p.bid * NTHREADS + p.tid; i < items; i += p.nblk * NTHREADS) {
        const int rc = i / (NC / 4), colg = (i % (NC / 4)) * 4, t = rc & (CL - 1);
        const f32x4 w0 = *(const f32x4*)(cw + colg), w1 = *(const f32x4*)(cw + NTOT + colg), w2 = *(const f32x4*)(cw + 2 * NTOT + colg);
        const u32x2 c = *(const u32x2*)(pc + (size_t)rc * NR + colg);
        u32x2 a = (u32x2){0u, 0u}, b = (u32x2){0u, 0u};
        if (t > 0) a = *(const u32x2*)(pc + (size_t)(rc - 1) * NR + colg);
        if (t < CL - 1) b = *(const u32x2*)(pc + (size_t)(rc + 1) * NR + colg);
        const f32x4 pv = (f32x4){bflo(a.x), bfhi(a.x), bflo(a.y), bfhi(a.y)}, cu = (f32x4){bflo(c.x), bfhi(c.x), bflo(c.y), bfhi(c.y)}, nx = (f32x4){bflo(b.x), bfhi(b.x), bflo(b.y), bfhi(b.y)};
        const f32x4 o = w0 * pv + w1 * cu + w2 * nx;
        const int row = TL + rc;
        if (GROUP == 0) {
            if (colg < 3 * D) { bf16_t* d = slot(p, colg < D ? 0 : colg < 2 * D ? 1 : 2); st4bf(d + (size_t)row * D + (colg & (D - 1)), o); }
            else { const int cc = colg - 3 * D, blk = cc >> 7, oo = cc & 127; f32x4 v;
                if (oo < 96) { if (blk & 1) v = o; else { v[0] = tanhf_(o[0]); v[1] = tanhf_(o[1]); v[2] = tanhf_(o[2]); v[3] = tanhf_(o[3]); } }
                else if (blk < 2) { v[0] = sigmoidf_(o[0]); v[1] = sigmoidf_(o[1]); v[2] = sigmoidf_(o[2]); v[3] = sigmoidf_(o[3]); }
                else v = (f32x4){0.f, 0.f, 0.f, 0.f};
                st4bf((bf16_t*)(p.ws + WS_LORAIN) + (size_t)row * LORA_W + cc, v); }
        } else {
            float* d = (float*)(p.ws + WS_CV) + (size_t)(colg >> 11) * (NB * D * CL); const int c0 = colg & (D - 1), b_ = rc >> 8;
#pragma unroll
            for (int e = 0; e < 4; ++e) d[((size_t)(b_ * D + c0 + e)) * CL + t] = o[e];
        }
    }
}

constexpr int SC_CH = 32;
constexpr int SC_NCH = (CL + SEQ) / SC_CH;
constexpr int SC_BUF_F = 6 * SC_CH * 64;
__device__ __forceinline__ int scan_row(int b, int dir, int s) {
    if (s < CL) return TL + b * CL + (dir ? CL - 1 - s : s);
    const int t = s - CL; return b * SEQ + (dir ? SEQ - 1 - t : t);
}
__device__ __forceinline__ void ph_scan(const Params& p, int l, unsigned char* lds_raw) {
    float* lds = (float*)lds_raw;
    float* ybuf = lds + 2 * SC_BUF_F;
    const int tid = p.tid, tl = tid >> 4, jq = tid & 15, ip = tid >> 4;
    for (int unit = p.bid; unit < NB * NHEAD * 2; unit += p.nblk) {
        const int dir = unit & 1, h = (unit >> 1) & (NHEAD - 1), b = unit >> 6;
        const bf16_t* kb = slot(p, 0); const bf16_t* vb = slot(p, 1); const bf16_t* rb = slot(p, 2);
        bf16_t* lw = slot(p, 3 + 2 * dir); const bf16_t* ab = slot(p, 4 + 2 * dir);
        const int col0 = h * HN + 4 * jq;
        const f32x4 kkw = *(const f32x4*)(inp(p, I_KK) + l * D + col0), kaw = *(const f32x4*)(inp(p, I_KA) + l * D + col0);
        float S0[4] = {0.f, 0.f, 0.f, 0.f}, S1[4] = {0.f, 0.f, 0.f, 0.f};
        u32x2 gk, gv, gr, gw, ga;
        auto gload = [&](int c) { const size_t off = (size_t)scan_row(b, dir, c * SC_CH + tl) * D + col0;
            gk = *(const u32x2*)(kb + off); gv = *(const u32x2*)(vb + off); gr = *(const u32x2*)(rb + off); gw = *(const u32x2*)(lw + off); ga = *(const u32x2*)(ab + off); };
        auto gstage = [&](int buf) { float* B = lds + buf * SC_BUF_F + tl * 64 + 4 * jq;
            const f32x4 k4 = (f32x4){bflo(gk.x), bfhi(gk.x), bflo(gk.y), bfhi(gk.y)}, a4 = (f32x4){bflo(ga.x), bfhi(ga.x), bflo(ga.y), bfhi(ga.y)};
            const f32x4 w4 = (f32x4){__expf(bflo(gw.x)), __expf(bfhi(gw.x)), __expf(bflo(gw.y)), __expf(bfhi(gw.y))};
            const f32x4 kx = k4 * kkw; float ss = kx[0] * kx[0] + kx[1] * kx[1] + kx[2] * kx[2] + kx[3] * kx[3]; ss = red16(ss);
            const f32x4 kk = kx * rsqrtf(fmaxf(ss, 1e-24f));
            *(f32x4*)(B) = kk; *(f32x4*)(B + SC_CH * 64) = w4; *(f32x4*)(B + 2 * SC_CH * 64) = kk * a4; *(f32x4*)(B + 3 * SC_CH * 64) = k4 * ((a4 - 1.0f) * kaw + 1.0f);
            *(f32x4*)(B + 4 * SC_CH * 64) = (f32x4){bflo(gr.x), bfhi(gr.x), bflo(gr.y), bfhi(gr.y)}; *(f32x4*)(B + 5 * SC_CH * 64) = (f32x4){bflo(gv.x), bfhi(gv.x), bflo(gv.y), bfhi(gv.y)}; };
        __syncthreads();
        gload(0); gstage(0);
        __syncthreads();
        for (int c = 0; c < SC_NCH; ++c) {
            const int buf = c & 1;
            if (c + 1 < SC_NCH) gload(c + 1);
            if (c > 0) {
                const float* Y = ybuf + (buf ^ 1) * (SC_CH * 64) + tl * 64 + 4 * jq; const f32x4 yv = *(const f32x4*)Y;
                st4bf(lw + (size_t)scan_row(b, dir, (c - 1) * SC_CH + tl) * D + col0, yv); }
            const float* B = lds + buf * SC_BUF_F + 4 * jq; float* Yw = ybuf + buf * (SC_CH * 64);
#pragma unroll 4
            for (int s = 0; s < SC_CH; ++s) {
                const f32x4 kk = *(const f32x4*)(B + s * 64), w = *(const f32x4*)(B + SC_CH * 64 + s * 64), ka = *(const f32x4*)(B + 2 * SC_CH * 64 + s * 64),
                            kt = *(const f32x4*)(B + 3 * SC_CH * 64 + s * 64), rr = *(const f32x4*)(B + 4 * SC_CH * 64 + s * 64);
                const f32x2 vv = *(const f32x2*)(lds + buf * SC_BUF_F + 5 * SC_CH * 64 + s * 64 + 2 * ip);
                float d0 = S0[0] * kk[0] + S0[1] * kk[1] + S0[2] * kk[2] + S0[3] * kk[3];
                float d1 = S1[0] * kk[0] + S1[1] * kk[1] + S1[2] * kk[2] + S1[3] * kk[3];
                d0 = red16(d0); d1 = red16(d1);
#pragma unroll
                for (int e = 0; e < 4; ++e) { S0[e] = S0[e] * w[e] + vv.x * kt[e] - d0 * ka[e]; S1[e] = S1[e] * w[e] + vv.y * kt[e] - d1 * ka[e]; }
                float y0 = S0[0] * rr[0] + S0[1] * rr[1] + S0[2] * rr[2] + S0[3] * rr[3];
                float y1 = S1[0] * rr[0] + S1[1] * rr[1] + S1[2] * rr[2] + S1[3] * rr[3];
                y0 = red16(y0); y1 = red16(y1);
                if (jq == 0) *(f32x2*)(Yw + s * 64 + 2 * ip) = (f32x2){y0, y1};
            }
            if (c + 1 < SC_NCH) gstage(buf ^ 1);
            __syncthreads();
        }
        { const float* Y = ybuf + ((SC_NCH - 1) & 1) * (SC_CH * 64) + tl * 64 + 4 * jq; const f32x4 yv = *(const f32x4*)Y;
          st4bf(lw + (size_t)scan_row(b, dir, (SC_NCH - 1) * SC_CH + tl) * D + col0, yv); }
    }
}

__device__ __forceinline__ void ph_rwkv_out(const Params& p, int l, int M, unsigned char* lds_raw) {
    constexpr int RB = 8;
    float* sb = (float*)lds_raw;
    const int tid = p.tid, col = 4 * tid;
    const f32x4 lnw = *(const f32x4*)(inp(p, I_LNW) + l * D + col), lnb = *(const f32x4*)(inp(p, I_LNB) + l * D + col), rk = *(const f32x4*)(inp(p, I_RK) + l * D + col);
    const float* g2 = inp(p, I_G2) + (size_t)l * 64 * D;
    const bf16_t* kb = slot(p, 0); const bf16_t* vb = slot(p, 1); const bf16_t* rb = slot(p, 2); const bf16_t* yf = slot(p, 3); const bf16_t* yb = slot(p, 5);
    const bf16_t* lora = (const bf16_t*)(p.ws + WS_LORAIN); bf16_t* out = slot(p, 6);
    for (int row0 = p.bid * RB; row0 < M; row0 += p.nblk * RB) {
        __syncthreads();
        { const int r = tid >> 6, i = tid & 63; sb[i * RB + r] = bf2f(lora[(size_t)(row0 + r) * LORA_W + (i < 32 ? 96 + i : 224 + (i - 32))]); }
        __syncthreads();
        f32x4 g[RB];
#pragma unroll
        for (int r = 0; r < RB; ++r) g[r] = (f32x4){0.f, 0.f, 0.f, 0.f};
#pragma unroll 1
        for (int ib = 0; ib < 64; ib += 16) {
            f32x4 w[16];
#pragma unroll
            for (int i = 0; i < 16; ++i) w[i] = *(const f32x4*)(g2 + (size_t)(ib + i) * D + col);
#pragma unroll
            for (int i = 0; i < 16; ++i) { const f32x4 s0 = *(const f32x4*)(sb + (ib + i) * RB), s1 = *(const f32x4*)(sb + (ib + i) * RB + 4);
#pragma unroll
                for (int r = 0; r < 4; ++r) { g[r] += w[i] * s0[r]; g[4 + r] += w[i] * s1[r]; } } }
        u32x2 ya[RB], yb2[RB], kk2[RB], vv2[RB], rr2[RB];
#pragma unroll
        for (int r = 0; r < RB; ++r) { const size_t off = (size_t)(row0 + r) * D + col;
            ya[r] = *(const u32x2*)(yf + off); yb2[r] = *(const u32x2*)(yb + off); kk2[r] = *(const u32x2*)(kb + off); vv2[r] = *(const u32x2*)(vb + off); rr2[r] = *(const u32x2*)(rb + off); }
#pragma unroll
        for (int r = 0; r < RB; ++r) {
            const size_t off = (size_t)(row0 + r) * D + col;
            const u32x2 a = ya[r], b = yb2[r], k2 = kk2[r], v2 = vv2[r], r2 = rr2[r];
            const f32x4 y = (f32x4){bflo(a.x) + bflo(b.x), bfhi(a.x) + bfhi(b.x), bflo(a.y) + bflo(b.y), bfhi(a.y) + bfhi(b.y)};
            const f32x4 k4 = (f32x4){bflo(k2.x), bfhi(k2.x), bflo(k2.y), bfhi(k2.y)}, v4 = (f32x4){bflo(v2.x), bfhi(v2.x), bflo(v2.y), bfhi(v2.y)}, r4 = (f32x4){bflo(r2.x), bfhi(r2.x), bflo(r2.y), bfhi(r2.y)};
            const float mu = red16(y[0] + y[1] + y[2] + y[3]) * (1.0f / HN);
            const f32x4 dy = y - mu;
            const float var = red16(dy[0] * dy[0] + dy[1] * dy[1] + dy[2] * dy[2] + dy[3] * dy[3]) * (1.0f / HN);
            const f32x4 yn = dy * rsqrtf(var + GN_EPS) * lnw + lnb;
            const f32x4 rkk = r4 * k4 * rk;
            const float bon = red16(rkk[0] + rkk[1] + rkk[2] + rkk[3]);
            st4bf(out + off, (yn + v4 * bon) * g[r]);
        }
    }
}

constexpr int S3_NS = 5, S3_NCH = (CL + SEQ) / 16;
constexpr int S3_SLOT = 18432;
constexpr int S3_OXQ1 = 0, S3_OXY = 3328, S3_OKAP = 6656, S3_OVU = 11776, S3_OTX = 16896, S3_OG = 18176;
constexpr int S3_PSCR = 8192;
constexpr int S3_OAL = 0, S3_OKH = 2304, S3_OAF = 4608, S3_ORN = 5632;
constexpr int S3_CSCR = 3584;
constexpr int S3_RING = 0, S3_PBASE = S3_RING + S3_NS * S3_SLOT, S3_CBASE = S3_PBASE + 4 * S3_PSCR, S3_FLAGS = S3_CBASE + 4 * S3_CSCR, S3_END = S3_FLAGS + 64;
static_assert(S3_END <= LDS_BYTES - 64, "scan LDS layout");
constexpr unsigned S3_SPIN_CAP = 1u << 22;
typedef short bf16x8_t __attribute__((ext_vector_type(8)));
__device__ __forceinline__ bf16x8_t ldfrag(const bf16_t* p) { return *(const bf16x8_t*)p; }
__device__ __forceinline__ f32x4 mma(const bf16x8_t a, const bf16x8_t b, const f32x4 c) { return __builtin_amdgcn_mfma_f32_16x16x32_bf16(a, b, c, 0, 0, 0); }
__device__ __forceinline__ bf16_t cvbf(float x) { return (bf16_t)(pg8::cvt_pk_bf16(x, 0.f) & 0xFFFFu); }
#define S3_LGKM() asm volatile("s_waitcnt lgkmcnt(0)" ::: "memory")
__device__ __forceinline__ void ph_scan3(const Params& p, int l, unsigned char* lds) {
    const int tid = p.tid, lane = tid & 63, wid = __builtin_amdgcn_readfirstlane(tid >> 6), fr = lane & 15, fq = lane >> 4;
    LAS unsigned* flags = (LAS unsigned*)(lds + S3_FLAGS);
#define S3_FLD(i) __hip_atomic_load(flags + (i), __ATOMIC_RELAXED, __HIP_MEMORY_SCOPE_WORKGROUP)
#define S3_FST(i, v) __hip_atomic_store(flags + (i), (v), __ATOMIC_RELAXED, __HIP_MEMORY_SCOPE_WORKGROUP)
    const bf16_t* kb = slot(p, 0); const bf16_t* vb = slot(p, 1); const bf16_t* rb = slot(p, 2);
    const f32x4 zero4 = (f32x4){0.f, 0.f, 0.f, 0.f};
    for (int unit = p.bid; unit < NB * NHEAD * 2; unit += p.nblk) {
        const int dir = unit & 1, h = (unit >> 1) & (NHEAD - 1), b = unit >> 6;
        bf16_t* lwy = slot(p, 3 + 2 * dir); const bf16_t* ab = slot(p, 4 + 2 * dir);
        const long rstride = dir ? -(long)D : (long)D;
        __syncthreads();
        for (int i = tid; i < S3_END / 4; i += NTHREADS) ((unsigned*)lds)[i] = 0u;
        __syncthreads();
        if (wid >= 4) {
            const int pw = wid - 4;
            unsigned char* scr = lds + S3_PBASE + pw * S3_PSCR;
            bf16_t* AL = (bf16_t*)(scr + S3_OAL); bf16_t* KH = (bf16_t*)(scr + S3_OKH); float* AF = (float*)(scr + S3_OAF); float* RN = (float*)(scr + S3_ORN);
            const float kkj = inp(p, I_KK)[l * D + h * HN + lane], kaj = inp(p, I_KA)[l * D + h * HN + lane];
            const int rt = lane >> 2, rp = lane & 3;
            const float* kkp = inp(p, I_KK) + l * D + h * HN + 16 * rp;
            const f32x4 kc0 = *(const f32x4*)kkp, kc1 = *(const f32x4*)(kkp + 4), kc2 = *(const f32x4*)(kkp + 8), kc3 = *(const f32x4*)(kkp + 12);
            typedef unsigned short u16x2 __attribute__((ext_vector_type(2)));
            u16x2 kq[8], rq[8], lq[8], aq[8], vq[8]; u32x4 kn0, kn1;
#define S3_FETCH(cc, K_, R_, L_, A_, V_, N0_, N1_) do { const size_t o_ = (size_t)scan_row(b, dir, 16 * (cc)) * D + h * HN; \
                const bf16_t* kp_ = kb + o_ + lane; const bf16_t* rp_ = rb + o_ + lane; const bf16_t* lp_ = lwy + o_ + lane; const bf16_t* ap_ = ab + o_ + lane; const bf16_t* vp_ = vb + o_ + lane; \
                _Pragma("unroll") for (int t = 0; t < 16; ++t) { K_[t >> 1][t & 1] = *kp_; R_[t >> 1][t & 1] = *rp_; L_[t >> 1][t & 1] = *lp_; A_[t >> 1][t & 1] = *ap_; V_[t >> 1][t & 1] = *vp_; kp_ += rstride; rp_ += rstride; lp_ += rstride; ap_ += rstride; vp_ += rstride; } \
                const bf16_t* kr_ = kb + o_ + (long)rt * rstride + 16 * rp; N0_ = *(const u32x4*)kr_; N1_ = *(const u32x4*)(kr_ + 8); } while (0)
            S3_FETCH(pw, kq, rq, lq, aq, vq, kn0, kn1);
#pragma unroll 1
            for (int c = pw; c < S3_NCH; c += 4) {
                const int sl = c % S3_NS; unsigned char* sb = lds + S3_RING + sl * S3_SLOT;
                bf16_t* XQ1 = (bf16_t*)(sb + S3_OXQ1); bf16_t* XY = (bf16_t*)(sb + S3_OXY); bf16_t* KAP = (bf16_t*)(sb + S3_OKAP); bf16_t* VU = (bf16_t*)(sb + S3_OVU); bf16_t* TX = (bf16_t*)(sb + S3_OTX); float* G = (float*)(sb + S3_OG);
                u16x2 kq2[8], rq2[8], lq2[8], aq2[8], vq2[8]; u32x4 kn2, kn3;
                { const int cn = c + 4 < S3_NCH ? c + 4 : c; S3_FETCH(cn, kq2, rq2, lq2, aq2, vq2, kn2, kn3); }
                { const u32x4 w0 = kn0, w1 = kn1;
                  const float x0 = bflo(w0[0]) * kc0[0], x1 = bfhi(w0[0]) * kc0[1], x2 = bflo(w0[1]) * kc0[2], x3 = bfhi(w0[1]) * kc0[3], x4 = bflo(w0[2]) * kc1[0], x5 = bfhi(w0[2]) * kc1[1], x6 = bflo(w0[3]) * kc1[2], x7 = bfhi(w0[3]) * kc1[3];
                  const float y0 = bflo(w1[0]) * kc2[0], y1 = bfhi(w1[0]) * kc2[1], y2 = bflo(w1[1]) * kc2[2], y3 = bfhi(w1[1]) * kc2[3], y4 = bflo(w1[2]) * kc3[0], y5 = bfhi(w1[2]) * kc3[1], y6 = bflo(w1[3]) * kc3[2], y7 = bfhi(w1[3]) * kc3[3];
                  float ss = x0 * x0 + x1 * x1 + x2 * x2 + x3 * x3 + x4 * x4 + x5 * x5 + x6 * x6 + x7 * x7 + y0 * y0 + y1 * y1 + y2 * y2 + y3 * y3 + y4 * y4 + y5 * y5 + y6 * y6 + y7 * y7;
                  ss += dppf<0xB1>(ss); ss += dppf<0x4E>(ss);
                  if (rp == 0) RN[rt] = rsqrtf(fmaxf(ss, 1e-24f)); }
                if (c >= S3_NS) { const unsigned need = (unsigned)(c - S3_NS + 1); unsigned sp = 0;
                    for (;;) { const unsigned m0 = S3_FLD(8), m1 = S3_FLD(9), m2 = S3_FLD(10), m3 = S3_FLD(11); const unsigned mn = min(min(m0, m1), min(m2, m3));
                        if (mn >= need || ++sp > S3_SPIN_CAP) break; __builtin_amdgcn_s_sleep(1); } }
                asm volatile("" ::: "memory");
                S3_LGKM();
                { float cl[16]; float run = 0.f;
#pragma unroll
                  for (int t = 0; t < 16; ++t) { run += bf2f(lq[t >> 1][t & 1]); cl[t] = run; }
                  const float cend = cl[15], gend = __expf(cend); G[lane] = gend;
                  unsigned kp[8], ap[8], vv[8]; float epm1 = 1.0f;
#pragma unroll
                  for (int t = 0; t < 16; ++t) {
                      const float em = __expf(-cl[t]), ep = __builtin_amdgcn_rcpf(em), ee = gend * em;
                      const float kv = bf2f(kq[t >> 1][t & 1]), a = bf2f(aq[t >> 1][t & 1]), kap = kv * kkj * RN[t], al = a * kap, kt = kv * (1.0f + (a - 1.0f) * kaj);
                      XQ1[t * 104 + lane] = cvbf(epm1 * kap); AL[t * 72 + lane] = cvbf(al * em); KH[t * 72 + lane] = cvbf(kt * em); XY[t * 104 + lane] = cvbf(bf2f(rq[t >> 1][t & 1]) * ep);
                      const unsigned kpb = cvbf(kt * ee), apb = cvbf(al * ee);
                      if (t & 1) { kp[t >> 1] |= kpb << 16; ap[t >> 1] |= apb << 16; } else { kp[t >> 1] = kpb; ap[t >> 1] = apb; vv[t >> 1] = __builtin_bit_cast(unsigned, vq[t >> 1]); }
                      epm1 = ep; }
                  u32x4* d = (u32x4*)(KAP + lane * 40);
                  d[0] = (u32x4){kp[0], kp[1], kp[2], kp[3]}; d[1] = (u32x4){kp[4], kp[5], kp[6], kp[7]}; d[2] = (u32x4){ap[0], ap[1], ap[2], ap[3]}; d[3] = (u32x4){ap[4], ap[5], ap[6], ap[7]};
                  u32x4* dv = (u32x4*)(VU + lane * 40); dv[0] = (u32x4){vv[0], vv[1], vv[2], vv[3]}; dv[1] = (u32x4){vv[4], vv[5], vv[6], vv[7]}; }
                S3_LGKM();
                { const bf16_t* Xk = XQ1 + fr * 104 + 8 * fq; const bf16_t* Xr = XY + fr * 104 + 8 * fq; const bf16_t* Ya = AL + fr * 72 + 8 * fq; const bf16_t* Yk = KH + fr * 72 + 8 * fq;
                  f32x4 dA = zero4, dB = zero4, dE = zero4, dF = zero4;
#pragma unroll
                  for (int ks = 0; ks < 2; ++ks) { const bf16x8_t xk = ldfrag(Xk + 32 * ks), xr = ldfrag(Xr + 32 * ks), ya = ldfrag(Ya + 32 * ks), yk = ldfrag(Yk + 32 * ks);
                      dA = mma(xk, ya, dA); dB = mma(xk, yk, dB); dE = mma(xr, yk, dE); dF = mma(xr, ya, dF); }
#pragma unroll
                  for (int e = 0; e < 4; ++e) { const int t = 4 * fq + e; const bool lo = fr < t, le = fr <= t;
                      dA[e] = lo ? dA[e] : 0.f; XQ1[t * 104 + 64 + fr] = cvbf(lo ? dB[e] : 0.f); XY[t * 104 + 64 + fr] = cvbf(le ? dE[e] : 0.f); XY[t * 104 + 80 + fr] = cvbf(le ? dF[e] : 0.f); }
                  float tc[16];
#pragma unroll
                  for (int t = 0; t < 16; ++t) { float v0 = (t == fr) ? 1.0f : 0.0f, v1 = 0.f;
#pragma unroll
                      for (int s = 0; s < t; ++s) { const float a = rdlane(dA[t & 3], 16 * (t >> 2) + s); if (s & 1) v1 -= a * tc[s]; else v0 -= a * tc[s]; }
                      tc[t] = v0 + v1; }
                  if (fq == 0) {
#pragma unroll
                      for (int t = 0; t < 16; ++t) TX[t * 40 + fr] = cvbf(tc[t]); } }
                S3_LGKM();
                if (lane == 0) S3_FST(sl, (unsigned)(c + 1));
#pragma unroll
                for (int t = 0; t < 8; ++t) { kq[t] = kq2[t]; rq[t] = rq2[t]; lq[t] = lq2[t]; aq[t] = aq2[t]; vq[t] = vq2[t]; }
                kn0 = kn2; kn1 = kn3;
            }
#undef S3_FETCH
        } else {
            const int it = wid;
            unsigned char* scr = lds + S3_CBASE + it * S3_CSCR;
            bf16_t* SB = (bf16_t*)scr; bf16_t* RT = (bf16_t*)(scr + 2304);
            f32x4 Sacc[4] = {zero4, zero4, zero4, zero4};
#pragma unroll 1
            for (int c = 0; c < S3_NCH; ++c) {
                const int sl = c % S3_NS; unsigned char* sb = lds + S3_RING + sl * S3_SLOT;
                const bf16_t* XQ1 = (const bf16_t*)(sb + S3_OXQ1); const bf16_t* XY = (const bf16_t*)(sb + S3_OXY); const bf16_t* KAP = (const bf16_t*)(sb + S3_OKAP); bf16_t* VU = (bf16_t*)(sb + S3_OVU); const bf16_t* TX = (const bf16_t*)(sb + S3_OTX); const float* G = (const float*)(sb + S3_OG);
                { unsigned sp = 0; while (S3_FLD(sl) != (unsigned)(c + 1)) { if (++sp > S3_SPIN_CAP) break; __builtin_amdgcn_s_sleep(1); } }
                asm volatile("" ::: "memory");
                const bf16_t* Ys = SB + fr * 72 + 8 * fq; bf16_t* VUr = VU + (16 * it + fr) * 40;
                { const bf16_t* X = XQ1 + fr * 104 + 8 * fq;
                  f32x4 d = mma(ldfrag(X), ldfrag(Ys), zero4); d = mma(ldfrag(X + 32), ldfrag(Ys + 32), d); d = mma(ldfrag(X + 64), ldfrag(VUr + 8 * fq), d);
                  *(u32x2*)(RT + fr * 40 + 4 * fq) = (u32x2){pg8::cvt_pk_bf16(d[0], d[1]), pg8::cvt_pk_bf16(d[2], d[3])}; }
                S3_LGKM();
                { const f32x4 d = mma(ldfrag(TX + fr * 40 + 8 * fq), ldfrag(RT + fr * 40 + 8 * fq), zero4);
                  *(u32x2*)(VUr + 16 + 4 * fq) = (u32x2){pg8::cvt_pk_bf16(-d[0], -d[1]), pg8::cvt_pk_bf16(-d[2], -d[3])}; }
                S3_LGKM();
                const bf16x8_t vu = ldfrag(VUr + 8 * fq);
                { const bf16_t* X = XY + fr * 104 + 8 * fq;
                  f32x4 d = mma(ldfrag(X), ldfrag(Ys), zero4); d = mma(ldfrag(X + 32), ldfrag(Ys + 32), d); d = mma(ldfrag(X + 64), vu, d);
                  bf16_t* yo = lwy + (size_t)scan_row(b, dir, 16 * c + 4 * fq) * D + h * HN + 16 * it + fr;
#pragma unroll
                  for (int e = 0; e < 4; ++e) { *yo = cvbf(d[e]); yo += rstride; } }
#pragma unroll
                for (int jt = 0; jt < 4; ++jt) Sacc[jt] = mma(vu, ldfrag(KAP + (16 * jt + fr) * 40 + 8 * fq), Sacc[jt] * G[16 * jt + fr]);
#pragma unroll
                for (int jt = 0; jt < 4; ++jt)
#pragma unroll
                    for (int e = 0; e < 4; ++e) SB[(4 * fq + e) * 72 + 16 * jt + fr] = cvbf(Sacc[jt][e]);
                S3_LGKM();
                if (lane == 0) S3_FST(8 + it, (unsigned)(c + 1));
            }
        }
    }
    __syncthreads();
}

__device__ __forceinline__ float hy_delta(int c) { return 3.0701134573f + (float)c * ((15.3505672866f - 3.0701134573f) / 2047.0f); }
__device__ __forceinline__ void ph_ctxfilter(const Params& p, int l) {
    const bf16_t* hd = (const bf16_t*)(p.ws + WS_HDNC); const float* w3 = inp(p, I_HW3) + (size_t)l * 64 * 8192; float* hcf = (float*)(p.ws + WS_HCF);
    const int gt = p.bid * NTHREADS + p.tid, GT = p.nblk * NTHREADS;
    if (GT % 8192 == 0) {
        const int col = gt % 8192; float wc[64];
#pragma unroll
        for (int k = 0; k < 64; ++k) wc[k] = w3[(size_t)k * 8192 + col];
        const float dl = hy_delta(col & (D - 1));
        for (int n = gt / 8192; n < CL; n += GT / 8192) { u32x4 hv[8];
#pragma unroll
            for (int k8 = 0; k8 < 8; ++k8) hv[k8] = *(const u32x4*)(hd + n * 256 + 8 * k8);
            float s = 0.f;
#pragma unroll
            for (int k8 = 0; k8 < 8; ++k8)
#pragma unroll
                for (int e = 0; e < 4; ++e) s += bflo(hv[k8][e]) * wc[8 * k8 + 2 * e] + bfhi(hv[k8][e]) * wc[8 * k8 + 2 * e + 1];
            hcf[(size_t)col * CL + n] = s * __expf(-((float)n / (float)(CL - 1)) * dl); }
    } else {
        for (int i = gt; i < 8192 * CL; i += GT) {
            const int col = i % 8192, n = i / 8192; float s = 0.f;
            for (int k = 0; k < 64; ++k) s += bf2f(hd[n * 256 + k]) * w3[(size_t)k * 8192 + col];
            hcf[(size_t)col * CL + n] = s * __expf(-((float)n / (float)(CL - 1)) * hy_delta(col & (D - 1))); }
    }
}
__device__ __forceinline__ void ph_ctxhyena(const Params& p, int l, unsigned char* lds_raw) {
    const int lane = p.tid & 63, wid = p.tid >> 6, wv = p.bid * 8 + wid, NW = p.nblk * 8;
    float* L = (float*)lds_raw + wid * 768;
    const float* hcf = (const float*)(p.ws + WS_HCF); const float* cv = (const float*)(p.ws + WS_CV); float* yhc = (float*)(p.ws + WS_YHC);
    for (int u = wv; u < NB * D; u += NW) {
        const int c = u & (D - 1), b = u >> 11;
        f32x4 z = *(const f32x4*)(cv + ((size_t)(b * D + c)) * CL + 4 * lane);
#pragma unroll
        for (int o = 0; o < 2; ++o) {
            const f32x4 f = *(const f32x4*)(hcf + ((size_t)((o * 2 + 0) * D + c)) * CL + 4 * lane), g = *(const f32x4*)(hcf + ((size_t)((o * 2 + 1) * D + c)) * CL + 4 * lane);
            float ss = 0.f;
#pragma unroll
            for (int i = 0; i < 4; ++i) { const int n = 4 * lane + i; if (n == 0) L[256 + 255] = f[i] + g[i]; else { L[256 + 255 - n] = f[i]; L[256 + 255 + n] = g[i]; } ss += f[i] * f[i] + g[i] * g[i]; }
            *(f32x4*)(L + 4 * lane) = z;
            ss = wave_sum(ss); const float rn = rsqrtf(ss);
            const float sk = inp(p, I_HSKIP)[(l * 2 + o) * D + c];
            const float* gate = cv + (size_t)(o + 1) * (NB * D * CL) + ((size_t)(b * D + c)) * CL;
            f32x4 acc = (f32x4){0.f, 0.f, 0.f, 0.f};
            const float* hb = L + 256 + 252 - 4 * lane;
#pragma unroll 4
            for (int s0 = 0; s0 < CL; s0 += 4) { const f32x4 us = *(const f32x4*)(L + s0), wa = *(const f32x4*)(hb + s0), wb = *(const f32x4*)(hb + s0 + 4);
                const float W[8] = {wa[0], wa[1], wa[2], wa[3], wb[0], wb[1], wb[2], wb[3]};
#pragma unroll
                for (int i = 0; i < 4; ++i)
#pragma unroll
                    for (int q = 0; q < 4; ++q) acc[i] += W[3 - i + q] * us[q]; }
            const f32x4 gt = *(const f32x4*)(gate + 4 * lane);
            z = gt * (acc * rn + z * sk);
        }
        *(f32x4*)(yhc + ((size_t)(b * D + c)) * CL + 4 * lane) = z;
    }
}

__device__ __forceinline__ f32x2 cmul(const f32x2 a, const f32x2 b) {
    const f32x2 t = a * __builtin_shufflevector(b, b, 0, 0);
    return __builtin_elementwise_fma(__builtin_shufflevector(a, a, 1, 0), (f32x2){-b.y, b.y}, t); }
__device__ __forceinline__ f32x2 cconj(const f32x2 a) { return (f32x2){a.x, -a.y}; }
template <bool INV> __device__ __forceinline__ void dft4(f32x2& a, f32x2& b, f32x2& c, f32x2& d) {
    const f32x2 s0 = a + c, s1 = a - c, s2 = b + d, s3 = b - d;
    const f32x2 r = __builtin_shufflevector(s3, s3, 1, 0); const f32x2 sg = INV ? (f32x2){-1.f, 1.f} : (f32x2){1.f, -1.f};
    a = s0 + s2; c = s0 - s2; b = __builtin_elementwise_fma(r, sg, s1); d = __builtin_elementwise_fma(r, -sg, s1);
}
template <bool INV> __device__ __forceinline__ void dft16(f32x2 (&x)[16]) {
    constexpr float C[10] = {1.f, 0.92387953251f, 0.70710678119f, 0.38268343237f, 0.f, 0.f, -0.70710678119f, 0.f, 0.f, -0.92387953251f};
    constexpr float S[10] = {0.f, 0.38268343237f, 0.70710678119f, 0.92387953251f, 1.f, 0.f, 0.70710678119f, 0.f, 0.f, -0.38268343237f};
#pragma unroll
    for (int n1 = 0; n1 < 4; ++n1) dft4<INV>(x[n1], x[n1 + 4], x[n1 + 8], x[n1 + 12]);
#pragma unroll
    for (int n1 = 1; n1 < 4; ++n1)
#pragma unroll
        for (int k2 = 1; k2 < 4; ++k2) { const int m = n1 * k2; x[n1 + 4 * k2] = cmul(x[n1 + 4 * k2], (f32x2){C[m], INV ? S[m] : -S[m]}); }
#pragma unroll
    for (int k2 = 0; k2 < 4; ++k2) dft4<INV>(x[4 * k2], x[4 * k2 + 1], x[4 * k2 + 2], x[4 * k2 + 3]);
    f32x2 y[16];
#pragma unroll
    for (int k1 = 0; k1 < 4; ++k1)
#pragma unroll
        for (int k2 = 0; k2 < 4; ++k2) y[4 * k1 + k2] = x[4 * k2 + k1];
#pragma unroll
    for (int k = 0; k < 16; ++k) x[k] = y[k];
}
__device__ __forceinline__ int zpad(int pidx) { return pidx + 2 * (pidx >> 4); }
constexpr int ZN = 18432;

__device__ __forceinline__ f32x2 twf(int j) { float x = (float)j * (1.0f / 32768.0f); asm volatile("" : "+v"(x));
    return (f32x2){__builtin_amdgcn_cosf(x), -__builtin_amdgcn_sinf(x)}; }
struct HyRaw { f32x2 a, b, c; unsigned w; unsigned short s0, s1, s2, s3; };
template <bool INV> __device__ __forceinline__ void dft32(f32x2 (&x)[32]) {
    constexpr float C[16] = {1.f, 0.98078528040f, 0.92387953251f, 0.83146961230f, 0.70710678119f, 0.55557023302f, 0.38268343237f, 0.19509032202f,
                             0.f, -0.19509032202f, -0.38268343237f, -0.55557023302f, -0.70710678119f, -0.83146961230f, -0.92387953251f, -0.98078528040f};
    constexpr float S[16] = {0.f, 0.19509032202f, 0.38268343237f, 0.55557023302f, 0.70710678119f, 0.83146961230f, 0.92387953251f, 0.98078528040f,
                             1.f, 0.98078528040f, 0.92387953251f, 0.83146961230f, 0.70710678119f, 0.55557023302f, 0.38268343237f, 0.19509032202f};
    f32x2 e[16], o[16];
#pragma unroll
    for (int k = 0; k < 16; ++k) { e[k] = x[2 * k]; o[k] = x[2 * k + 1]; }
    __builtin_amdgcn_sched_barrier(0); dft16<INV>(e); __builtin_amdgcn_sched_barrier(0); dft16<INV>(o); __builtin_amdgcn_sched_barrier(0);
#pragma unroll
    for (int k = 0; k < 16; ++k) { const f32x2 t = cmul(o[k], (f32x2){C[k], INV ? S[k] : -S[k]}); x[k] = e[k] + t; x[k + 16] = e[k] - t; }
}
template <class Ld, class Mk> __device__ __forceinline__ void fft_fwdA(f32x2* Z, int tid, Ld ld, Mk mk) {
    __syncthreads();
    asm volatile("" : "+v"(tid));
    f32x2 x[32];
#pragma unroll
    for (int h = 0; h < 2; ++h) { HyRaw raw[16];
#pragma unroll
      for (int i = 0; i < 16; ++i) raw[i] = ld((16 * h + i) * 512 + tid);
#pragma unroll
      for (int i = 0; i < 16; ++i) x[16 * h + i] = mk((16 * h + i) * 512 + tid, raw[i]);
      __builtin_amdgcn_sched_barrier(0); }
    dft32<false>(x);
    const f32x2 w1 = twf(2 * tid); f32x2 wk = w1;
    Z[zpad(tid)] = x[0];
#pragma unroll
    for (int k = 1; k < 32; ++k) { Z[zpad(k * 512 + tid)] = cmul(x[k], wk); wk = cmul(wk, w1); }
    __syncthreads();
}
__device__ __forceinline__ void fft_fwdB(f32x2* Z, int tid) {
    asm volatile("" : "+v"(tid));
    const int blk = tid >> 4, n2 = tid & 15, base = blk * 512 + n2;
    const f32x2 w1 = twf(64 * n2);
    f32x2 x[32];
#pragma unroll
    for (int n1 = 0; n1 < 32; ++n1) x[n1] = Z[zpad(base + n1 * 16)];
    dft32<false>(x);
    f32x2 wk = w1;
    Z[zpad(base)] = x[0];
#pragma unroll
    for (int k = 1; k < 32; ++k) { Z[zpad(base + k * 16)] = cmul(x[k], wk); wk = cmul(wk, w1); }
    __syncthreads();
}
__device__ __forceinline__ void fft_invB(f32x2* Z, int tid) {
    asm volatile("" : "+v"(tid));
    const int blk = tid >> 4, n2 = tid & 15, base = blk * 512 + n2;
    const f32x2 w1 = cconj(twf(64 * n2)); f32x2 wk = w1;
    f32x2 x[32];
    x[0] = Z[zpad(base)];
#pragma unroll
    for (int k = 1; k < 32; ++k) { x[k] = cmul(Z[zpad(base + k * 16)], wk); wk = cmul(wk, w1); }
    dft32<true>(x);
#pragma unroll
    for (int n1 = 0; n1 < 32; ++n1) Z[zpad(base + n1 * 16)] = x[n1];
    __syncthreads();
}
__device__ __forceinline__ unsigned cpk(const f32x2 v) { return pg8::cvt_pk_bf16(v.x, v.y); }
__device__ __forceinline__ f32x2 cunpk(unsigned w) { return (f32x2){bflo(w), bfhi(w)}; }
__device__ __forceinline__ void fft_fwd_rest_to_stash(f32x2* Z, int tid, unsigned (&g)[32]) {
    fft_fwdB(Z, tid);
    asm volatile("" : "+v"(tid));
#pragma unroll
    for (int j = 0; j < 2; ++j) { const int q = tid + 512 * j; f32x2 x[16];
#pragma unroll
        for (int n1 = 0; n1 < 16; ++n1) x[n1] = Z[18 * q + n1];
        dft16<false>(x);
#pragma unroll
        for (int k = 0; k < 16; ++k) g[j * 16 + k] = cpk(x[k]);
        __builtin_amdgcn_sched_barrier(0); }
}
template <class Ld, class Out> __device__ __forceinline__ void fft_conv_rest(f32x2* Z, int tid, const unsigned (&g)[32], Ld ld, Out out) {
    fft_fwdB(Z, tid);
    asm volatile("" : "+v"(tid));
#pragma unroll
    for (int j = 0; j < 2; ++j) { const int q = tid + 512 * j; f32x2 x[16];
#pragma unroll
        for (int n1 = 0; n1 < 16; ++n1) x[n1] = Z[18 * q + n1];
        dft16<false>(x);
#pragma unroll
        for (int k = 0; k < 16; ++k) x[k] = cmul(x[k], cunpk(g[j * 16 + k]));
        dft16<true>(x);
#pragma unroll
        for (int n1 = 0; n1 < 16; ++n1) Z[18 * q + n1] = x[n1];
        __builtin_amdgcn_sched_barrier(0); }
    __syncthreads();
    fft_invB(Z, tid);
    asm volatile("" : "+v"(tid));
    { const f32x2 w1 = cconj(twf(2 * tid)); f32x2 wk = w1; f32x2 x[32];
      x[0] = Z[zpad(tid)];
#pragma unroll
      for (int k = 1; k < 32; ++k) { x[k] = cmul(Z[zpad(k * 512 + tid)], wk); wk = cmul(wk, w1); }
      dft32<true>(x);
#pragma unroll
      for (int h = 0; h < 4; ++h) { HyRaw raw[8];
#pragma unroll
          for (int i = 0; i < 8; ++i) raw[i] = ld((8 * h + i) * 512 + tid);
#pragma unroll
          for (int i = 0; i < 8; ++i) out(8 * h + i, (8 * h + i) * 512 + tid, x[8 * h + i], raw[i]);
          __builtin_amdgcn_sched_barrier(0); } }
}

template <int O> __device__ __forceinline__ void hy_order(const Params& p, int l, int c, f32x2* Z, float* red, const f32x2* tw, int tid, const bf16_t* Ht, bf16_t* hv, const bf16_t* gate, unsigned* zs) {
    unsigned gs[32];
    const float delta = hy_delta(c);
    const size_t cb0 = ((size_t)(0 * D + c)) * SEQ, cb1 = ((size_t)(1 * D + c)) * SEQ;
    const bf16_t* fw = Ht + ((size_t)((O * 2 + 0) * D + c)) * SEQ; const bf16_t* bw = Ht + ((size_t)((O * 2 + 1) * D + c)) * SEQ;
    float ssq = 0.f;
    auto ld_filt = [=](int n) { HyRaw r{}; const int nb = n == 0 ? 0 : SEQ - n; r.s0 = fw[n]; r.s1 = bw[nb]; return r; };

    auto ld_z = [=](int n) { HyRaw r{}; if (O == 0) { r.s0 = hv[cb0 + n]; r.s1 = hv[cb1 + n]; } else r.w = zs[n]; return r; };

    auto zval = [=](const HyRaw& r) { return O == 0 ? (f32x2){bf2f(r.s0), bf2f(r.s1)} : cunpk(r.w); };
    fft_fwdA(Z, tid, ld_filt, [&](int n, const HyRaw& r) { const int nb = n == 0 ? 0 : SEQ - n;
        const float f = bf2f(r.s0) * __expf(-((float)n * (1.0f / (SEQ - 1))) * delta), g = bf2f(r.s1) * __expf(-((float)nb * (1.0f / (SEQ - 1))) * delta);
        ssq += f * f + g * g; return (f32x2){f + g, 0.f}; });
    fft_fwd_rest_to_stash(Z, tid, gs);
    ssq = wave_sum(ssq); if ((tid & 63) == 0) red[tid >> 6] = ssq;
    fft_fwdA(Z, tid, ld_z, [=](int, const HyRaw& r) { return zval(r); });
    float tot = 0.f;
#pragma unroll
    for (int w = 0; w < 8; ++w) tot += red[w];
    const float scale = 0.5f * (1.0f / SEQ) * rsqrtf(tot);
    unsigned rsv[32];
    fft_conv_rest(Z, tid, gs, [=](int) { return HyRaw{}; }, [&](int i, int, f32x2 val, const HyRaw&) { rsv[i] = cpk(val * scale); });
    fft_fwdA(Z, tid, ld_filt, [=](int n, const HyRaw& r) { const int nb = n == 0 ? 0 : SEQ - n;
        const float f = bf2f(r.s0) * __expf(-((float)n * (1.0f / (SEQ - 1))) * delta), g = bf2f(r.s1) * __expf(-((float)nb * (1.0f / (SEQ - 1))) * delta);
        const float gd = n == 0 ? f + g : f - g; const f32x2 w = twf(n); return (f32x2){gd * w.x, gd * w.y}; });
    fft_fwd_rest_to_stash(Z, tid, gs);
    fft_fwdA(Z, tid, ld_z, [=](int n, const HyRaw& r) { return cmul(zval(r), twf(n)); });
    const float sk = inp(p, I_HSKIP)[(l * 2 + O) * D + c];
    fft_conv_rest(Z, tid, gs,
        [=](int n) { HyRaw r{}; if (O == 0) { r.s0 = hv[cb0 + n]; r.s1 = hv[cb1 + n]; } else r.w = zs[n]; r.s2 = gate[cb0 + n]; r.s3 = gate[cb1 + n]; return r; },
        [&](int i, int n, f32x2 val, const HyRaw& r) {
            const f32x2 cv = cunpk(rsv[i]) + cmul(val, cconj(twf(n))) * scale;
            const f32x2 zz = zval(r);
            const f32x2 res = (f32x2){bf2f(r.s2) * (cv.x + zz.x * sk), bf2f(r.s3) * (cv.y + zz.y * sk)};
            if (O == 0) zs[n] = cpk(res); else { hv[cb0 + n] = f2bf(res.x); hv[cb1 + n] = f2bf(res.y); } });
}

__device__ __forceinline__ void ph_hyena(const Params& p, int l, unsigned char* lds_raw) {
    f32x2* Z = (f32x2*)lds_raw; float* red = (float*)(lds_raw + (size_t)ZN * 8);
    const f32x2* tw = (const f32x2*)(p.ws + WS_TW);
    const int tid = p.tid;
    const bf16_t* Ht = (const bf16_t*)slot(p, 3);
    bf16_t* hv = slot(p, 0); const bf16_t* hx1 = slot(p, 1); const bf16_t* hx2 = slot(p, 2);
    unsigned* zs = (unsigned*)slot(p, 5) + (size_t)p.bid * SEQ;
#pragma unroll 1
    for (int c = p.bid; c < D; c += p.nblk) {
        hy_order<0>(p, l, c, Z, red, tw, tid, Ht, hv, hx1, zs);
        hy_order<1>(p, l, c, Z, red, tw, tid, Ht, hv, hx2, zs);
    }
}

constexpr float PEER_USCALE = 128.0f, PEER_VSCALE = 8.0f;
__device__ __forceinline__ void ph_prep2(const Params& p, int l, int M) {
    norm_rows(p, inp(p, I_N2G) + l * D, l, 3, 4, M);
}

__constant__ unsigned char c_cand[50] = {
    0x00,0x01,0x02,0x03,0x04,0x05,0x06,0x07,0x08,0x09,0x0A,0x0B,0x0C,0x0D,0x0E,0x0F, 0x10,0x11,0x12,0x13,0x14,0x15,0x16,0x17, 0x20,0x21,0x22,0x23,0x24, 0x30,0x31,0x32,0x33,
    0x40,0x41,0x42, 0x50,0x51, 0x60,0x61, 0x70,0x71, 0x80,0x90,0xA0,0xB0,0xC0,0xD0,0xE0,0xF0};
__device__ __forceinline__ unsigned fkey(float x) { const unsigned u = __float_as_uint(x); return (u & 0x80000000u) ? ~u : (u | 0x80000000u); }
__device__ __forceinline__ int mbcnt64(unsigned long long m) { return (int)__builtin_amdgcn_mbcnt_hi((unsigned)(m >> 32), __builtin_amdgcn_mbcnt_lo((unsigned)m, 0u)); }
__device__ __forceinline__ void ph_topk(const Params& p, int M, unsigned char* lds_raw) {
    constexpr int U = 2;
    const int lane = p.tid & 63, wid = p.tid >> 6, wv = p.bid * 8 + wid, NW = p.nblk * 8, total = M * 8;
    const float* sc = (const float*)slot(p, 3); int* idx = (int*)slot(p, 2); float* gate = (float*)slot(p, 2) + (size_t)MR * 128;
    const int cand_ab = lane < 50 ? (int)c_cand[lane] : 0;
    float fn[U][4];
#pragma unroll
    for (int u = 0; u < U; ++u) { int it0 = wv + u * NW; it0 = it0 < total ? it0 : wv; if (wv < total) { const float* s = sc + (size_t)(it0 >> 3) * D + (it0 & 7) * 256;
#pragma unroll
        for (int j = 0; j < 4; ++j) fn[u][j] = s[lane + 64 * j]; } }
    for (int it = wv; it < total; it += U * NW) {
        int itu[U]; float f[U][4]; unsigned k[U][4];
#pragma unroll
        for (int u = 0; u < U; ++u) { itu[u] = it + u * NW < total ? it + u * NW : it;
#pragma unroll
            for (int j = 0; j < 4; ++j) { f[u][j] = fn[u][j]; k[u][j] = fkey(f[u][j]); } }
#pragma unroll
        for (int u = 0; u < U; ++u) { int itn = itu[u] + U * NW; itn = itn < total ? itn : itu[u]; const float* s = sc + (size_t)(itn >> 3) * D + (itn & 7) * 256;
#pragma unroll
            for (int j = 0; j < 4; ++j) fn[u][j] = s[lane + 64 * j]; }
        unsigned th[U][2];
#pragma unroll
        for (int u = 0; u < U; ++u) { th[u][0] = 0u; th[u][1] = 0u; }
#pragma unroll
        for (int bit = 31; bit >= 16; --bit)
#pragma unroll
            for (int u = 0; u < U; ++u)
#pragma unroll
                for (int pp = 0; pp < 2; ++pp) { const unsigned c = th[u][pp] | (1u << bit);
                    const int n = __popcll(__ballot(k[u][2 * pp] >= c)) + __popcll(__ballot(k[u][2 * pp + 1] >= c)); th[u][pp] = n >= 16 ? c : th[u][pp]; }
#pragma unroll
        for (int u = 0; u < U; ++u)
#pragma unroll
            for (int pp = 0; pp < 2; ++pp) {
                const bool more = __popcll(__ballot(k[u][2 * pp] >= th[u][pp])) + __popcll(__ballot(k[u][2 * pp + 1] >= th[u][pp])) != 16;
                if (more) { unsigned t = th[u][pp];
#pragma unroll
                    for (int bit = 15; bit >= 0; --bit) { const unsigned c = t | (1u << bit);
                        const int n = __popcll(__ballot(k[u][2 * pp] >= c)) + __popcll(__ballot(k[u][2 * pp + 1] >= c)); t = n >= 16 ? c : t; }
                    th[u][pp] = t; } }
        float cv[U]; unsigned key[U]; int ca[U], cb[U];
#pragma unroll
        for (int u = 0; u < U; ++u) {
            unsigned* L = (unsigned*)lds_raw + (wid * U + u) * 192;
            unsigned* ck = L; unsigned* cvl = L + 32; unsigned* ci = L + 64; float* topv = (float*)(L + 96); int* topi = (int*)(L + 128);
#pragma unroll
            for (int pp = 0; pp < 2; ++pp) { const unsigned t = th[u][pp], ka = k[u][2 * pp], kb = k[u][2 * pp + 1];
                const unsigned long long ga = __ballot(ka > t), gb = __ballot(kb > t), ea = __ballot(ka == t), eb = __ballot(kb == t);
                const int need = 16 - __popcll(ga) - __popcll(gb);
                const bool sa = (ka > t) || (ka == t && mbcnt64(ea) < need), sb = (kb > t) || (kb == t && __popcll(ea) + mbcnt64(eb) < need);
                const unsigned long long ma = __ballot(sa), mb = __ballot(sb);
                const int pa = mbcnt64(ma), pb = __popcll(ma) + mbcnt64(mb);
                if (sa) { ck[pp * 16 + pa] = ka; cvl[pp * 16 + pa] = __float_as_uint(f[u][2 * pp]); ci[pp * 16 + pa] = (unsigned)lane; }
                if (sb) { ck[pp * 16 + pb] = kb; cvl[pp * 16 + pb] = __float_as_uint(f[u][2 * pp + 1]); ci[pp * 16 + pb] = (unsigned)(lane + 64); } }
            if (lane < 32) { const int pp = lane >> 4, me = lane & 15; const unsigned my = ck[lane]; int rk = 0;
#pragma unroll
                for (int j = 0; j < 16; ++j) { const unsigned o = ck[pp * 16 + j]; rk += (o > my || (o == my && j < me)) ? 1 : 0; }
                topv[pp * 16 + rk] = __uint_as_float(cvl[lane]); topi[pp * 16 + rk] = (int)ci[lane]; }
            cv[u] = 0.f; key[u] = 0u; ca[u] = 0; cb[u] = 0;
            if (lane < 50) { const int ab = cand_ab; ca[u] = ab >> 4; cb[u] = ab & 15; cv[u] = topv[ca[u]] + topv[16 + cb[u]]; key[u] = fkey(cv[u]); }
        }
        unsigned tc[U];
#pragma unroll
        for (int u = 0; u < U; ++u) tc[u] = 0u;
#pragma unroll
        for (int bit = 31; bit >= 14; --bit)
#pragma unroll
            for (int u = 0; u < U; ++u) { const unsigned c = tc[u] | (1u << bit); tc[u] = __popcll(__ballot(key[u] >= c)) >= 16 ? c : tc[u]; }
#pragma unroll
        for (int u = 0; u < U; ++u) {
            const bool more2 = __popcll(__ballot(key[u] >= tc[u])) != 16;
            if (more2) { unsigned t = tc[u];
#pragma unroll
                for (int bit = 13; bit >= 0; --bit) { const unsigned c = t | (1u << bit); t = __popcll(__ballot(key[u] >= c)) >= 16 ? c : t; }
                tc[u] = t; } }
#pragma unroll
        for (int u = 0; u < U; ++u) {
            const int* topi = (const int*)((unsigned*)lds_raw + (wid * U + u) * 192 + 128);
            const int row = itu[u] >> 3, h = itu[u] & 7; const unsigned t = tc[u];
            const unsigned long long g = __ballot(key[u] > t), e_ = __ballot(key[u] == t);
            const int need = 16 - __popcll(g);
            const bool win = (key[u] > t) || (key[u] == t && mbcnt64(e_) < need);
            const unsigned long long wm = __ballot(win);
            const float v16 = rdlane(cv[u], __builtin_amdgcn_readfirstlane(__ffsll(e_) - 1));
            const float ex = win ? __expf(cv[u] - v16) : 0.f;
            const float den = wave_sum(ex);
            if (win) { const int sl = mbcnt64(wm); idx[(size_t)row * 128 + h * 16 + sl] = topi[ca[u]] * 128 + topi[16 + cb[u]]; gate[(size_t)row * 128 + h * 16 + sl] = ex / den; }
        }
    }
}

__device__ __forceinline__ float gelu_exact(float v) {
    const float av = fabsf(v), t = __builtin_amdgcn_rcpf(av * 0.2316418882f + 1.0f);
    float q = t * 0.5307027145f + (-0.7265760135f); q = q * t + 0.7107068705f; q = q * t + (-0.142248368f); q = q * t + 0.127414796f; q = q * t;
    const float e = __builtin_amdgcn_exp2f((v * v) * (-0.72134752044f));
    const float m = v * (q * e);
    return v < 0.f ? m : v - m;
}
__device__ __forceinline__ void ph_expert(const Params& p, int l, int M) {
    const int lane = p.tid & 63, wv = p.bid * 8 + (p.tid >> 6), NW = p.nblk * 8;
    const unsigned char* U = (const unsigned char*)(p.ws + WS_PEER8); const unsigned char* V = U + (size_t)NEXP * D; const bf16_t* hb = (const bf16_t*)(p.ws + WS_H);
    const int* idx = (const int*)slot(p, 2); const float* gate = (const float*)slot(p, 2) + (size_t)MR * 128;
    u32x4 hw[4]; int idn0 = 0, idn1 = 0; float gn0 = 0.f, gn1 = 0.f;
    if (wv < M) {
#pragma unroll
        for (int c = 0; c < 2; ++c)
#pragma unroll
            for (int q = 0; q < 2; ++q) hw[c * 2 + q] = *(const u32x4*)(hb + (size_t)wv * D + c * 1024 + lane * 16 + q * 8);
        idn0 = idx[(size_t)wv * 128 + lane]; idn1 = idx[(size_t)wv * 128 + 64 + lane]; gn0 = gate[(size_t)wv * 128 + lane]; gn1 = gate[(size_t)wv * 128 + 64 + lane]; }
    for (int row = wv; row < M; row += NW) {
        float x[32], acc[32];
#pragma unroll
        for (int c = 0; c < 2; ++c)
#pragma unroll
            for (int q = 0; q < 2; ++q) { const u32x4 w = hw[c * 2 + q];
#pragma unroll
                for (int e = 0; e < 4; ++e) { x[c * 16 + q * 8 + 2 * e] = bflo(w[e]); x[c * 16 + q * 8 + 2 * e + 1] = bfhi(w[e]); } }
#pragma unroll
        for (int i = 0; i < 32; ++i) acc[i] = 0.f;
        const int id0 = idn0, id1 = idn1; const float g0 = gn0, g1 = gn1;
        { const int rn = row + NW < M ? row + NW : row;
#pragma unroll
          for (int c = 0; c < 2; ++c)
#pragma unroll
              for (int q = 0; q < 2; ++q) hw[c * 2 + q] = *(const u32x4*)(hb + (size_t)rn * D + c * 1024 + lane * 16 + q * 8);
          idn0 = idx[(size_t)rn * 128 + lane]; idn1 = idx[(size_t)rn * 128 + 64 + lane]; gn0 = gate[(size_t)rn * 128 + lane]; gn1 = gate[(size_t)rn * 128 + 64 + lane]; }
        float* xr = xrow(p, row); const int mr = mrow_of(row); const float* ga = modp(p, l, mr, 5);
        f32x4 xv[8], gv[8];
#pragma unroll
        for (int c = 0; c < 2; ++c)
#pragma unroll
            for (int q = 0; q < 4; ++q) { const int col = c * 1024 + lane * 16 + 4 * q; xv[c * 4 + q] = *(const f32x4*)(xr + col); gv[c * 4 + q] = *(const f32x4*)(ga + col); }
#pragma unroll 4
        for (int e = 0; e < 128; ++e) {
            const int id = __builtin_amdgcn_readlane(e < 64 ? id0 : id1, e & 63);
            const float g = __builtin_bit_cast(float, __builtin_amdgcn_readlane(__builtin_bit_cast(int, e < 64 ? g0 : g1), e & 63));
            const unsigned char* ur = U + (size_t)id * D + lane * 16; const unsigned char* vr = V + (size_t)id * D + lane * 16;
            u32x4 uw[2], vw[2];
#pragma unroll
            for (int c = 0; c < 2; ++c) { uw[c] = *(const u32x4*)(ur + c * 1024); vw[c] = *(const u32x4*)(vr + c * 1024); }
            float d = 0.f;
#pragma unroll
            for (int c = 0; c < 2; ++c)
#pragma unroll
                for (int q = 0; q < 4; ++q) { const f32x2 lo = __builtin_amdgcn_cvt_pk_f32_fp8((int)uw[c][q], false), hi = __builtin_amdgcn_cvt_pk_f32_fp8((int)uw[c][q], true);
                    d += lo.x * x[c * 16 + 4 * q] + lo.y * x[c * 16 + 4 * q + 1] + hi.x * x[c * 16 + 4 * q + 2] + hi.y * x[c * 16 + 4 * q + 3]; }
            d = wave_sum(d) * (1.0f / PEER_USCALE);
            const float a = g * gelu_exact(d) * (1.0f / PEER_VSCALE);
#pragma unroll
            for (int c = 0; c < 2; ++c)
#pragma unroll
                for (int q = 0; q < 4; ++q) { const f32x2 lo = __builtin_amdgcn_cvt_pk_f32_fp8((int)vw[c][q], false), hi = __builtin_amdgcn_cvt_pk_f32_fp8((int)vw[c][q], true);
                    acc[c * 16 + 4 * q] += a * lo.x; acc[c * 16 + 4 * q + 1] += a * lo.y; acc[c * 16 + 4 * q + 2] += a * hi.x; acc[c * 16 + 4 * q + 3] += a * hi.y; }
        }
        float ss = 0.f;
#pragma unroll
        for (int i = 0; i < 8; ++i) { xv[i] = xv[i] + gv[i] * (f32x4){acc[4 * i], acc[4 * i + 1], acc[4 * i + 2], acc[4 * i + 3]}; ss += xv[i][0] * xv[i][0] + xv[i][1] * xv[i][1] + xv[i][2] * xv[i][2] + xv[i][3] * xv[i][3]; }
        ss = wave_sum(ss);
        const float rs = rsqrtf(ss * (1.0f / D) + NORM_EPS);
        if (l == 1) {
            const float* fg = inp(p, I_FING);
#pragma unroll
            for (int c = 0; c < 2; ++c)
#pragma unroll
                for (int q = 0; q < 4; ++q) { const int col = c * 1024 + lane * 16 + 4 * q; *(f32x4*)(xr + col) = (xv[c * 4 + q] * rs) * *(const f32x4*)(fg + col); }
        } else {
            const float* g1 = inp(p, I_N1G) + (l + 1) * D; const float* sh = modp(p, l + 1, mr, 0); const float* sc = modp(p, l + 1, mr, 1);
            bf16_t* hrow = (bf16_t*)(p.ws + WS_H) + (size_t)row * D;
#pragma unroll
            for (int c = 0; c < 2; ++c) { unsigned w[8];
#pragma unroll
                for (int q = 0; q < 4; ++q) { const int col = c * 1024 + lane * 16 + 4 * q; *(f32x4*)(xr + col) = xv[c * 4 + q];
                    const f32x4 y = (xv[c * 4 + q] * rs) * *(const f32x4*)(g1 + col) * (*(const f32x4*)(sc + col) + 1.0f) + *(const f32x4*)(sh + col);
                    w[2 * q] = pack2(y[0], y[1]); w[2 * q + 1] = pack2(y[2], y[3]); }
                u32x4* d = (u32x4*)(hrow + c * 1024 + lane * 16); d[0] = (u32x4){w[0], w[1], w[2], w[3]}; d[1] = (u32x4){w[4], w[5], w[6], w[7]}; }
        }
    }
}

__device__ __forceinline__ void ph_final(const Params& p) {
    const int lane = p.tid & 63, wv = p.bid * 8 + (p.tid >> 6), NW = p.nblk * 8;
    const float* g = inp(p, I_FING);
    for (int r = wv; r < TL; r += NW) {
        float* xr = p.out + (size_t)r * D; f32x4 v[8]; float ss = 0.f;
#pragma unroll
        for (int c = 0; c < 8; ++c) { v[c] = *(const f32x4*)(xr + c * 256 + lane * 4); ss += v[c][0] * v[c][0] + v[c][1] * v[c][1] + v[c][2] * v[c][2] + v[c][3] * v[c][3]; }
        ss = wave_sum(ss); const float rs = rsqrtf(ss * (1.0f / D) + NORM_EPS);
#pragma unroll
        for (int c = 0; c < 8; ++c) { const int col = c * 256 + lane * 4; *(f32x4*)(xr + col) = (v[c] * rs) * *(const f32x4*)(g + col); }
    }
}

__global__ void __launch_bounds__(NTHREADS, 2) mega(KArgs a) {
    extern __shared__ __attribute__((aligned(16))) unsigned char shm[];
    volatile LAS unsigned* st = (volatile LAS unsigned*)(shm + LDS_BYTES - 16);
    if (threadIdx.x == 0) { st[0] = 0u; st[1] = 0u; st[2] = 0u; st[3] = 0u; }
    __syncthreads();
    unsigned char* const k_ws = a.ws; float* const k_out = a.out; const int k_wid = __builtin_amdgcn_readfirstlane(threadIdx.x >> 6), k_bid = blockIdx.x, k_nblk = gridDim.x;
#define CTX(q) Params q; { GAS unsigned char* w_ = (GAS unsigned char*)k_ws; GAS float* o_ = (GAS float*)k_out;     int b_ = k_bid, n_ = k_nblk, wv_ = k_wid; unsigned m_ = 0xFFFFFFFFu; asm volatile("; PHP_MARK" : "+s"(w_), "+s"(o_), "+s"(wv_), "+s"(b_), "+s"(n_), "+s"(m_)); int t_ = wv_ * 64 + (int)__builtin_amdgcn_mbcnt_hi(m_, __builtin_amdgcn_mbcnt_lo(m_, 0u)); q.ws = (unsigned char*)w_; q.out = (float*)o_; q.tid = t_; q.bid = b_; q.nblk = n_; }
#define GBAR() do { unsigned char* w_ = k_ws; asm volatile("" : "+s"(w_)); XcdBarrier b_; b_.bar = (unsigned*)(w_ + WS_BAR); b_.x = xb_xcc_id(); b_.st = st; xcd_barrier(b_); } while (0)
    (void)xcd_barrier_post((unsigned*)(k_ws + WS_BAR), st);
    { unsigned char* ws = k_ws;
    if (blockIdx.x == 0 && threadIdx.x == 0) { const float** tab = (const float**)(ws + WS_PTRS);
#pragma unroll
        for (int i = 0; i < 33; ++i) tab[i] = a.in[i]; } }
    { CTX(q); ph_init(q, a.in[I_X], a.in[I_CTX], a.in[I_C], a.in[I_CCTX], a.in[I_ADAW]); }
    GBAR();
    { CTX(q); ph_modred(q); }
    GBAR();
    { CTX(q); ph_prepA(q, 0); norm_rows(q, inp(q, I_N1G), 0, 0, 1, MR, inp(q, I_X), inp(q, I_CTX)); } GBAR();
#pragma unroll 1
    for (int l = 0; l < 2; ++l) {
        const bool last = (l == 1);
        const int ML = last ? TL : MR;
        { CTX(q); unsigned char* ws = q.ws; EpiConv<0> E{(const float*)(ws + WS_CONVW), (bf16_t*)(ws + WS_PCTX), slot(q, 0), (bf16_t*)(ws + WS_LORAIN)};
          run_gemm(q, shm, (const bf16_t*)(ws + WS_H), D, (const bf16_t*)(ws + WS_WTIN), D, MR, NR, D, E); } GBAR();
        { CTX(q); ph_ctxconv<0>(q); } GBAR();
        { CTX(q); unsigned char* ws = q.ws;
          { EpiLora E{(const float*)(ws + WS_LBIAS), 0, slot(q, 3)};
            run_gemm(q, shm, (const bf16_t*)(ws + WS_LORAIN), LORA_W, (const bf16_t*)(ws + WS_WTLORA), LORA_W, MR, 2 * D, 256, E); }
          { EpiLora E{(const float*)(ws + WS_LBIAS), 2, slot(q, 3)}; Params q2 = q; q2.bid = (q.bid + 32) % q.nblk;
            run_gemm(q2, shm, (const bf16_t*)(ws + WS_LORAIN) + 256, LORA_W, (const bf16_t*)(ws + WS_WTLORA) + (size_t)2 * D * LORA_W + 256, LORA_W, MR, 2 * D, 256, E); } } GBAR();
        { CTX(q); constexpr int NU = NB * NHEAD * 2;
          if (q.bid < NU) ph_scan3(q, l, shm); else { Params g = q; g.bid = q.bid - NU; g.nblk = q.nblk - NU; ph_prepB(g, l); ph_prep_bg(g, l); if (!last) ph_prepA(g, l + 1); } } GBAR();
        { CTX(q); ph_rwkv_out(q, l, ML, shm); } GBAR();
        { CTX(q); unsigned char* ws = q.ws; EpiConv<1> E{(const float*)(ws + WS_CONVW) + NR, (bf16_t*)(ws + WS_PCTX), slot(q, 0), nullptr};
          run_gemm(q, shm, (const bf16_t*)(ws + WS_H), D, (const bf16_t*)(ws + WS_WTIN) + (size_t)NR * D, D, ML, NHY, D, E); }
        { CTX(q); unsigned char* ws = q.ws; EpiBf E{slot(q, 3), SEQ};
          run_gemm(q, shm, (const bf16_t*)(ws + WS_W3T), 256, (const bf16_t*)(ws + WS_HDN), 256, 8192, SEQ, 256, E); } GBAR();
        if (!last) { { CTX(q); ph_ctxconv<1>(q); } { CTX(q); ph_ctxfilter(q, l); } GBAR(); { CTX(q); ph_ctxhyena(q, l, shm); } }
        { CTX(q); ph_hyena(q, l, shm); } GBAR();
        { CTX(q); unsigned char* ws = q.ws; EpiGate E{slot(q, 6), slot(q, 0), (const float*)(ws + WS_YHC), slot(q, 5)};
          run_gemm(q, shm, (const bf16_t*)(ws + WS_H), D, (const bf16_t*)(ws + WS_WTIN) + (size_t)(NR + NHY) * D, D, ML, NG, D, E); } GBAR();
        { CTX(q); unsigned char* ws = q.ws; EpiResid E{q.out, (float*)(ws + WS_CTXRES), (const float*)(ws + WS_MOD) + (size_t)(l * 18 + 2) * D, l == 0 ? inp(q, I_X) : (const float*)q.out, l == 0 ? inp(q, I_CTX) : (const float*)(ws + WS_CTXRES)};
          run_gemm(q, shm, slot(q, 5), D, (const bf16_t*)(ws + WS_WTOUT), D, ML, D, D, E); } GBAR();
        { CTX(q); ph_prep2(q, l, ML); } GBAR();
        { CTX(q); unsigned char* ws = q.ws; EpiF32 E{(float*)slot(q, 3), D};
          run_gemm(q, shm, (const bf16_t*)(ws + WS_H), D, (const bf16_t*)(ws + WS_WTSC), D, ML, D, D, E); } GBAR();
        { CTX(q); ph_topk(q, ML, shm); } GBAR();
        { CTX(q); ph_expert(q, l, ML); } GBAR();
    }
}

extern "C" void kernel_launch(void* const* d_in, const int* in_sizes, int n_in, void* d_out, int out_size, void* d_ws, size_t ws_size, hipStream_t stream) {
    static int grid = 0;
    if (grid == 0) {
        if (n_in != 33 || out_size != TL * D || ws_size < WS_END) { fprintf(stderr, "kernel_launch: unexpected shapes / workspace (%d inputs, out %d, ws %zu < %zu)\n", n_in, out_size, ws_size, (size_t)WS_END); grid = -1; return; }
        int dev = 0, cus = 0;
        if (hipGetDevice(&dev) != hipSuccess || hipDeviceGetAttribute(&cus, hipDeviceAttributeMultiprocessorCount, dev) != hipSuccess) { grid = -1; return; }
        if (hipFuncSetAttribute((const void*)mega, hipFuncAttributeMaxDynamicSharedMemorySize, LDS_BYTES) != hipSuccess) { fprintf(stderr, "kernel_launch: hipFuncSetAttribute failed\n"); grid = -1; return; }
        int per_cu = 0;
        if (hipOccupancyMaxActiveBlocksPerMultiprocessor(&per_cu, (const void*)mega, NTHREADS, LDS_BYTES) != hipSuccess || per_cu < 1) { fprintf(stderr, "kernel_launch: occupancy query says %d\n", per_cu); (void)hipGetLastError(); }
        grid = cus;
        if (grid <= NB * NHEAD * 2) { fprintf(stderr, "kernel_launch: needs more than %d compute units\n", NB * NHEAD * 2); grid = -1; return; }
    }
    if (grid < 0) return;
    (void)hipMemsetAsync((char*)d_ws + WS_BAR, 0, XCD_BAR_WORDS * sizeof(unsigned), stream);
    KArgs a{};
    for (int i = 0; i < 33; ++i) a.in[i] = (const float*)d_in[i];
    a.out = (float*)d_out; a.ws = (unsigned char*)d_ws;
    hipLaunchKernelGGL(mega, dim3(grid), dim3(NTHREADS), LDS_BYTES, stream, a);
}
```
